# Optimizing an MI355X kernel written in HIP

```python
import jax, jax.numpy as jnp
from jax import lax
import numpy as np

D_MODEL = 1024
BATCH = 2
SEQ = 8192
DEPTH = 2

EPS = 1e-6
ROPE_THETA = 10000.0
N_BRANCH = 3
LRU_WIDTH = 512
LRU_BLOCKS = 8
LRU_BLOCK = LRU_WIDTH // LRU_BLOCKS
LRU_CONV = 4
LRU_C = 8.0
RET_HEADS = 8
RET_DK = 64
RET_DV = 64
RET_CHUNK = 128
MLA_HEADS = 8
MLA_Q_RANK = 384
MLA_KV_RANK = 256
MLA_NOPE = 64
MLA_ROPE = 32
MLA_V = 64
ATTN_BLOCK = 128
D_FF = 2816
FFN_CONV = 3

IN_SIZES = (LRU_WIDTH, LRU_WIDTH,
            RET_HEADS * RET_DK, RET_HEADS * RET_DK, RET_HEADS * RET_DV, RET_HEADS * RET_DV,
            MLA_Q_RANK, MLA_KV_RANK, MLA_ROPE,
            N_BRANCH * D_MODEL)
N_IN = (2 * LRU_WIDTH + 2 * RET_HEADS * RET_DK + 2 * RET_HEADS * RET_DV
        + MLA_Q_RANK + MLA_KV_RANK + MLA_ROPE + N_BRANCH * D_MODEL)

kernel_name = "hybrid_lru_retention_mla_convglu"


def rmsnorm(x, g):
    xf = x.astype(jnp.float32)
    y = xf * lax.rsqrt(jnp.mean(xf * xf, axis=-1, keepdims=True) + EPS)
    return (y * g.astype(jnp.float32)).astype(x.dtype)


def modulate(h, shift, scale):
    return h * (1.0 + scale[:, None, :]) + shift[:, None, :]


def causal_dwconv(x, w, b):
    k_w = w.shape[0]
    s = x.shape[1]
    xp = jnp.pad(x, ((0, 0), (k_w - 1, 0), (0, 0)))
    y = xp[:, k_w - 1:k_w - 1 + s] * w[k_w - 1] + b
    for k in range(k_w - 1):
        y = y + xp[:, k:k + s] * w[k]
    return y


def rope_tables(positions, dim):
    inv = ROPE_THETA ** (-jnp.arange(0, dim, 2, dtype=jnp.float32) / dim)
    ang = positions.astype(jnp.float32)[..., None] * inv
    return jnp.cos(ang), jnp.sin(ang)


def apply_rope(x, cos, sin):
    half = x.shape[-1] // 2
    x1, x2 = x[..., :half], x[..., half:]
    y = jnp.concatenate([x1 * cos - x2 * sin, x1 * sin + x2 * cos], axis=-1)
    return y.astype(x.dtype)


def split_cols(t):
    out = []
    start = 0
    for n in IN_SIZES:
        out.append(t[..., start:start + n])
        start += n
    return out


def rglru_branch(xb, gb, conv_w, conv_b, wa, ba, wx, bx, lam):
    bsz, s, _ = xb.shape
    xc = causal_dwconv(xb, conv_w, conv_b)
    xblk = xc.reshape(bsz, s, LRU_BLOCKS, LRU_BLOCK)
    r = jax.nn.sigmoid(jnp.einsum('bsnh,nhk->bsnk', xblk, wa).reshape(bsz, s, LRU_WIDTH) + ba)
    i = jax.nn.sigmoid(jnp.einsum('bsnh,nhk->bsnk', xblk, wx).reshape(bsz, s, LRU_WIDTH) + bx)
    log_a = -LRU_C * r.astype(jnp.float32) * jax.nn.softplus(-lam.astype(jnp.float32))
    a = jnp.exp(log_a)
    mult = jnp.sqrt(-jnp.expm1(2.0 * log_a))
    u = mult * (i * xc).astype(jnp.float32)

    def combine(p, q):
        a1, b1 = p
        a2, b2 = q
        return a1 * a2, a2 * b1 + b2

    _, h = lax.associative_scan(combine, (a, u), axis=1)
    return h.astype(xb.dtype) * jax.nn.gelu(gb)


def retention_branch(q, k, v, g, cos, sin):
    bsz, s, _ = q.shape
    nc = s // RET_CHUNK
    f32 = jnp.float32
    q = apply_rope(q.reshape(bsz, s, RET_HEADS, RET_DK), cos[:, :, None, :], sin[:, :, None, :]).astype(f32)
    k = apply_rope(k.reshape(bsz, s, RET_HEADS, RET_DK), cos[:, :, None, :], sin[:, :, None, :]).astype(f32)
    k = k * (RET_DK ** -0.5)
    v = v.reshape(bsz, s, RET_HEADS, RET_DV).astype(f32)

    log_gamma = jnp.log1p(-(2.0 ** (-5.0 - jnp.arange(RET_HEADS, dtype=f32))))
    idx = jnp.arange(RET_CHUNK, dtype=f32)
    diff = idx[:, None] - idx[None, :]
    causal = diff >= 0
    inner_decay = jnp.where(causal[None], jnp.exp(jnp.where(causal, diff, 0.0)[None] * log_gamma[:, None, None]), 0.0)
    kv_decay = jnp.exp((RET_CHUNK - 1.0 - idx)[None, :] * log_gamma[:, None])
    q_decay = jnp.exp((idx + 1.0)[:, None] * log_gamma[None, :])
    chunk_decay = jnp.exp(RET_CHUNK * log_gamma)

    qc = q.reshape(bsz, nc, RET_CHUNK, RET_HEADS, RET_DK)
    kc = k.reshape(bsz, nc, RET_CHUNK, RET_HEADS, RET_DK)
    vc = v.reshape(bsz, nc, RET_CHUNK, RET_HEADS, RET_DV)

    scores = jnp.einsum('bnchd,bnshd->bnhcs', qc, kc) * inner_decay
    y_inner = jnp.einsum('bnhcs,bnshe->bnche', scores, vc)

    kv = jnp.einsum('bnshd,bnshe,hs->nbhde', kc, vc, kv_decay)

    def step(state, kv_n):
        return state * chunk_decay[None, :, None, None] + kv_n, state

    _, s_prev = lax.scan(step, jnp.zeros((bsz, RET_HEADS, RET_DK, RET_DV), f32), kv)
    y_cross = jnp.einsum('bnchd,nbhde->bnche', qc, s_prev) * q_decay[None, None, :, :, None]

    y = (y_inner + y_cross).reshape(bsz, s, RET_HEADS, RET_DV)
    mu = jnp.mean(y, axis=-1, keepdims=True)
    var = jnp.mean(jnp.square(y - mu), axis=-1, keepdims=True)
    y = ((y - mu) * lax.rsqrt(var + EPS)).reshape(bsz, s, RET_HEADS * RET_DV).astype(g.dtype)
    return jax.nn.silu(g) * y


def mla_branch(cq, ckv, kr, q_norm_g, w_uq, kv_norm_g, w_ukv, cos, sin):
    bsz, s, _ = cq.shape
    dqk = MLA_NOPE + MLA_ROPE
    q = (rmsnorm(cq, q_norm_g) @ w_uq).reshape(bsz, s, MLA_HEADS, dqk)
    q_nope, q_rope = q[..., :MLA_NOPE], q[..., MLA_NOPE:]
    q_rope = apply_rope(q_rope, cos[:, :, None, :], sin[:, :, None, :])
    kvu = (rmsnorm(ckv, kv_norm_g) @ w_ukv).reshape(bsz, s, MLA_HEADS, MLA_NOPE + MLA_V)
    k_nope, v = kvu[..., :MLA_NOPE], kvu[..., MLA_NOPE:]
    k_rope = apply_rope(kr, cos, sin)
    q = jnp.concatenate([q_nope, q_rope], axis=-1)
    k = jnp.concatenate([k_nope, jnp.broadcast_to(k_rope[:, :, None, :], (bsz, s, MLA_HEADS, MLA_ROPE))], axis=-1)
    scale = dqk ** -0.5
    nb = s // ATTN_BLOCK
    qb = q.reshape(bsz, nb, ATTN_BLOCK, MLA_HEADS, dqk).transpose(1, 0, 2, 3, 4)
    key_idx = jnp.arange(s)

    def attend(args):
        q_blk, start = args
        sc = jnp.einsum('bqhd,bkhd->bhqk', q_blk, k).astype(jnp.float32) * scale
        q_idx = start + jnp.arange(ATTN_BLOCK)
        mask = key_idx[None, :] <= q_idx[:, None]
        sc = jnp.where(mask[None, None], sc, -1e30)
        p = jax.nn.softmax(sc, axis=-1).astype(v.dtype)
        return jnp.einsum('bhqk,bkhe->bqhe', p, v)

    o = lax.map(attend, (qb, jnp.arange(nb) * ATTN_BLOCK))
    return o.transpose(1, 0, 2, 3, 4).reshape(bsz, s, MLA_HEADS * MLA_V)


def mixer_sublayer(h, w_in, lru_conv_w, lru_conv_b, lru_wa, lru_ba, lru_wx, lru_bx, lru_lambda, lru_wo,
                   ret_wo, mla_q_norm_g, mla_w_uq, mla_kv_norm_g, mla_w_ukv, mla_wo, w_out,
                   cos_r, sin_r, cos_m, sin_m):
    bsz, s, _ = h.shape
    t = h @ w_in
    lru_x, lru_g, ret_q, ret_k, ret_v, ret_g, mla_cq, mla_ckv, mla_kr, gate_logits = split_cols(t)
    y_lru = rglru_branch(lru_x, lru_g, lru_conv_w, lru_conv_b, lru_wa, lru_ba, lru_wx, lru_bx, lru_lambda) @ lru_wo
    y_ret = retention_branch(ret_q, ret_k, ret_v, ret_g, cos_r, sin_r) @ ret_wo
    y_mla = mla_branch(mla_cq, mla_ckv, mla_kr, mla_q_norm_g, mla_w_uq, mla_kv_norm_g, mla_w_ukv, cos_m, sin_m) @ mla_wo
    gates = jax.nn.sigmoid(gate_logits).reshape(bsz, s, N_BRANCH, D_MODEL)
    merged = gates[:, :, 0] * y_lru + gates[:, :, 1] * y_ret + gates[:, :, 2] * y_mla
    return merged @ w_out


def conv_glu(h, w_up, conv_w, conv_b, w_down):
    up = causal_dwconv(h @ w_up, conv_w, conv_b)
    u, g = up[..., :D_FF], up[..., D_FF:]
    return (jax.nn.gelu(g) * u) @ w_down


def setup_inputs(seed: int = 0) -> dict:
    key = jax.random.key(seed)
    ks = jax.random.split(key, 32)
    f32 = jnp.float32
    L = DEPTH

    def dense(k, shape, fan_in, gain=1.0):
        return jax.random.normal(k, shape, f32) * (gain * fan_in ** -0.5)

    def gain(k, shape):
        return 1.0 + 0.05 * jax.random.normal(k, shape, f32)

    def bias(k, shape):
        return 0.02 * jax.random.normal(k, shape, f32)

    offs = jax.random.randint(ks[2], (BATCH, 1), 0, 4096, dtype=jnp.int32)
    positions = (offs + jnp.arange(SEQ, dtype=jnp.int32)[None, :]).astype(jnp.int32)
    a_c = jax.random.uniform(ks[12], (L, LRU_WIDTH), f32, minval=0.9, maxval=0.999)
    a_base = a_c ** (1.0 / LRU_C)
    lru_lambda = jnp.log(a_base) - jnp.log1p(-a_base)
    return {
        "x": jax.random.normal(ks[0], (BATCH, SEQ, D_MODEL), f32),
        "c": jax.random.normal(ks[1], (BATCH, D_MODEL), f32),
        "positions": positions,
        "ada_w": dense(ks[3], (L, D_MODEL, 6 * D_MODEL), D_MODEL, 0.5),
        "ada_b": bias(ks[4], (L, 6 * D_MODEL)),
        "mix_pre_g": gain(ks[5], (L, D_MODEL)),
        "mix_post_g": gain(ks[6], (L, D_MODEL)),
        "w_in": dense(ks[7], (L, D_MODEL, N_IN), D_MODEL),
        "lru_conv_w": dense(ks[8], (L, LRU_CONV, LRU_WIDTH), LRU_CONV),
        "lru_conv_b": bias(ks[9], (L, LRU_WIDTH)),
        "lru_wa": dense(ks[10], (L, LRU_BLOCKS, LRU_BLOCK, LRU_BLOCK), LRU_BLOCK),
        "lru_ba": bias(ks[11], (L, LRU_WIDTH)),
        "lru_wx": dense(ks[13], (L, LRU_BLOCKS, LRU_BLOCK, LRU_BLOCK), LRU_BLOCK),
        "lru_bx": bias(ks[14], (L, LRU_WIDTH)),
        "lru_lambda": lru_lambda,
        "lru_wo": dense(ks[15], (L, LRU_WIDTH, D_MODEL), LRU_WIDTH),
        "ret_wo": dense(ks[16], (L, RET_HEADS * RET_DV, D_MODEL), RET_HEADS * RET_DV),
        "mla_q_norm_g": gain(ks[17], (L, MLA_Q_RANK)),
        "mla_w_uq": dense(ks[18], (L, MLA_Q_RANK, MLA_HEADS * (MLA_NOPE + MLA_ROPE)), MLA_Q_RANK),
        "mla_kv_norm_g": gain(ks[19], (L, MLA_KV_RANK)),
        "mla_w_ukv": dense(ks[20], (L, MLA_KV_RANK, MLA_HEADS * (MLA_NOPE + MLA_V)), MLA_KV_RANK),
        "mla_wo": dense(ks[21], (L, MLA_HEADS * MLA_V, D_MODEL), MLA_HEADS * MLA_V),
        "w_out": dense(ks[22], (L, D_MODEL, D_MODEL), D_MODEL),
        "ffn_pre_g": gain(ks[23], (L, D_MODEL)),
        "ffn_post_g": gain(ks[24], (L, D_MODEL)),
        "ffn_w_up": dense(ks[25], (L, D_MODEL, 2 * D_FF), D_MODEL),
        "ffn_conv_w": dense(ks[26], (L, FFN_CONV, 2 * D_FF), FFN_CONV),
        "ffn_conv_b": bias(ks[27], (L, 2 * D_FF)),
        "ffn_w_down": dense(ks[28], (L, D_FF, D_MODEL), D_FF),
    }


def reference(x, c, positions, ada_w, ada_b, mix_pre_g, mix_post_g, w_in, lru_conv_w, lru_conv_b,
              lru_wa, lru_ba, lru_wx, lru_bx, lru_lambda, lru_wo, ret_wo, mla_q_norm_g, mla_w_uq,
              mla_kv_norm_g, mla_w_ukv, mla_wo, w_out, ffn_pre_g, ffn_post_g, ffn_w_up, ffn_conv_w,
              ffn_conv_b, ffn_w_down):
    cos_r, sin_r = rope_tables(positions, RET_DK)
    cos_m, sin_m = rope_tables(positions, MLA_ROPE)
    c_act = jax.nn.silu(c)
    for l in range(DEPTH):
        mod = c_act @ ada_w[l] + ada_b[l]
        sh_m, sc_m, g_m, sh_f, sc_f, g_f = jnp.split(mod, 6, axis=-1)
        h = modulate(rmsnorm(x, mix_pre_g[l]), sh_m, sc_m)
        y = mixer_sublayer(h, w_in[l], lru_conv_w[l], lru_conv_b[l], lru_wa[l], lru_ba[l], lru_wx[l],
                           lru_bx[l], lru_lambda[l], lru_wo[l], ret_wo[l], mla_q_norm_g[l], mla_w_uq[l],
                           mla_kv_norm_g[l], mla_w_ukv[l], mla_wo[l], w_out[l],
                           cos_r, sin_r, cos_m, sin_m)
        x = x + g_m[:, None, :] * rmsnorm(y, mix_post_g[l])
        h = modulate(rmsnorm(x, ffn_pre_g[l]), sh_f, sc_f)
        y = conv_glu(h, ffn_w_up[l], ffn_conv_w[l], ffn_conv_b[l], ffn_w_down[l])
        x = x + g_f[:, None, :] * rmsnorm(y, ffn_post_g[l])
    return x
```

```cpp
#include <hip/hip_runtime.h>
#include <hip/hip_bf16.h>
#include <hip/hip_cooperative_groups.h>
#include <cstdio>
#include <cstdint>
namespace cg = cooperative_groups;

#ifndef MK_ONE_LAUNCH
#define MK_ONE_LAUNCH 0
#endif

constexpr int DM = 1024, NB = 2, SEQ = 8192, M = NB * SEQ, DEPTH = 2;
constexpr int LRU_W = 512, RET_H = 8, MLA_H = 8, QRANK = 384, KVRANK = 256, DFF = 2816;
constexpr int NIN = 6816;
constexpr float EPS = 1e-6f;

constexpr size_t MiB = 1u << 20;
constexpr size_t WS_CTL = 0, CTL_ZERO_BYTES = 64 * 1024;
constexpr size_t WS_MOD = 1 * MiB;
constexpr size_t WS_RSTD = WS_MOD + 128 * 1024;
constexpr size_t WS_LSA = WS_RSTD + 128 * 1024;
constexpr size_t WS_LSH = WS_LSA + 256 * 1024;
constexpr size_t WS_LC = WS_LSH + 256 * 1024;
constexpr size_t WS_ROPE = 3 * MiB;
constexpr size_t WS_W = 10 * MiB;
constexpr size_t WS_XN = 30 * MiB;
constexpr size_t WS_YB = 62 * MiB;
constexpr size_t WS_RS = 110 * MiB;
constexpr size_t WS_BIG = 126 * MiB;
constexpr size_t WS_TL = WS_BIG, WS_TR = WS_BIG + 32 * MiB, WS_TM = WS_BIG + 96 * MiB;
constexpr size_t WS_Q = WS_BIG, WS_K = WS_BIG + 24 * MiB, WS_V = WS_BIG + 48 * MiB;
constexpr size_t WS_G = WS_BIG, WS_Y = WS_BIG;
constexpr size_t WS_UPH = 62 * MiB, WS_ACT = 150 * MiB, WS_Y2 = 62 * MiB;
constexpr size_t WS_END = 256 * MiB;
constexpr size_t WO_IN = 0, WO_G = WO_IN + (size_t)3840 * 1024 * 2, WO_OUT = WO_G + (size_t)3072 * 1024 * 2, WO_O3 = WO_OUT + (size_t)1024 * 1024 * 2,
                 WO_UQ = WO_O3 + (size_t)3 * 1024 * 512 * 2, WO_UKV = WO_UQ + (size_t)768 * 384 * 2, WO_AT = WO_UKV + (size_t)1024 * 256 * 2, WO_XT = WO_AT + 65536, WO_MIX_END = WO_XT + 65536;
constexpr size_t WO_UP = 0, WO_DOWN = (size_t)5632 * 1024 * 2, WO_FFN_END = WO_DOWN + (size_t)1024 * 2816 * 2;
static_assert(WO_MIX_END <= 20 * MiB && WO_FFN_END <= 20 * MiB, "weight region");
static_assert(WS_ACT + (size_t)M * DFF * 2 <= WS_END && WS_UPH + (size_t)8192 * 5632 * 2 <= WS_ACT, "ffn map");

constexpr int LDS_BYTES = 147456;
constexpr int MISC_OFF = 131072 + 320;
constexpr int NWAVES = 8;

typedef float f32x16 __attribute__((ext_vector_type(16)));
typedef unsigned u32x2 __attribute__((ext_vector_type(2)));
typedef float f32x2 __attribute__((ext_vector_type(2)));

__device__ const double INVR[32] = {1.0, 0.7498942093324559, 0.5623413251903491, 0.4216965034285822, 0.31622776601683794, 0.23713737056616552, 0.1778279410038923, 0.1333521432163324, 0.1, 0.07498942093324558, 0.05623413251903491, 0.042169650342858224, 0.03162277660168379, 0.023713737056616554, 0.01778279410038923, 0.01333521432163324, 0.01, 0.007498942093324558, 0.005623413251903491, 0.004216965034285823, 0.0031622776601683794, 0.0023713737056616554, 0.0017782794100389228, 0.001333521432163324, 0.001, 0.0007498942093324559, 0.0005623413251903491, 0.00042169650342858224, 0.00031622776601683794, 0.00023713737056616554, 0.00017782794100389227, 0.0001333521432163324};
__device__ const float LG2G[8] = {-0.04580368961312479f, -0.02272007650008353f, -0.011315313227834146f, -0.005646563141142063f, -0.0028205190623786626f, -0.0014095702546713536f, -0.0007046129765893727f, -0.0003522634716290214f};

struct Ctx { int tid, lane, wave, G, vcu; };
struct Args { const void* in[29]; float* out; unsigned char* ws; int ph_lo, ph_hi; };
enum { I_X = 0, I_C, I_POS, I_ADAW, I_ADAB, I_MIXPRE, I_MIXPOST, I_WIN, I_LCW, I_LCB, I_LWA, I_LBA, I_LWX, I_LBX, I_LLAM, I_LWO, I_RWO, I_QNG, I_WUQ, I_KVNG, I_WUKV, I_MWO, I_WOUT,
       I_FPRE, I_FPOST, I_WUP, I_FCW, I_FCB, I_WDOWN };


#define GAS __attribute__((address_space(1)))
#define LAS __attribute__((address_space(3)))
extern __shared__ __attribute__((aligned(16))) unsigned char g_lds[];
constexpr int ARGS_LDS_OFF = 131072 + 1024;
__device__ __forceinline__ int opaque_u(int v) { int t; asm volatile("v_mov_b32 %0, %1" : "=v"(t) : "s"(v)); return __builtin_amdgcn_readfirstlane(t); }
__device__ __forceinline__ unsigned long long lds_arg(int idx) {
    const int z = opaque_u(0);
    volatile LAS unsigned* p = (volatile LAS unsigned*)((LAS unsigned char*)g_lds + z + ARGS_LDS_OFF) + 2 * idx;
    const unsigned lo = p[0], hi = p[1];
    return ((unsigned long long)(unsigned)__builtin_amdgcn_readfirstlane((int)hi) << 32) | (unsigned)__builtin_amdgcn_readfirstlane((int)lo);
}
__device__ __forceinline__ const void* inptr(const Args&, int i) { return (const void*)(GAS const void*)lds_arg(i); }
__device__ __forceinline__ unsigned char* wsptr(const Args&) { return (unsigned char*)(GAS unsigned char*)lds_arg(30); }
__device__ __forceinline__ float* outptr(const Args&) { return (float*)(GAS float*)lds_arg(29); }

namespace pg8 {
#define PG8_LAS __attribute__((address_space(3)))
typedef unsigned short bf16_t;
typedef short bf16x8 __attribute__((ext_vector_type(8)));
typedef float f32x4 __attribute__((ext_vector_type(4)));
typedef unsigned u32x4 __attribute__((ext_vector_type(4)));
typedef unsigned u32x2 __attribute__((ext_vector_type(2)));
constexpr int BM = 256, BK = 64, HALF = 128, HTB = HALF * BK * 2, STAGE_BYTES = 8 * HTB, NXCD = 8, WGM = 8;

__host__ __device__ __forceinline__ int lds_byte(int r, int c) { const int st = (r >> 4) * 2 + (c >> 5), rr = r & 15, cc = c & 31, ob = rr * 64 + cc * 2; return st * 1024 + (ob ^ (((ob >> 9) & 1) << 5)); }
__host__ __device__ __forceinline__ void stage_rc(int b, int& R, int& C) { const int st = b / 1024, sb = b % 1024, swz = sb ^ (((sb >> 9) & 1) << 5); R = (st >> 1) * 16 + swz / 64; C = (st & 1) * 32 + (swz % 64) / 2; }
__host__ __device__ __forceinline__ int perm32(int rho) { const int n = rho >> 4, i = rho & 15; return 8 * (i >> 2) + 4 * n + (i & 3); }

struct Unit { int pm, pn; };
struct Gemm { const bf16_t* A; const bf16_t* Bt; int M, N, K, lda; };

struct StaticOrder {
    int nM, nN, nwg, G, c;
    __host__ __device__ void init(int M_, int N_, int G_, int c_) { nM = M_ / BM; nN = N_ / BM; nwg = nM * nN; G = G_; c = c_; }
    __host__ __device__ bool next(int i, Unit& u) const {
        const long L = (long)i * G + c; if (L >= nwg) return false;
        int wgid = (int)L; { const int q = nwg / NXCD, r = nwg % NXCD, xcd = wgid % NXCD, off = wgid / NXCD; wgid = (xcd < r ? xcd * (q + 1) : r * (q + 1) + (xcd - r) * q) + off; }
        const int nig = WGM * nN, gid = wgid / nig, fm = gid * WGM, gsz = (nM - fm) < WGM ? (nM - fm) : WGM;
        u.pm = fm + ((wgid % nig) % gsz); u.pn = (wgid % nig) / gsz; return true;
    }
    __device__ __forceinline__ void a_ready(const Unit&) const {}
    __device__ __forceinline__ void done(const Unit&) const {}
};

typedef float f32x2_t __attribute__((ext_vector_type(2))); typedef __bf16 bf16x2_t __attribute__((ext_vector_type(2)));
__device__ __forceinline__ unsigned cvt_pk_bf16(float lo, float hi) { f32x2_t v = {lo, hi}; bf16x2_t b = __builtin_convertvector(v, bf16x2_t); return __builtin_bit_cast(unsigned, b); }
__device__ __forceinline__ float bf_lo(unsigned w) { return __uint_as_float(w << 16); }
__device__ __forceinline__ float bf_hi(unsigned w) { return __uint_as_float(w & 0xffff0000u); }
__device__ __forceinline__ float sigmoidf_(float x) { return __builtin_amdgcn_rcpf(1.0f + __builtin_amdgcn_exp2f(-1.4426950408889634f * x)); }


template <int ACT, size_t O0, int LD0, int T1, size_t O1, int LD1, int T2, size_t O2, int LD2> struct EpiRoute {
    static constexpr bool PERM = true, AFTER_DRAIN = false;
    const Args* a;
    __device__ __forceinline__ void operator()(const f32x4 (&acc)[2][2][4][2], const Unit& u, int wr, int wc, int fr, int fq) const {
        unsigned char* ws = wsptr(*a);
        bf16_t* base; int ld, ct;
        if (u.pn < T1) { base = (bf16_t*)(ws + O0); ld = LD0; ct = u.pn; } else if (u.pn < T2) { base = (bf16_t*)(ws + O1); ld = LD1; ct = u.pn - T1; } else { base = (bf16_t*)(ws + O2); ld = LD2; ct = u.pn - T2; }
        int row0 = u.pm * BM + wr * 64 + fr, col0 = ct * BM + wc * 32 + 8 * fq; asm volatile("" : "+v"(row0), "+v"(col0));
#pragma unroll
        for (int ai = 0; ai < 2; ++ai)
#pragma unroll
            for (int m = 0; m < 4; ++m) { bf16_t* rowp = base + (size_t)(row0 + ai * HALF + m * 16) * ld + col0;
#pragma unroll
                for (int bj = 0; bj < 2; ++bj) { f32x4 v0 = acc[ai][bj][m][0], v1 = acc[ai][bj][m][1];
                    if (ACT == 2) {
#pragma unroll
                        for (int e = 0; e < 4; ++e) { v0[e] = sigmoidf_(v0[e]); v1[e] = sigmoidf_(v1[e]); } }
                    u32x4 w; w.x = cvt_pk_bf16(v0[0], v0[1]); w.y = cvt_pk_bf16(v0[2], v0[3]); w.z = cvt_pk_bf16(v1[0], v1[1]); w.w = cvt_pk_bf16(v1[2], v1[3]);
                    *(u32x4*)(rowp + bj * HALF) = w; } }
    }
};
struct EpiQ {
    static constexpr bool PERM = true, AFTER_DRAIN = false;
    const Args* a;
    __device__ __forceinline__ void operator()(const f32x4 (&acc)[2][2][4][2], const Unit& u, int wr, int wc, int fr, int fq) const {
        unsigned char* ws = wsptr(*a);
        const char* Qc = (const char*)(ws + WS_Q); const char* rstd = (const char*)(ws + WS_RSTD); const char* cosm = (const char*)(ws + WS_ROPE) + (size_t)M * 64 * 4; const char* sinm = cosm + (size_t)M * 16 * 4;
        int row0 = u.pm * BM + wr * 64 + fr, fq4 = fq; asm volatile("" : "+v"(row0), "+v"(fq4));
        const int g32 = u.pn * 8 + wc;
#pragma unroll
        for (int ai = 0; ai < 2; ++ai)
#pragma unroll
            for (int m = 0; m < 4; ++m) { const unsigned row = (unsigned)(row0 + ai * HALF + m * 16); const float rs = *(const float*)(rstd + row * 4u);
#pragma unroll
                for (int bj = 0; bj < 2; ++bj) { const int g = g32 + 4 * bj;
                    f32x4 v0 = acc[ai][bj][m][0] * rs, v1 = acc[ai][bj][m][1] * rs;
                    if ((g % 3) == 2) { const f32x4 cs = *(const f32x4*)(cosm + row * 64u + (unsigned)fq4 * 16u), sn = *(const f32x4*)(sinm + row * 64u + (unsigned)fq4 * 16u);
                        f32x4 p, b; p[0] = v0[0] * cs[0] - v0[1] * sn[0]; p[1] = v0[0] * sn[0] + v0[1] * cs[0]; p[2] = v0[2] * cs[1] - v0[3] * sn[1]; p[3] = v0[2] * sn[1] + v0[3] * cs[1];
                        b[0] = v1[0] * cs[2] - v1[1] * sn[2]; b[1] = v1[0] * sn[2] + v1[1] * cs[2]; b[2] = v1[2] * cs[3] - v1[3] * sn[3]; b[3] = v1[2] * sn[3] + v1[3] * cs[3]; v0 = p; v1 = b; }
                    u32x4 w; w.x = cvt_pk_bf16(v0[0], v0[1]); w.y = cvt_pk_bf16(v0[2], v0[3]); w.z = cvt_pk_bf16(v1[0], v1[1]); w.w = cvt_pk_bf16(v1[2], v1[3]);
                    *(u32x4*)(Qc + row * 1536u + (unsigned)(g * 64 + fq4 * 16)) = w; }
                asm volatile("" ::: "memory"); }
    }
};
struct EpiKV {
    static constexpr bool PERM = true, AFTER_DRAIN = false;
    const Args* a;
    __device__ __forceinline__ void operator()(const f32x4 (&acc)[2][2][4][2], const Unit& u, int wr, int wc, int fr, int fq) const {
        unsigned char* ws = wsptr(*a);
        bf16_t* Kp = (bf16_t*)(ws + WS_K); bf16_t* Vp = (bf16_t*)(ws + WS_V); const float* rstd = (const float*)(ws + WS_RSTD) + M;
        int row0 = u.pm * BM + wr * 64 + fr, col0 = u.pn * BM + wc * 32 + 8 * fq; asm volatile("" : "+v"(row0), "+v"(col0));
#pragma unroll
        for (int ai = 0; ai < 2; ++ai)
#pragma unroll
            for (int m = 0; m < 4; ++m) { const int row = row0 + ai * HALF + m * 16; const float rs = rstd[row];
#pragma unroll
                for (int bj = 0; bj < 2; ++bj) { const int c = col0 + bj * HALF, h = c >> 7, w = c & 127;
                    const f32x4 v0 = acc[ai][bj][m][0] * rs, v1 = acc[ai][bj][m][1] * rs;
                    u32x4 o; o.x = cvt_pk_bf16(v0[0], v0[1]); o.y = cvt_pk_bf16(v0[2], v0[3]); o.z = cvt_pk_bf16(v1[0], v1[1]); o.w = cvt_pk_bf16(v1[2], v1[3]);
                    bf16_t* dst = (w < 64) ? (Kp + (size_t)row * 768 + h * 96 + w) : (Vp + (size_t)row * 512 + h * 64 + (w - 64));
                    *(u32x4*)dst = o; }
                asm volatile("" ::: "memory"); }
    }
};
struct EpiMerge {
    static constexpr bool PERM = true, AFTER_DRAIN = false;
    const Args* a; int b;
    __device__ __forceinline__ void operator()(const f32x4 (&acc)[2][2][4][2], const Unit& u, int wr, int wc, int fr, int fq) const {
        unsigned char* ws = wsptr(*a);
        bf16_t* O = (bf16_t*)(ws + WS_XN); const bf16_t* Gt = (const bf16_t*)(ws + WS_G) + 1024 * b; const bool accum = b > 0;
        int row0 = u.pm * BM + wr * 64 + fr, col0 = u.pn * BM + wc * 32 + 8 * fq; asm volatile("" : "+v"(row0), "+v"(col0));
#pragma unroll
        for (int ai = 0; ai < 2; ++ai)
#pragma unroll
            for (int m = 0; m < 4; ++m) { const int row = row0 + ai * HALF + m * 16;
#pragma unroll
                for (int bj = 0; bj < 2; ++bj) { const int c = col0 + bj * HALF;
                    const u32x4 gw = *(const u32x4*)(Gt + (size_t)row * 3072 + c);
                    f32x4 v0 = acc[ai][bj][m][0], v1 = acc[ai][bj][m][1];
                    v0[0] *= bf_lo(gw.x); v0[1] *= bf_hi(gw.x); v0[2] *= bf_lo(gw.y); v0[3] *= bf_hi(gw.y); v1[0] *= bf_lo(gw.z); v1[1] *= bf_hi(gw.z); v1[2] *= bf_lo(gw.w); v1[3] *= bf_hi(gw.w);
                    if (accum) { const u32x4 ow = *(const u32x4*)(O + (size_t)row * 1024 + c);
                        v0[0] += bf_lo(ow.x); v0[1] += bf_hi(ow.x); v0[2] += bf_lo(ow.y); v0[3] += bf_hi(ow.y); v1[0] += bf_lo(ow.z); v1[1] += bf_hi(ow.z); v1[2] += bf_lo(ow.w); v1[3] += bf_hi(ow.w); }
                    u32x4 o; o.x = cvt_pk_bf16(v0[0], v0[1]); o.y = cvt_pk_bf16(v0[2], v0[3]); o.z = cvt_pk_bf16(v1[0], v1[1]); o.w = cvt_pk_bf16(v1[2], v1[3]);
                    *(u32x4*)(O + (size_t)row * 1024 + c) = o; }
                asm volatile("" ::: "memory"); }
    }
};
template <size_t OFF> struct EpiF32 {
    static constexpr bool PERM = false, AFTER_DRAIN = false;
    const Args* a;
    __device__ __forceinline__ void operator()(const f32x4 (&acc)[2][2][4][2], const Unit& u, int wr, int wc, int fr, int fq) const {
        float* O = (float*)(wsptr(*a) + OFF);
        int row0 = u.pm * BM + wr * 64 + fr, col0 = u.pn * BM + wc * 32 + 4 * fq; asm volatile("" : "+v"(row0), "+v"(col0));
#pragma unroll
        for (int ai = 0; ai < 2; ++ai)
#pragma unroll
            for (int m = 0; m < 4; ++m) { float* rowp = O + (size_t)(row0 + ai * HALF + m * 16) * 1024 + col0;
#pragma unroll
                for (int bj = 0; bj < 2; ++bj)
#pragma unroll
                    for (int n = 0; n < 2; ++n) *(f32x4*)(rowp + bj * HALF + n * 16) = acc[ai][bj][m][n]; }
    }
};

template <class Epi, class Sched, bool ALIGN_EPI = false, bool SP2 = false>
__device__ __forceinline__ void gemm_phase(PG8_LAS unsigned char* lds, const Gemm g, const Sched& S, const Epi& E, int tid_in) {
    int tid_ = tid_in; asm volatile("" : "+v"(tid_));
    const int tid = tid_, wid = __builtin_amdgcn_readfirstlane(tid >> 6), lane = tid & 63, wr = wid >> 2, wc = wid & 3, fr = lane & 15, fq = lane >> 4;
    const int K = g.K, nt = K / BK;
    unsigned voffA[2], voffB[2];
#pragma unroll
    for (int i = 0; i < 2; ++i) { int R, C; stage_rc(tid * 16 + i * 8192, R, C); const int Rb = Epi::PERM ? ((R & ~31) + perm32(R & 31)) : R;
        voffA[i] = (unsigned)(R * g.lda + C) * 2u; voffB[i] = (unsigned)(Rb * K + C) * 2u; }
    const size_t kstep = (size_t)(BK * 2);
    const size_t hstepA = (size_t)HALF * g.lda * 2, hstepB = (size_t)HALF * K * 2;
    const size_t tstepA = 2 * hstepA, tstepB = 2 * hstepB;
    const unsigned ldsw = (unsigned)wid * 1024u;
    const int aoff = lds_byte(wr * 64 + fr, fq * 8), boff = lds_byte(wc * 32 + fr, fq * 8);
#define PG8_SA(b, h) (((b) * 2 + (h)) * HTB)
#define PG8_SB(b, h) ((4 + (b) * 2 + (h)) * HTB)
#define PG8_STAGE(bufoff, gbase, voff) do { _Pragma("unroll") for (int _i = 0; _i < 2; ++_i) \
        __builtin_amdgcn_global_load_lds((const unsigned*)((const char*)(gbase) + (voff)[_i]), (PG8_LAS unsigned*)(lds + (bufoff) + ldsw + _i * 8192), 16, 0, 0); } while (0)
#define PG8_LDA(dst, b, h) do { _Pragma("unroll") for (int m = 0; m < 4; ++m) _Pragma("unroll") for (int k = 0; k < 2; ++k) dst[m][k] = *(const PG8_LAS bf16x8*)(lds + PG8_SA(b, h) + aoff + m * 2048 + k * 1024); } while (0)
#define PG8_LDB(dst, b, h) do { _Pragma("unroll") for (int n = 0; n < 2; ++n) _Pragma("unroll") for (int k = 0; k < 2; ++k) dst[n][k] = *(const PG8_LAS bf16x8*)(lds + PG8_SB(b, h) + boff + n * 2048 + k * 1024); } while (0)
#define PG8_MMA(ai, bj, At, Bt) do { __builtin_amdgcn_s_setprio(1); _Pragma("unroll") for (int m = 0; m < 4; ++m) _Pragma("unroll") for (int n = 0; n < 2; ++n) _Pragma("unroll") for (int k = 0; k < 2; ++k) \
        acc[ai][bj][m][n] = __builtin_amdgcn_mfma_f32_16x16x32_bf16(Bt[n][k], At[m][k], acc[ai][bj][m][n], 0, 0, 0); __builtin_amdgcn_s_setprio(0); } while (0)
#define PG8_WAIT_V(n) asm volatile("s_waitcnt vmcnt(" #n ")" ::: "memory")
#define PG8_WAIT_L(n) asm volatile("s_waitcnt lgkmcnt(" #n ")" ::: "memory")
#define PG8_BAR __builtin_amdgcn_s_barrier()
#define PG8_SCHED __builtin_amdgcn_sched_barrier(0)
    Unit cur, nxt; int ui = 0;
    if (!S.next(0, cur)) return;
    f32x4 acc[2][2][4][2];
#pragma unroll
    for (int a = 0; a < 2; ++a)
#pragma unroll
        for (int b = 0; b < 2; ++b)
#pragma unroll
            for (int m = 0; m < 4; ++m)
#pragma unroll
                for (int n = 0; n < 2; ++n) acc[a][b][m][n] = (f32x4){0.f, 0.f, 0.f, 0.f};
    bf16x8 At[4][2], B0[2][2], B1[2][2];
    const char* cA = (const char*)g.A + (size_t)cur.pm * tstepA; const char* cB = (const char*)g.Bt + (size_t)cur.pn * tstepB;
    S.a_ready(cur);
    if constexpr (SP2) {
        PG8_STAGE(PG8_SB(0, 0), cB, voffB); PG8_STAGE(PG8_SB(0, 1), cB + hstepB, voffB); PG8_STAGE(PG8_SA(0, 0), cA, voffA); PG8_STAGE(PG8_SA(0, 1), cA + hstepA, voffA);
        if (wr == 1) PG8_BAR;
        PG8_WAIT_V(2); PG8_BAR;
        PG8_STAGE(PG8_SB(1, 0), cB + kstep, voffB); PG8_STAGE(PG8_SA(1, 0), cA + kstep, voffA); PG8_STAGE(PG8_SB(1, 1), cB + hstepB + kstep, voffB);
        PG8_WAIT_V(6); PG8_BAR;
    } else {
        PG8_STAGE(PG8_SB(0, 0), cB, voffB); PG8_STAGE(PG8_SA(0, 0), cA, voffA); PG8_STAGE(PG8_SB(0, 1), cB + hstepB, voffB); PG8_STAGE(PG8_SA(0, 1), cA + hstepA, voffA);
        if (wr == 1) PG8_BAR;
        PG8_WAIT_V(4); PG8_BAR;
        PG8_STAGE(PG8_SB(1, 0), cB + kstep, voffB); PG8_STAGE(PG8_SA(1, 0), cA + kstep, voffA); PG8_STAGE(PG8_SB(1, 1), cB + hstepB + kstep, voffB);
        PG8_WAIT_V(6); PG8_BAR;
    }
    for (;;) {
        const bool has_next = S.next(ui + 1, nxt);
        const char* nA = has_next ? (const char*)g.A + (size_t)nxt.pm * tstepA : cA; const char* nB = has_next ? (const char*)g.Bt + (size_t)nxt.pn * tstepB : cB;
        for (int t = 0; t < nt; t += 2) {
            const bool last = (t == nt - 2);
            const char* a1 = cA + (size_t)(t + 1) * kstep;
            const char* a2 = last ? nA : cA + (size_t)(t + 2) * kstep; const char* b2 = last ? nB : cB + (size_t)(t + 2) * kstep;
            const char* a3 = a2 + kstep; const char* b3 = b2 + kstep;
            if (last && has_next) S.a_ready(nxt);
            if constexpr (SP2) {
            PG8_LDB(B0, 0, 0); PG8_LDB(B1, 0, 1); PG8_SCHED; PG8_LDA(At, 0, 0); PG8_STAGE(PG8_SA(1, 1), a1 + hstepA, voffA);
            PG8_WAIT_V(8); PG8_WAIT_L(0); PG8_BAR; PG8_MMA(0, 0, At, B0); PG8_MMA(0, 1, At, B1); PG8_BAR; PG8_SCHED;
            PG8_LDA(At, 0, 1); PG8_STAGE(PG8_SB(0, 0), b2, voffB); PG8_STAGE(PG8_SB(0, 1), b2 + hstepB, voffB); PG8_STAGE(PG8_SA(0, 0), a2, voffA);
            PG8_WAIT_V(8); PG8_WAIT_L(0); PG8_BAR; PG8_MMA(1, 0, At, B0); PG8_MMA(1, 1, At, B1); PG8_BAR; PG8_SCHED;
            PG8_LDB(B0, 1, 0); PG8_LDB(B1, 1, 1); PG8_SCHED; PG8_LDA(At, 1, 0); PG8_STAGE(PG8_SA(0, 1), a2 + hstepA, voffA);
            PG8_WAIT_V(8); PG8_WAIT_L(0); PG8_BAR; PG8_MMA(0, 0, At, B0); PG8_MMA(0, 1, At, B1); PG8_BAR; PG8_SCHED;
            PG8_LDA(At, 1, 1); PG8_STAGE(PG8_SB(1, 0), b3, voffB); PG8_STAGE(PG8_SB(1, 1), b3 + hstepB, voffB); PG8_STAGE(PG8_SA(1, 0), a3, voffA);
            PG8_WAIT_V(8); PG8_WAIT_L(0); PG8_BAR; PG8_MMA(1, 0, At, B0); PG8_MMA(1, 1, At, B1); PG8_BAR; PG8_SCHED;
            } else {
            PG8_LDB(B0, 0, 0); PG8_SCHED; PG8_LDA(At, 0, 0); PG8_STAGE(PG8_SA(1, 1), a1 + hstepA, voffA);
            PG8_WAIT_L(8); PG8_BAR; PG8_WAIT_L(0); PG8_MMA(0, 0, At, B0); PG8_BAR; PG8_SCHED;
            PG8_LDB(B1, 0, 1); PG8_STAGE(PG8_SB(0, 0), b2, voffB);
            PG8_BAR; PG8_WAIT_L(0); PG8_MMA(0, 1, At, B1); PG8_BAR;
            PG8_LDA(At, 0, 1); PG8_STAGE(PG8_SA(0, 0), a2, voffA);
            PG8_BAR; PG8_WAIT_L(0); PG8_MMA(1, 0, At, B0); PG8_BAR; PG8_SCHED;
            PG8_STAGE(PG8_SB(0, 1), b2 + hstepB, voffB);
            PG8_WAIT_V(6); PG8_BAR; PG8_MMA(1, 1, At, B1); PG8_BAR;
            PG8_LDB(B0, 1, 0); PG8_SCHED; PG8_LDA(At, 1, 0); PG8_STAGE(PG8_SA(0, 1), a2 + hstepA, voffA);
            PG8_WAIT_L(8); PG8_BAR; PG8_WAIT_L(0); PG8_MMA(0, 0, At, B0); PG8_BAR; PG8_SCHED;
            PG8_LDB(B1, 1, 1); PG8_STAGE(PG8_SB(1, 0), b3, voffB);
            PG8_BAR; PG8_WAIT_L(0); PG8_MMA(0, 1, At, B1); PG8_BAR;
            PG8_LDA(At, 1, 1); PG8_STAGE(PG8_SA(1, 0), a3, voffA);
            PG8_BAR; PG8_WAIT_L(0); PG8_MMA(1, 0, At, B0); PG8_BAR; PG8_SCHED;
            PG8_STAGE(PG8_SB(1, 1), b3 + hstepB, voffB);
            PG8_WAIT_V(6); PG8_BAR; PG8_MMA(1, 1, At, B1); PG8_BAR;
            }
        }
        if constexpr (ALIGN_EPI) { if (wr == 0) PG8_BAR; }
        if constexpr (!Epi::AFTER_DRAIN) { E(acc, cur, wr, wc, fr, fq); S.done(cur); }
        if (!has_next) break;
#pragma unroll
        for (int a = 0; a < 2; ++a)
#pragma unroll
            for (int b = 0; b < 2; ++b)
#pragma unroll
                for (int m = 0; m < 4; ++m)
#pragma unroll
                    for (int n = 0; n < 2; ++n) acc[a][b][m][n] = (f32x4){0.f, 0.f, 0.f, 0.f};
        cur = nxt; cA = nA; cB = nB; ++ui;
        if constexpr (ALIGN_EPI) { if (wr == 1) PG8_BAR; }
    }
    PG8_WAIT_V(0);
    if constexpr (!ALIGN_EPI) { if (wr == 0) PG8_BAR; }
    PG8_BAR;
    if constexpr (Epi::AFTER_DRAIN) { E.fused(acc, cur, wr, wc, fr, fq, lds, wid, lane); S.done(cur); }
#undef PG8_SA
#undef PG8_SB
#undef PG8_STAGE
#undef PG8_LDA
#undef PG8_LDB
#undef PG8_MMA
#undef PG8_WAIT_V
#undef PG8_WAIT_L
#undef PG8_BAR
#undef PG8_SCHED
}
}

#define GAS __attribute__((address_space(1)))
#define LAS __attribute__((address_space(3)))
typedef unsigned short bf16;
typedef unsigned v4u __attribute__((ext_vector_type(4)));
typedef float f32x4 __attribute__((ext_vector_type(4)));
typedef short bf16x8 __attribute__((ext_vector_type(8)));
typedef GAS unsigned gu32;
typedef GAS unsigned long long gu64;
#define RLX_AGENT __ATOMIC_RELAXED, __HIP_MEMORY_SCOPE_AGENT
#define LDS_WAIT() asm volatile("s_waitcnt lgkmcnt(0)" ::: "memory")
#define VM_WAIT() asm volatile("s_waitcnt vmcnt(0)" ::: "memory")
__device__ __forceinline__ unsigned long long rt() { return __builtin_amdgcn_s_memrealtime(); }
__device__ __forceinline__ unsigned f2bf(float f) { unsigned u = __builtin_bit_cast(unsigned, f); return (u + 0x7fffu + ((u >> 16) & 1u)) >> 16; }
__device__ __forceinline__ unsigned pk2(float lo, float hi) { return f2bf(lo) | (f2bf(hi) << 16); }

#define XB_TMO      128
#define XB_XCNT(j)  (256  + 64 * (j))
#define XB_XSUB(j)  (1280 + 64 * (j))
#define XB_XGEN(j)  (2304 + 64 * (j))
#define XB_TOP      3328
#define XB_TOPGEN   3392
#define XCD_BAR_WORDS 3456
#define XB_SPIN_CAP (1u << 18)

__device__ __forceinline__ unsigned xb_ld(unsigned* p)              { return __hip_atomic_load(p, __ATOMIC_RELAXED, __HIP_MEMORY_SCOPE_AGENT); }
__device__ __forceinline__ unsigned xb_add(unsigned* p, unsigned v) { return __hip_atomic_fetch_add(p, v, __ATOMIC_RELAXED, __HIP_MEMORY_SCOPE_AGENT); }
__device__ __forceinline__ unsigned xb_xcc_id() { return (unsigned)__builtin_amdgcn_s_getreg((3 << 11) | 20) & 0xFu; }
#define XB_SPIN(cond, bar) do { unsigned _sp = 0; while (cond) { __builtin_amdgcn_s_sleep(1); \
    if ((++_sp & 255u) == 0u) { if (xb_ld(&(bar)[XB_TMO])) break; if (_sp > XB_SPIN_CAP) { atomicAdd(&(bar)[XB_TMO], 1u); break; } } } } while (0)

struct XcdBarrier {
    unsigned* bar; unsigned x;
    volatile LAS unsigned* st;
};

__device__ __forceinline__ XcdBarrier xcd_barrier_post(unsigned* bar, volatile LAS unsigned* st) {
    XcdBarrier b; b.bar = bar; b.x = xb_xcc_id(); b.st = st;
    if (threadIdx.x == 0) (void)xb_add(&bar[XB_XCNT(b.x)], 1u);
    return b;
}
__device__ __forceinline__ void xcd_barrier_complete(unsigned* bar, unsigned x, unsigned& nloc, unsigned& nx) {
    const unsigned G = gridDim.x * gridDim.y * gridDim.z;
    unsigned sum, cnt, mine, sp = 0u;
    for (;;) {
        sum = 0u; cnt = 0u; mine = 0u;
#pragma unroll
        for (unsigned j = 0; j < 16; ++j) { const unsigned c = xb_ld(&bar[XB_XCNT(j)]); sum += c; cnt += (c > 0u) ? 1u : 0u; mine = (j == x) ? c : mine; }
        if (sum == G) break;
        __builtin_amdgcn_s_sleep(1);
        if ((++sp & 255u) == 0u) { if (xb_ld(&bar[XB_TMO])) break; if (sp > XB_SPIN_CAP) { atomicAdd(&bar[XB_TMO], 1u); break; } }
    }
    nloc = mine > 0u ? mine : 1u; nx = cnt > 0u ? cnt : 1u;
}

__device__ __forceinline__ void xcd_barrier(const XcdBarrier& b) {
    asm volatile("s_waitcnt vmcnt(0)" ::: "memory");
    __syncthreads();
    if (threadIdx.x == 0) {
        unsigned* bar = b.bar;
        __builtin_amdgcn_s_waitcnt(0);
        unsigned nloc = b.st[0], nx = b.st[1];
        if (nloc == 0u) { xcd_barrier_complete(bar, b.x, nloc, nx); b.st[0] = nloc; b.st[1] = nx; }
        const unsigned old = xb_add(&bar[XB_XSUB(b.x)], 1u);
        const unsigned gen = old / nloc;
        if (old + 1u == (gen + 1u) * nloc) {
            __builtin_amdgcn_fence(__ATOMIC_RELEASE, "agent");
            asm volatile("s_waitcnt vmcnt(0)" ::: "memory");
            const unsigned og = xb_add(&bar[XB_TOP], 1u);
            const unsigned tg = og / nx;
            if (og + 1u == (tg + 1u) * nx) xb_add(&bar[XB_TOPGEN], 1u);
            else XB_SPIN(xb_ld(&bar[XB_TOPGEN]) == tg, bar);
            __builtin_amdgcn_fence(__ATOMIC_ACQUIRE, "agent");
            xb_add(&bar[XB_XGEN(b.x)], 1u);
            asm volatile("s_waitcnt vmcnt(0)" ::: "memory");
        } else {
            XB_SPIN(xb_ld(&bar[XB_XGEN(b.x)]) == gen, bar);
            __builtin_amdgcn_fence(__ATOMIC_ACQUIRE, "agent");
            asm volatile("s_waitcnt vmcnt(0)" ::: "memory");
        }
    }
    __syncthreads();
}

namespace att {
using bf16 = unsigned short;
typedef short bf16x8 __attribute__((ext_vector_type(8)));
typedef short s16x4 __attribute__((ext_vector_type(4)));
typedef float f32x16 __attribute__((ext_vector_type(16)));
typedef float f32x4 __attribute__((ext_vector_type(4)));
typedef unsigned u32x4 __attribute__((ext_vector_type(4)));
constexpr int DQK = 96, DV = 64, NW = 8, QBLK = 32, KVBLK = 64, QB = NW * QBLK;
constexpr int QP = 768, KP = 768, VP = 512, OP = 1536;
constexpr int SHM_V = KVBLK * DV * 2  , SHM_K = KVBLK * 256  ;
constexpr int LDS_BYTES = 2 * SHM_V + 2 * SHM_K + NW * 64 * 4;
constexpr float SCALE = 0.10206207261596575f;
constexpr float THR = 8.f;
#define KSWZ(row, colB) ((row) * 256 + ((colB) ^ (((row) & 7) << 4)))
#define SBAR() __builtin_amdgcn_sched_barrier(0)
__device__ __forceinline__ int v_st(int k, int c) { const int kk = (k & ~0xC) | ((k & 4) << 1) | ((k & 8) >> 1); return ((kk >> 3) * 2 + (c >> 5)) * 512 + ((kk & 7) * 32 + (c & 31)) * 2; }
__device__ __forceinline__ int v_rd_base(int lane) { return ((lane & 3) << 3) | (((lane >> 2) & 3) << 6) | (((lane >> 4) & 1) << 5) | (((lane >> 5) & 1) << 8); }
__device__ __forceinline__ int crow(int r, int hi) { return (r & 3) + 8 * (r >> 2) + 4 * hi; }
typedef float f32x2_t __attribute__((ext_vector_type(2))); typedef __bf16 bf16x2_t __attribute__((ext_vector_type(2)));
__device__ __forceinline__ unsigned cvtpk(float lo, float hi) { f32x2_t v = {lo, hi}; bf16x2_t b = __builtin_convertvector(v, bf16x2_t); return __builtin_bit_cast(unsigned, b); }
__device__ __forceinline__ void mask_tile(f32x16& p0, f32x16& p1, int dq) {
    const float NEG = -__builtin_inff();
#pragma unroll
    for (int r = 0; r < 16; ++r) { const int c = (r & 3) + 8 * (r >> 2); if (dq - c < 0) p0[r] = NEG; if (dq - c - 32 < 0) p1[r] = NEG; }
}
__device__ __forceinline__ void partialSM(f32x16& p0, f32x16& p1, float& m_reg, float& mn, float& alpha) {
    float pmax = p0[0];
#pragma unroll
    for (int r = 1; r < 16; ++r) pmax = fmaxf(pmax, p0[r]);
#pragma unroll
    for (int r = 0; r < 16; ++r) pmax = fmaxf(pmax, p1[r]);
    { auto rr = __builtin_amdgcn_permlane32_swap(__float_as_uint(pmax), __float_as_uint(pmax), false, false);
      pmax = fmaxf(__uint_as_float(rr[0]), __uint_as_float(rr[1])); }
    constexpr float C2 = 1.4426950408889634f * SCALE;
    if (__builtin_expect(__all((pmax - m_reg) * SCALE <= THR), 1)) { mn = m_reg; alpha = 1.f; }
    else { mn = fmaxf(m_reg, pmax); alpha = __builtin_amdgcn_exp2f((m_reg - mn) * C2); m_reg = mn; }
    const float mnL = -mn * C2;
#pragma unroll
    for (int r = 0; r < 16; ++r) p0[r] = fmaf(p0[r], C2, mnL);
#pragma unroll
    for (int r = 0; r < 16; ++r) p1[r] = fmaf(p1[r], C2, mnL);
#pragma unroll
    for (int r = 0; r < 16; ++r) p0[r] = __builtin_amdgcn_exp2f(p0[r]);
}
__device__ __forceinline__ void finishSM(f32x16& p0, f32x16& p1, float alpha, float& l_reg, bf16x8& pa0, bf16x8& pa1, bf16x8& pa2, bf16x8& pa3) {
#pragma unroll
    for (int r = 0; r < 16; ++r) p1[r] = __builtin_amdgcn_exp2f(p1[r]);
    float ps = 0;
#pragma unroll
    for (int r = 0; r < 16; ++r) ps += p0[r];
#pragma unroll
    for (int r = 0; r < 16; ++r) ps += p1[r];
    { auto rr = __builtin_amdgcn_permlane32_swap(__float_as_uint(ps), __float_as_uint(ps), false, false);
      ps = __uint_as_float(rr[0]) + __uint_as_float(rr[1]); }
    l_reg = l_reg * alpha + ps;
#define PK4(P, B_, OUT) do { unsigned a0 = cvtpk(P[B_+0], P[B_+1]), a1 = cvtpk(P[B_+2], P[B_+3]);                          \
        unsigned b0 = cvtpk(P[B_+4], P[B_+5]), b1 = cvtpk(P[B_+6], P[B_+7]);                                             \
        auto r0 = __builtin_amdgcn_permlane32_swap(a0, b0, false, false); auto r1 = __builtin_amdgcn_permlane32_swap(a1, b1, false, false); \
        u32x4 w = {r0[0], r1[0], r0[1], r1[1]}; OUT = *reinterpret_cast<bf16x8*>(&w); } while (0)
    PK4(p0, 0, pa0); PK4(p0, 8, pa1); PK4(p1, 0, pa2); PK4(p1, 8, pa3);
#undef PK4
}
template <int KB>
__device__ __forceinline__ void qkt(f32x16& p0, f32x16& p1, const char* K_lds, int r32, int hi, const bf16x8* qr) {
    p0 = f32x16{}; p1 = f32x16{};
    const char* kb[4];
#pragma unroll
    for (int dd = 0; dd < 4; ++dd) kb[dd] = K_lds + KB * SHM_K + KSWZ(r32, (dd * 16 + hi * 8) * 2);
#pragma unroll
    for (int d0 = 0; d0 < 6; ++d0) { const char* a = kb[d0 & 3] + (d0 >> 2) * 128;
        bf16x8 b0 = *reinterpret_cast<const bf16x8*>(a);
        bf16x8 b1 = *reinterpret_cast<const bf16x8*>(a + 32 * 256);
        p0 = __builtin_amdgcn_mfma_f32_32x32x16_bf16(b0, qr[d0], p0, 0, 0, 0);
        p1 = __builtin_amdgcn_mfma_f32_32x32x16_bf16(b1, qr[d0], p1, 0, 0, 0); }
}
template <int VB>
__device__ __forceinline__ void pv_tile(f32x16* o, int vb0, bf16x8 pa0, bf16x8 pa1, bf16x8 pa2, bf16x8 pa3) {
#define TRRD(dst, off) asm volatile("ds_read_b64_tr_b16 %0, %1 offset:%2" : "=&v"(dst) : "v"(vb0), "i"(off) : "memory")
#define PV_D0(d0) do { s16x4 l0, l1, l2, l3, h0, h1, h2, h3; constexpr int b_ = VB * SHM_V + (d0) * 512;   \
        TRRD(l0, b_); TRRD(h0, b_ + 1024); TRRD(l1, b_ + 2048); TRRD(h1, b_ + 3072); TRRD(l2, b_ + 4096); TRRD(h2, b_ + 5120); TRRD(l3, b_ + 6144); TRRD(h3, b_ + 7168); \
        asm volatile("s_waitcnt lgkmcnt(0)" ::: "memory"); SBAR();   \
        o[d0] = __builtin_amdgcn_mfma_f32_32x32x16_bf16(pa0, (bf16x8){l0[0], l0[1], l0[2], l0[3], h0[0], h0[1], h0[2], h0[3]}, o[d0], 0, 0, 0);   \
        o[d0] = __builtin_amdgcn_mfma_f32_32x32x16_bf16(pa1, (bf16x8){l1[0], l1[1], l1[2], l1[3], h1[0], h1[1], h1[2], h1[3]}, o[d0], 0, 0, 0);   \
        o[d0] = __builtin_amdgcn_mfma_f32_32x32x16_bf16(pa2, (bf16x8){l2[0], l2[1], l2[2], l2[3], h2[0], h2[1], h2[2], h2[3]}, o[d0], 0, 0, 0);   \
        o[d0] = __builtin_amdgcn_mfma_f32_32x32x16_bf16(pa3, (bf16x8){l3[0], l3[1], l3[2], l3[3], h3[0], h3[1], h3[2], h3[3]}, o[d0], 0, 0, 0); } while (0)
    PV_D0(0); PV_D0(1);
#undef PV_D0
#undef TRRD
}
struct BlockRef { const bf16* Q; const bf16* K; const bf16* V; bf16* O; int P0; };
struct Seam { bf16x8 qr[6]; bf16x8 st_v, st_k0, st_k1; };
#define VMW() asm volatile("s_waitcnt vmcnt(0)" ::: "memory")
#define VMWN(n) asm volatile("s_waitcnt vmcnt(%0)" :: "i"(n) : "memory")
#define SLOAD(Kp_, Vp_, k0) do { S.st_v = *(const bf16x8*)((Vp_) + (size_t)((k0) + vr) * VP + vc);                                   \
        if (kact) { S.st_k0 = *(const bf16x8*)((Kp_) + (size_t)((k0) + sr) * KP + kc); S.st_k1 = *(const bf16x8*)((Kp_) + (size_t)((k0) + 32 + sr) * KP + kc); } } while (0)
#define SWRITE_K(bf) do { if (kact) { *(bf16x8*)(K_lds + (bf) * SHM_K + kws) = S.st_k0; *(bf16x8*)(K_lds + (bf) * SHM_K + kws + 32 * 256) = S.st_k1; } } while (0)
#define SWRITE_V(bf) do { *(bf16x8*)(V_lds + (bf) * SHM_V + vst) = S.st_v; } while (0)
#define STG_DECL const int sr = tid >> 4, kc = ((tid & 15) < 12 ? (tid & 15) : 11) * 8; const bool kact = true; const int kws = KSWZ(sr, kc * 2); \
        const int vr = tid >> 3, vc = (tid & 7) * 8, vst = v_st(vr, vc);
__device__ __forceinline__ void attn_prime(const BlockRef& cur, char* lds, Seam& S, int tid_in) {
    int tid_ = tid_in; asm volatile("" : "+v"(tid_)); const int tid = tid_, wid = __builtin_amdgcn_readfirstlane(tid >> 6), lane = tid & 63, r32 = lane & 31, hi = lane >> 5;
    STG_DECL; (void)vst; char* K_lds = lds + 2 * SHM_V;
#pragma unroll
    for (int d0 = 0; d0 < 6; ++d0) S.qr[d0] = *(const bf16x8*)(cur.Q + (size_t)(wid * QBLK + r32) * QP + d0 * 16 + hi * 8);
    SLOAD(cur.K, cur.V, 0); VMW(); SWRITE_K(0);
    __syncthreads();
}
__device__ __forceinline__ void attn_block(const BlockRef& cur, const BlockRef& nxt, char* lds, Seam& S, int tid_in) {
    int tid_ = tid_in; asm volatile("" : "+v"(tid_)); const int tid = tid_, wid = __builtin_amdgcn_readfirstlane(tid >> 6), lane = tid & 63, r32 = lane & 31, hi = lane >> 5;
    const int NT = (cur.P0 + QB) / KVBLK;
    const int qlo = cur.P0 + wid * QBLK, qm = qlo + r32 - 4 * hi;
    char* V_lds = lds; char* K_lds = lds + 2 * SHM_V;
    float* ws = (float*)(lds + 2 * SHM_V + 2 * SHM_K) + wid * 64; float* li_l = ws, * al_l = ws + 32;
    float m_reg = -1e30f, l_reg = 0; f32x16 o[2] = {};
    STG_DECL;
    const int vb0 = (int)(uintptr_t)V_lds + v_rd_base(lane);
    const bf16* Kh = cur.K; const bf16* Vh = cur.V;
#define RESC(a) do { if (__any((a) < 1.f)) { if (hi == 0) al_l[r32] = (a); asm volatile("s_waitcnt lgkmcnt(0)" ::: "memory");              \
                     _Pragma("unroll") for (int d_ = 0; d_ < 2; ++d_) _Pragma("unroll") for (int r = 0; r < 16; ++r) o[d_][r] *= al_l[crow(r, hi)]; } } while (0)
#define KBASE(t) ((t) * KVBLK)
#define MASKT(P0_, P1_, t) do { const int kb_ = KBASE(t); if (kb_ + KVBLK - 1 > qlo) mask_tile(P0_, P1_, qm - kb_); } while (0)
    constexpr int NQL = 6;
#define SEAM_K0() do { VMWN(NQL); SWRITE_K(0); SBAR(); } while (0)
    f32x16 pA0, pA1, pB0, pB1; float mnA, mnB, alA, alB; bf16x8 pa0, pa1, pa2, pa3;
    SWRITE_V(0); SBAR();
    if (NT > 1) { SLOAD(Kh, Vh, KBASE(1)); }
    SBAR(); qkt<0>(pA0, pA1, K_lds, r32, hi, S.qr);
    MASKT(pA0, pA1, 0); partialSM(pA0, pA1, m_reg, mnA, alA);
    if (NT > 1) { VMW(); SWRITE_V(1); SWRITE_K(1); }
    __syncthreads();
#define HALF_STEP(PX0, PX1, mnX, alX, PY0, PY1, alY, t, KB, VB, SB) do {                                                      \
        SBAR(); qkt<KB>(PX0, PX1, K_lds, r32, hi, S.qr);                                                                      \
        finishSM(PY0, PY1, alY, l_reg, pa0, pa1, pa2, pa3); SBAR();                                                           \
        if ((t) + 1 < NT) { SLOAD(Kh, Vh, KBASE((t) + 1)); SBAR(); }                                                          \
        pv_tile<VB>(o, vb0, pa0, pa1, pa2, pa3); MASKT(PX0, PX1, (t)); partialSM(PX0, PX1, m_reg, mnX, alX);                  \
        __syncthreads();                                                                                                      \
        if ((t) + 1 < NT) { VMW(); SWRITE_V(SB); SWRITE_K(SB); }                                                              \
        RESC(alX); __syncthreads(); } while (0)
    for (int t = 1; t + 1 < NT; t += 2) {
        HALF_STEP(pB0, pB1, mnB, alB, pA0, pA1, alA, t, 1, 0, 0);
        HALF_STEP(pA0, pA1, mnA, alA, pB0, pB1, alB, t + 1, 0, 1, 1);
    }
    SBAR(); qkt<1>(pB0, pB1, K_lds, r32, hi, S.qr); SBAR();
    SLOAD(nxt.K, nxt.V, 0); SBAR();
#pragma unroll
    for (int d0 = 0; d0 < 6; ++d0) S.qr[d0] = *(const bf16x8*)(nxt.Q + (size_t)(wid * QBLK + r32) * QP + d0 * 16 + hi * 8);
    SBAR();
    finishSM(pA0, pA1, alA, l_reg, pa0, pa1, pa2, pa3); SBAR();
    pv_tile<0>(o, vb0, pa0, pa1, pa2, pa3);
    MASKT(pB0, pB1, NT - 1); partialSM(pB0, pB1, m_reg, mnB, alB); __syncthreads(); RESC(alB);
    finishSM(pB0, pB1, alB, l_reg, pa0, pa1, pa2, pa3); SBAR(); pv_tile<1>(o, vb0, pa0, pa1, pa2, pa3);
    SBAR(); SEAM_K0();
    if (hi == 0) li_l[r32] = l_reg; asm volatile("s_waitcnt lgkmcnt(0)" ::: "memory");
    float rli[16];
#pragma unroll
    for (int r = 0; r < 16; ++r) rli[r] = __builtin_amdgcn_rcpf(li_l[crow(r, hi)]);
    bf16* Ow = cur.O + (size_t)(wid * QBLK) * OP;
#pragma unroll
    for (int r = 0; r < 16; ++r) { const int orow = crow(r, hi);
#pragma unroll
        for (int d0 = 0; d0 < 2; ++d0) { const float v = o[d0][r] * rli[r];
            const float vn = __int_as_float(__builtin_amdgcn_mov_dpp(__float_as_int(v), 0xB1, 0xf, 0xf, true));
            if ((r32 & 1) == 0) *(unsigned*)(Ow + (size_t)orow * OP + d0 * 32 + r32) = cvtpk(v, vn); } }
    __syncthreads();
#undef RESC
#undef KBASE
#undef MASKT
#undef SEAM_K0
#undef HALF_STEP
}
#undef VMW
#undef VMWN
#undef SLOAD
#undef SWRITE_K
#undef SWRITE_V
#undef STG_DECL
#undef SBAR
}


template <int O> __device__ __forceinline__ float swz_xor(float v) { return __int_as_float(__builtin_amdgcn_ds_swizzle(__float_as_int(v), (O << 10) | 0x1f)); }
__device__ __forceinline__ float half_sum(float v) { auto rr = __builtin_amdgcn_permlane32_swap(__float_as_uint(v), __float_as_uint(v), false, false); return __uint_as_float(rr[0]) + __uint_as_float(rr[1]); }
__device__ __forceinline__ float wave_sum(float v) {
    v += swz_xor<1>(v); v += swz_xor<2>(v); v += swz_xor<4>(v); v += swz_xor<8>(v); v += swz_xor<16>(v);
    return half_sum(v);
}
__device__ __forceinline__ float bf2f(bf16 h) { return __uint_as_float((unsigned)h << 16); }
__device__ __forceinline__ float gelu_tanh(float x) { const float z = 1.5957691216057308f * (x + 0.044715f * x * x * x); return x * __builtin_amdgcn_rcpf(1.0f + __builtin_amdgcn_exp2f(-1.4426950408889634f * z)); }
__device__ __forceinline__ float sigm(float x) { return __builtin_amdgcn_rcpf(1.0f + __builtin_amdgcn_exp2f(-1.4426950408889634f * x)); }
__device__ __forceinline__ void unpack8(const v4u w, float* f) { f[0] = __uint_as_float(w.x << 16); f[1] = __uint_as_float(w.x & 0xffff0000u); f[2] = __uint_as_float(w.y << 16); f[3] = __uint_as_float(w.y & 0xffff0000u);
    f[4] = __uint_as_float(w.z << 16); f[5] = __uint_as_float(w.z & 0xffff0000u); f[6] = __uint_as_float(w.w << 16); f[7] = __uint_as_float(w.w & 0xffff0000u); }
__device__ __forceinline__ v4u pack8f(const float* f) { v4u o; o.x = pk2(f[0], f[1]); o.y = pk2(f[2], f[3]); o.z = pk2(f[4], f[5]); o.w = pk2(f[6], f[7]); return o; }

__device__ __forceinline__ int mapcol(int kind, int n) {
    if (kind == 0) return n;
    if (kind == 1) {
        if (n < 1024) return n;
        if (n < 2048) { const int base = n < 1536 ? 1024 : 1536, w = n - base, hd = w >> 6, i = w & 63; return base + hd * 64 + (i >> 1) + 32 * (i & 1); }
        if (n < 3712) return n;
        if (n < 3744) { const int w = n - 3712; return 3712 + (w >> 1) + 16 * (w & 1); }
        return -1;
    }
    if (kind == 2) return 3744 + n;
    if (kind == 3) { const int hd = n / 96, w = n - hd * 96; return w < 64 ? n : hd * 96 + 64 + ((w - 64) >> 1) + 16 * ((w - 64) & 1); }
    { const int pn = n >> 8, i = n & 255; return i < 128 ? pn * 128 + i : 2816 + pn * 128 + (i - 128); }
}
__device__ __forceinline__ void conv_item(const float* W, int K, int Nsrc, bf16* WT, int kind, const float* ksc, LAS float* scr, int item, int nblk, int lane) {
    const int kb = item / nblk, nb = item - kb * nblk, k0 = 64 * kb, n0 = 32 * nb;
    const int sc = mapcol(kind, n0 + (lane & 31));
#pragma unroll 8
    for (int i = 0; i < 32; ++i) { const int kk = 2 * i + (lane >> 5); float v = 0.f; if (sc >= 0) v = W[(size_t)(k0 + kk) * Nsrc + sc]; if (ksc) v *= ksc[k0 + kk]; scr[kk * 33 + (lane & 31)] = v; }
    LDS_WAIT(); asm volatile("" ::: "memory");
    const int c = lane & 7;
#pragma unroll
    for (int j = 0; j < 4; ++j) { const int n = (lane >> 3) + 8 * j; const LAS float* s = scr + (8 * c) * 33 + n;
        v4u o; o.x = pk2(s[0 * 33], s[1 * 33]); o.y = pk2(s[2 * 33], s[3 * 33]); o.z = pk2(s[4 * 33], s[5 * 33]); o.w = pk2(s[6 * 33], s[7 * 33]);
        *(GAS v4u*)(WT + (size_t)(n0 + n) * K + k0 + 8 * c) = o; }
    LDS_WAIT(); asm volatile("" ::: "memory");
}
__device__ __forceinline__ void conv_matrix(const Ctx& X, LAS unsigned char* lds, const float* W, int K, int Nsrc, bf16* WT, int ndst, int kind, const float* ksc) {
    LAS float* scr = (LAS float*)(lds + X.wave * 16384);
    const int gw = X.vcu * NWAVES + X.wave, NGW = X.G * NWAVES, nblk = ndst / 32, nitems = (K / 64) * nblk;
    for (int it = gw; it < nitems; it += NGW) conv_item(W, K, Nsrc, WT, kind, ksc, scr, it, nblk, X.lane);
}
__device__ __forceinline__ void convert_mixer(const Ctx& X, LAS unsigned char* lds, const Args& a, int l) {
    bf16* Wb = (bf16*)(wsptr(a) + WS_W);
    const float* win = (const float*)inptr(a, I_WIN) + (size_t)l * 1024 * NIN;
    conv_matrix(X, lds, win, 1024, NIN, (bf16*)((char*)Wb + WO_IN), 3840, 1, nullptr);
    conv_matrix(X, lds, win, 1024, NIN, (bf16*)((char*)Wb + WO_G), 3072, 2, nullptr);
    conv_matrix(X, lds, (const float*)inptr(a, I_WOUT) + (size_t)l * 1024 * 1024, 1024, 1024, (bf16*)((char*)Wb + WO_OUT), 1024, 0, nullptr);
    conv_matrix(X, lds, (const float*)inptr(a, I_LWO) + (size_t)l * 512 * 1024, 512, 1024, (bf16*)((char*)Wb + WO_O3), 1024, 0, nullptr);
    conv_matrix(X, lds, (const float*)inptr(a, I_RWO) + (size_t)l * 512 * 1024, 512, 1024, (bf16*)((char*)Wb + WO_O3) + 1024 * 512, 1024, 0, nullptr);
    conv_matrix(X, lds, (const float*)inptr(a, I_MWO) + (size_t)l * 512 * 1024, 512, 1024, (bf16*)((char*)Wb + WO_O3) + 2 * 1024 * 512, 1024, 0, nullptr);
    conv_matrix(X, lds, (const float*)inptr(a, I_WUQ) + (size_t)l * 384 * 768, 384, 768, (bf16*)((char*)Wb + WO_UQ), 768, 3, (const float*)inptr(a, I_QNG) + l * 384);
    conv_matrix(X, lds, (const float*)inptr(a, I_WUKV) + (size_t)l * 256 * 1024, 256, 1024, (bf16*)((char*)Wb + WO_UKV), 1024, 0, (const float*)inptr(a, I_KVNG) + l * 256);
    for (int blk = 0; blk < 8; ++blk) {
        conv_matrix(X, lds, (const float*)inptr(a, I_LWA) + (size_t)(l * 8 + blk) * 4096, 64, 64, (bf16*)((char*)Wb + WO_AT) + blk * 4096, 64, 0, nullptr);
        conv_matrix(X, lds, (const float*)inptr(a, I_LWX) + (size_t)(l * 8 + blk) * 4096, 64, 64, (bf16*)((char*)Wb + WO_XT) + blk * 4096, 64, 0, nullptr);
    }
}
__device__ __forceinline__ void convert_ffn(const Ctx& X, LAS unsigned char* lds, const Args& a, int l) {
    bf16* Wb = (bf16*)(wsptr(a) + WS_W);
    conv_matrix(X, lds, (const float*)inptr(a, I_WUP) + (size_t)l * 1024 * 5632, 1024, 5632, (bf16*)((char*)Wb + WO_UP), 5632, 4, nullptr);
    conv_matrix(X, lds, (const float*)inptr(a, I_WDOWN) + (size_t)l * 2816 * 1024, 2816, 1024, (bf16*)((char*)Wb + WO_DOWN), 1024, 0, nullptr);
}

__device__ __forceinline__ void p_mods(const Ctx& X, LAS unsigned char* lds, const Args& a) {
    LAS float* cact = (LAS float*)lds; LAS float* red = (LAS float*)(lds + 8192);
    const float* c = (const float*)inptr(a, I_C);
    for (int i = X.tid; i < NB * 1024; i += 512) { const float v = c[i]; cact[i] = v * sigm(v); }
    __syncthreads();
    float* MOD = (float*)(wsptr(a) + WS_MOD);
    const float* adaw = (const float*)inptr(a, I_ADAW); const float* adab = (const float*)inptr(a, I_ADAB);
    for (int it = X.vcu; it < DEPTH * 96; it += X.G) {
        const int l = it / 96, j0 = (it - l * 96) * 64, cl = X.tid & 63, ks = X.tid >> 6;
        const float* w = adaw + (size_t)l * 1024 * 6144 + j0 + cl;
        float a0 = 0.f, a1 = 0.f;
#pragma unroll 8
        for (int k = ks * 128; k < ks * 128 + 128; ++k) { const float wv = w[(size_t)k * 6144]; a0 += cact[k] * wv; a1 += cact[1024 + k] * wv; }
        red[(ks * 64 + cl) * 2] = a0; red[(ks * 64 + cl) * 2 + 1] = a1;
        __syncthreads();
        if (X.tid < 128) { const int cc = X.tid & 63, b = X.tid >> 6; float s = 0.f;
#pragma unroll
            for (int q = 0; q < 8; ++q) s += red[(q * 64 + cc) * 2 + b];
            MOD[(size_t)(l * NB + b) * 6144 + j0 + cc] = s + adab[l * 6144 + j0 + cc]; }
        __syncthreads();
    }
}
__device__ __forceinline__ void p_rope(const Ctx& X, const Args& a) {
    float* cr = (float*)(wsptr(a) + WS_ROPE); float* sr = cr + (size_t)M * 32; float* cm = sr + (size_t)M * 32; float* sm = cm + (size_t)M * 16;
    const int* pos = (const int*)inptr(a, I_POS);
    const int nth = X.G * 512;
    for (int idx = X.vcu * 512 + X.tid; idx < M * 32; idx += nth) {
        const int row = idx >> 5, i = idx & 31;
        const double ang = (double)pos[row] * INVR[i];
        const double k = __builtin_rint(ang * 0.15915494309189535);
        double r = __builtin_fma(-k, 6.283185307179586, ang); r = __builtin_fma(-k, 2.4492935982947064e-16, r);
        const float rf = (float)r; const float sn = sinf(rf), cs = cosf(rf);
        cr[idx] = cs; sr[idx] = sn;
        if ((i & 1) == 0) { cm[row * 16 + (i >> 1)] = cs; sm[row * 16 + (i >> 1)] = sn; }
    }
}

template <int MODE, bool HAS_NEXT>
__device__ __forceinline__ void row_pass(const Ctx& X, const float* xin, float* xout, const float* Y, const float* gpost, const float* gate  ,
                                         const float* gpre, const float* shift, const float* scale, bf16* XN) {
    const int gw = X.vcu * NWAVES + X.wave, NGW = X.G * NWAVES, lane = X.lane;
    for (int b = 0; b < NB; ++b) {
        f32x4 vgp[4], vgt[4], vpre[4], vsh[4], vsc[4];
#pragma unroll
        for (int j = 0; j < 4; ++j) { const int cidx = 4 * lane + 256 * j;
            if (MODE == 1) { vgp[j] = *(const f32x4*)(gpost + cidx); vgt[j] = *(const f32x4*)(gate + (size_t)b * 6144 + cidx); }
            if (MODE == 0 || HAS_NEXT) { vpre[j] = *(const f32x4*)(gpre + cidx); vsh[j] = *(const f32x4*)(shift + (size_t)b * 6144 + cidx); vsc[j] = *(const f32x4*)(scale + (size_t)b * 6144 + cidx) + 1.0f; } }
        for (int m = gw; m < SEQ; m += NGW) { const size_t row = (size_t)b * SEQ + m;
            f32x4 xv[4];
#pragma unroll
            for (int j = 0; j < 4; ++j) xv[j] = *(const f32x4*)(xin + row * 1024 + 4 * lane + 256 * j);
            if (MODE == 1) { f32x4 yv[4]; float s = 0.f;
#pragma unroll
                for (int j = 0; j < 4; ++j) { yv[j] = *(const f32x4*)(Y + row * 1024 + 4 * lane + 256 * j); s += (yv[j].x * yv[j].x + yv[j].y * yv[j].y) + (yv[j].z * yv[j].z + yv[j].w * yv[j].w); }
                const float rs = __builtin_amdgcn_rsqf(wave_sum(s) * (1.0f / 1024.0f) + EPS);
#pragma unroll
                for (int j = 0; j < 4; ++j) { xv[j] = xv[j] + vgt[j] * (yv[j] * rs * vgp[j]); *(f32x4*)(xout + row * 1024 + 4 * lane + 256 * j) = xv[j]; } }
            if (MODE == 0 || HAS_NEXT) { float s = 0.f;
#pragma unroll
                for (int j = 0; j < 4; ++j) s += (xv[j].x * xv[j].x + xv[j].y * xv[j].y) + (xv[j].z * xv[j].z + xv[j].w * xv[j].w);
                const float rs = __builtin_amdgcn_rsqf(wave_sum(s) * (1.0f / 1024.0f) + EPS);
#pragma unroll
                for (int j = 0; j < 4; ++j) { const f32x4 h = (xv[j] * rs * vpre[j]) * vsc[j] + vsh[j];
                    u32x2 w; w.x = pk2(h.x, h.y); w.y = pk2(h.z, h.w); *(u32x2*)(XN + row * 1024 + 4 * lane + 256 * j) = w; } }
        }
    }
}

__device__ __forceinline__ void p_mla_rstd(const Ctx& X, const Args& a) {
    const bf16* TM = (const bf16*)(wsptr(a) + WS_TM); float* RSTD = (float*)(wsptr(a) + WS_RSTD);
    const int gw = X.vcu * NWAVES + X.wave, NGW = X.G * NWAVES, lane = X.lane;
    for (int m = gw; m < M; m += NGW) {
        float sq = 0.f, skv = 0.f;
#pragma unroll
        for (int k = 0; k < 3; ++k) { const u32x2 w = *(const u32x2*)(TM + (size_t)m * 768 + k * 256 + lane * 4);
            const float f0 = __uint_as_float(w.x << 16), f1 = __uint_as_float(w.x & 0xffff0000u), f2 = __uint_as_float(w.y << 16), f3 = __uint_as_float(w.y & 0xffff0000u);
            const float s = (f0 * f0 + f1 * f1) + (f2 * f2 + f3 * f3);
            if (k == 0) sq += s; else if (k == 1) { if (lane < 32) sq += s; else skv += s; } else { if (lane < 32) skv += s; } }
        sq = wave_sum(sq); skv = wave_sum(skv);
        if (lane == 0) { RSTD[m] = __builtin_amdgcn_rsqf(sq * (1.0f / 384.0f) + EPS); RSTD[M + m] = __builtin_amdgcn_rsqf(skv * (1.0f / 256.0f) + EPS); }
    }
}
__device__ __forceinline__ void p_krope(const Ctx& X, const Args& a) {
    const bf16* TM = (const bf16*)(wsptr(a) + WS_TM); bf16* Kp = (bf16*)(wsptr(a) + WS_K);
    const float* cm = (const float*)(wsptr(a) + WS_ROPE) + (size_t)M * 64; const float* sm = cm + (size_t)M * 16;
    const int nth = X.G * 512;
    for (int idx = X.vcu * 512 + X.tid; idx < M * 4; idx += nth) { const int row = idx >> 2, cc = idx & 3;
        const v4u w = *(const v4u*)(TM + (size_t)row * 768 + 640 + cc * 8); float f[8]; unpack8(w, f);
        const f32x4 cs = *(const f32x4*)(cm + (size_t)row * 16 + cc * 4), sn = *(const f32x4*)(sm + (size_t)row * 16 + cc * 4);
        float o[8];
#pragma unroll
        for (int p = 0; p < 4; ++p) { o[2 * p] = f[2 * p] * cs[p] - f[2 * p + 1] * sn[p]; o[2 * p + 1] = f[2 * p] * sn[p] + f[2 * p + 1] * cs[p]; }
        const v4u ow = pack8f(o);
#pragma unroll
        for (int h = 0; h < 8; ++h) *(v4u*)(Kp + (size_t)row * 768 + h * 96 + 64 + cc * 8) = ow; }
}

__device__ __forceinline__ float log1p_small(float e) { return e < 0.03f ? e * (1.0f + e * (-0.5f + e * (0.33333334f + e * (-0.25f + e * 0.2f)))) : 0.6931471805599453f * __builtin_amdgcn_logf(1.0f + e); }
__device__ __forceinline__ float softplus_neg(float x) { const float z = -x, e = __builtin_amdgcn_exp2f(-1.4426950408889634f * __builtin_fabsf(z)); return __builtin_fmaxf(z, 0.0f) + log1p_small(e); }
__device__ __forceinline__ float neg_expm1(float y) { return y > -0.1f ? -y * (1.0f + y * (0.5f + y * (0.16666667f + y * (0.041666668f + y * 0.008333334f)))) : 1.0f - __builtin_amdgcn_exp2f(1.4426950408889634f * y); }
constexpr int LRU_XS = 0, LRU_XC = 33792, LRU_XCB = LRU_XC + 32768, LRU_AA = LRU_XCB + 18432, LRU_SEG = LRU_AA + 32768, LRU_END = LRU_SEG + 4096;
static_assert(LRU_END <= 131072, "lru lds");
template <int PASS>
__device__ __forceinline__ void lru_phase(const Ctx& X, unsigned char* ldsg, const Args& a, int l) {
    float* XS = (float*)(ldsg + LRU_XS); float* XC = (float*)(ldsg + LRU_XC); bf16* XCB = (bf16*)(ldsg + LRU_XCB); float* AA = (float*)(ldsg + LRU_AA); float* SEG = (float*)(ldsg + LRU_SEG);
    const bf16* TL = (const bf16*)(wsptr(a) + WS_TL); bf16* YB = (bf16*)(wsptr(a) + WS_YB);
    const bf16* WaT = (const bf16*)(wsptr(a) + WS_W + WO_AT); const bf16* WxT = (const bf16*)(wsptr(a) + WS_W + WO_XT);
    float* LSA = (float*)(wsptr(a) + WS_LSA); float* LSH = (float*)(wsptr(a) + WS_LSH); const float* LC = (const float*)(wsptr(a) + WS_LC);
    const float* cw = (const float*)inptr(a, I_LCW) + l * 4 * 512; const float* cbv = (const float*)inptr(a, I_LCB) + l * 512;
    const float* ba = (const float*)inptr(a, I_LBA) + l * 512; const float* bx = (const float*)inptr(a, I_LBX) + l * 512; const float* lam = (const float*)inptr(a, I_LLAM) + l * 512;
    const int tid = X.tid, lane = X.lane, wave = X.wave, r32 = lane & 31, hi = lane >> 5;
    for (int u = X.vcu; u < NB * 64 * 8; u += X.G) {
        const int blk = u & 7, n = (u >> 3) & 63, b = u >> 9, ch0 = blk * 64; const size_t row0 = (size_t)b * SEQ + n * 128;
        for (int c = tid; c < 131 * 8; c += 512) { const int r = c >> 3, cc = (c & 7) * 8, srow = n * 128 + r - 3; float f[8];
            if (srow >= 0) { const v4u w = *(const v4u*)(TL + ((size_t)b * SEQ + srow) * 1024 + ch0 + cc); unpack8(w, f); }
            else {
#pragma unroll
                for (int e = 0; e < 8; ++e) f[e] = 0.f; }
#pragma unroll
            for (int e = 0; e < 8; ++e) XS[r * 64 + cc + e] = f[e]; }
        __syncthreads();
        { const int c = tid & 63, rg = tid >> 6; const float w0 = cw[ch0 + c], w1 = cw[512 + ch0 + c], w2 = cw[1024 + ch0 + c], w3 = cw[1536 + ch0 + c], bb = cbv[ch0 + c];
#pragma unroll 4
            for (int r = 0; r < 16; ++r) { const int t = rg * 16 + r; const float v = bb + w0 * XS[t * 64 + c] + w1 * XS[(t + 1) * 64 + c] + w2 * XS[(t + 2) * 64 + c] + w3 * XS[(t + 3) * 64 + c];
                XC[t * 64 + c] = v; XCB[t * 72 + c] = (bf16)f2bf(v); } }
        __syncthreads();
        { const int tb = wave >> 1, cb = wave & 1; f32x16 R = {}, I = {};
#pragma unroll
            for (int ks = 0; ks < 4; ++ks) { const bf16x8 A = *(const bf16x8*)(XCB + (32 * tb + r32) * 72 + 16 * ks + 8 * hi);
                const bf16x8 Ba = *(const bf16x8*)(WaT + (size_t)(blk * 64 + 32 * cb + r32) * 64 + 16 * ks + 8 * hi), Bx = *(const bf16x8*)(WxT + (size_t)(blk * 64 + 32 * cb + r32) * 64 + 16 * ks + 8 * hi);
                R = __builtin_amdgcn_mfma_f32_32x32x16_bf16(A, Ba, R, 0, 0, 0); I = __builtin_amdgcn_mfma_f32_32x32x16_bf16(A, Bx, I, 0, 0, 0); }
            const int c = 32 * cb + r32; const float bav = ba[ch0 + c], bxv = bx[ch0 + c], sp = softplus_neg(lam[ch0 + c]);
#pragma unroll
            for (int r = 0; r < 16; ++r) { const int t = 32 * tb + (r & 3) + 8 * (r >> 2) + 4 * hi;
                const float rr = sigm(R[r] + bav), ii = sigm(I[r] + bxv), la = -8.0f * rr * sp, av = __builtin_amdgcn_exp2f(1.4426950408889634f * la), mult = __builtin_amdgcn_sqrtf(neg_expm1(2.0f * la));
                AA[t * 64 + c] = av; XC[t * 64 + c] = mult * ii * XC[t * 64 + c]; } }
        __syncthreads();
        { const int c = tid & 63, sg = tid >> 6; float Ap = 1.f, Hp = 0.f;
#pragma unroll 4
            for (int i = 0; i < 16; ++i) { const int t = sg * 16 + i; const float av = AA[t * 64 + c]; Hp = av * Hp + XC[t * 64 + c]; Ap *= av; }
            SEG[sg * 64 + c] = Ap; SEG[512 + sg * 64 + c] = Hp;
            __syncthreads();
            if (PASS == 1) { if (tid < 64) { float A2 = 1.f, H2 = 0.f;
#pragma unroll
                    for (int s = 0; s < 8; ++s) { const float sa = SEG[s * 64 + c]; H2 = sa * H2 + SEG[512 + s * 64 + c]; A2 *= sa; }
                    LSA[(size_t)(b * 64 + n) * 512 + ch0 + c] = A2; LSH[(size_t)(b * 64 + n) * 512 + ch0 + c] = H2; } }
            else { float hin = LC[(size_t)(b * 64 + n) * 512 + ch0 + c];
                for (int s = 0; s < sg; ++s) hin = SEG[s * 64 + c] * hin + SEG[512 + s * 64 + c];
#pragma unroll 4
                for (int i = 0; i < 16; ++i) { const int t = sg * 16 + i; hin = AA[t * 64 + c] * hin + XC[t * 64 + c];
                    const float g = bf2f(TL[(row0 + t) * 1024 + 512 + ch0 + c]);
                    YB[(row0 + t) * 1536 + ch0 + c] = (bf16)f2bf(hin * gelu_tanh(g)); } }
        }
        __syncthreads();
    }
}
__device__ __forceinline__ void lru_prefix(const Ctx& X, const Args& a) {
    const float* LSA = (const float*)(wsptr(a) + WS_LSA); const float* LSH = (const float*)(wsptr(a) + WS_LSH); float* LC = (float*)(wsptr(a) + WS_LC);
    const int idx = X.vcu * 512 + X.tid;
    if (idx < NB * 512) { const int b = idx >> 9, ch = idx & 511; float h = 0.f;
        for (int n0 = 0; n0 < 64; n0 += 8) { float av[8], hv[8];
#pragma unroll
            for (int j = 0; j < 8; ++j) { av[j] = LSA[(size_t)(b * 64 + n0 + j) * 512 + ch]; hv[j] = LSH[(size_t)(b * 64 + n0 + j) * 512 + ch]; }
#pragma unroll
            for (int j = 0; j < 8; ++j) { LC[(size_t)(b * 64 + n0 + j) * 512 + ch] = h; h = av[j] * h + hv[j]; } } }
}

constexpr int RT_Q = 0, RT_K = 18432, RT_V = 36864, RT_S = 55296, RT_HALF = 64512, RT_P = 72;
template <int PASS>
__device__ __forceinline__ void ret_phase(const Ctx& X, unsigned char* ldsg, const Args& a) {
    const bf16* TR = (const bf16*)(wsptr(a) + WS_TR); bf16* YB = (bf16*)(wsptr(a) + WS_YB); float* RS = (float*)(wsptr(a) + WS_RS);
    const float* cr = (const float*)(wsptr(a) + WS_ROPE); const float* sr = cr + (size_t)M * 32;
    const int tid = X.tid, lane = X.lane, wave = X.wave, r32 = lane & 31, hi = lane >> 5, half = wave >> 2, w4 = wave & 3, t2 = tid & 255;
    bf16* Qs = (bf16*)(ldsg + half * RT_HALF + RT_Q); bf16* Ks = (bf16*)(ldsg + half * RT_HALF + RT_K); bf16* Vs = (bf16*)(ldsg + half * RT_HALF + RT_V); bf16* Ss = (bf16*)(ldsg + half * RT_HALF + RT_S);
    for (int u = X.vcu; u < NB * 64 * 4; u += X.G) {
        const int hp = u & 3, n = (u >> 2) & 63, b = u >> 8, h = 2 * hp + half; const size_t row0 = (size_t)b * SEQ + n * 128; const float lg = LG2G[h];
        for (int c = t2; c < 1024; c += 256) { const int r = c >> 3, cc = (c & 7) * 8; const size_t grow = row0 + r;
            const f32x4 cs = *(const f32x4*)(cr + grow * 32 + (cc >> 1)), sn = *(const f32x4*)(sr + grow * 32 + (cc >> 1));
            { const v4u w = *(const v4u*)(TR + grow * 2048 + 512 + h * 64 + cc); float f[8], o[8]; unpack8(w, f);
              const float kd = (PASS == 1) ? 0.125f * __builtin_amdgcn_exp2f((float)(127 - r) * lg) : 0.125f;
#pragma unroll
              for (int p = 0; p < 4; ++p) { o[2 * p] = (f[2 * p] * cs[p] - f[2 * p + 1] * sn[p]) * kd; o[2 * p + 1] = (f[2 * p] * sn[p] + f[2 * p + 1] * cs[p]) * kd; }
              *(v4u*)(Ks + r * RT_P + cc) = pack8f(o); }
            *(v4u*)(Vs + r * RT_P + cc) = *(const v4u*)(TR + grow * 2048 + 1024 + h * 64 + cc);
            if (PASS == 2) { const v4u w = *(const v4u*)(TR + grow * 2048 + h * 64 + cc); float f[8], o[8]; unpack8(w, f);
#pragma unroll
              for (int p = 0; p < 4; ++p) { o[2 * p] = f[2 * p] * cs[p] - f[2 * p + 1] * sn[p]; o[2 * p + 1] = f[2 * p] * sn[p] + f[2 * p + 1] * cs[p]; }
              *(v4u*)(Qs + r * RT_P + cc) = pack8f(o); } }
        if (PASS == 2) { const float* sp = RS + ((size_t)(b * 8 + h) * 64 + n) * 4096;
            for (int c = t2; c < 1024; c += 256) { const int d = c >> 4, e0 = (c & 15) * 4; const f32x4 v = *(const f32x4*)(sp + d * 64 + e0);
                Ss[(e0 + 0) * RT_P + d] = (bf16)f2bf(v.x); Ss[(e0 + 1) * RT_P + d] = (bf16)f2bf(v.y); Ss[(e0 + 2) * RT_P + d] = (bf16)f2bf(v.z); Ss[(e0 + 3) * RT_P + d] = (bf16)f2bf(v.w); } }
        __syncthreads();
        if (PASS == 1) {
            const int db = w4 >> 1, eb = w4 & 1; f32x16 acc = {};
#pragma unroll
            for (int ks = 0; ks < 8; ++ks) { bf16x8 A, B;
#pragma unroll
                for (int j = 0; j < 8; ++j) { A[j] = (short)Ks[(16 * ks + 8 * hi + j) * RT_P + 32 * db + r32]; B[j] = (short)Vs[(16 * ks + 8 * hi + j) * RT_P + 32 * eb + r32]; }
                acc = __builtin_amdgcn_mfma_f32_32x32x16_bf16(A, B, acc, 0, 0, 0); }
            float* dst = RS + ((size_t)(b * 8 + h) * 64 + n) * 4096;
#pragma unroll
            for (int r = 0; r < 16; ++r) dst[(32 * db + (r & 3) + 8 * (r >> 2) + 4 * hi) * 64 + 32 * eb + r32] = acc[r];
        } else {
            const int cb = w4; bf16x8 qf[4];
#pragma unroll
            for (int ks = 0; ks < 4; ++ks) qf[ks] = *(const bf16x8*)(Qs + (32 * cb + r32) * RT_P + 16 * ks + 8 * hi);
            f32x16 yin[2] = {}, ycr[2] = {};
            for (int sb = 0; sb <= cb; ++sb) { f32x16 st = {};
#pragma unroll
                for (int ks = 0; ks < 4; ++ks) { const bf16x8 A = *(const bf16x8*)(Ks + (32 * sb + r32) * RT_P + 16 * ks + 8 * hi); st = __builtin_amdgcn_mfma_f32_32x32x16_bf16(A, qf[ks], st, 0, 0, 0); }
#pragma unroll
                for (int r = 0; r < 16; ++r) { const int d = (32 * cb + r32) - (32 * sb + (r & 3) + 8 * (r >> 2) + 4 * hi); st[r] = d >= 0 ? st[r] * __builtin_amdgcn_exp2f((float)d * lg) : 0.f; }
#pragma unroll
                for (int t = 0; t < 2; ++t) { v4u pw; pw.x = pk2(st[8 * t], st[8 * t + 1]); pw.y = pk2(st[8 * t + 2], st[8 * t + 3]); pw.z = pk2(st[8 * t + 4], st[8 * t + 5]); pw.w = pk2(st[8 * t + 6], st[8 * t + 7]);
                    const bf16x8 Bf = __builtin_bit_cast(bf16x8, pw);
#pragma unroll
                    for (int eb = 0; eb < 2; ++eb) { bf16x8 A;
#pragma unroll
                        for (int j = 0; j < 8; ++j) A[j] = (short)Vs[(32 * sb + 16 * t + 8 * (j >> 2) + 4 * hi + (j & 3)) * RT_P + 32 * eb + r32];
                        yin[eb] = __builtin_amdgcn_mfma_f32_32x32x16_bf16(A, Bf, yin[eb], 0, 0, 0); } } }
#pragma unroll
            for (int eb = 0; eb < 2; ++eb)
#pragma unroll
                for (int ks = 0; ks < 4; ++ks) { const bf16x8 A = *(const bf16x8*)(Ss + (32 * eb + r32) * RT_P + 16 * ks + 8 * hi); ycr[eb] = __builtin_amdgcn_mfma_f32_32x32x16_bf16(A, qf[ks], ycr[eb], 0, 0, 0); }
            const float qd = __builtin_amdgcn_exp2f((float)(32 * cb + r32 + 1) * lg);
            float s = 0.f;
#pragma unroll
            for (int eb = 0; eb < 2; ++eb)
#pragma unroll
                for (int r = 0; r < 16; ++r) { yin[eb][r] += qd * ycr[eb][r]; s += yin[eb][r]; }
            s = half_sum(s); const float mu = s * (1.0f / 64.0f); float q = 0.f;
#pragma unroll
            for (int eb = 0; eb < 2; ++eb)
#pragma unroll
                for (int r = 0; r < 16; ++r) { const float dlt = yin[eb][r] - mu; yin[eb][r] = dlt; q += dlt * dlt; }
            q = half_sum(q); const float rstd = __builtin_amdgcn_rsqf(q * (1.0f / 64.0f) + EPS);
            const size_t grow = row0 + 32 * cb + r32;
#pragma unroll
            for (int eb = 0; eb < 2; ++eb)
#pragma unroll
                for (int qd4 = 0; qd4 < 4; ++qd4) { const int e0 = 32 * eb + 8 * qd4 + 4 * hi;
                    const u32x2 gw = *(const u32x2*)(TR + grow * 2048 + 1536 + h * 64 + e0);
                    const float g0 = __uint_as_float(gw.x << 16), g1 = __uint_as_float(gw.x & 0xffff0000u), g2 = __uint_as_float(gw.y << 16), g3 = __uint_as_float(gw.y & 0xffff0000u);
                    u32x2 ow; ow.x = pk2(g0 * sigm(g0) * yin[eb][4 * qd4] * rstd, g1 * sigm(g1) * yin[eb][4 * qd4 + 1] * rstd); ow.y = pk2(g2 * sigm(g2) * yin[eb][4 * qd4 + 2] * rstd, g3 * sigm(g3) * yin[eb][4 * qd4 + 3] * rstd);
                    *(u32x2*)(YB + grow * 1536 + 512 + h * 64 + e0) = ow; }
        }
        __syncthreads();
    }
}
__device__ __forceinline__ void ret_prefix(const Ctx& X, const Args& a) {
    float* RS = (float*)(wsptr(a) + WS_RS);
    const int nth = X.G * 512;
    for (int idx = X.vcu * 512 + X.tid; idx < NB * 8 * 4096; idx += nth) { const int bh = idx >> 12, off = idx & 4095, h = bh & 7;
        const float cd = __builtin_amdgcn_exp2f(128.0f * LG2G[h]); float* base = RS + (size_t)bh * 64 * 4096 + off; float st = 0.f;
        for (int n0 = 0; n0 < 64; n0 += 8) { float t[8];
#pragma unroll
            for (int j = 0; j < 8; ++j) t[j] = base[(size_t)(n0 + j) * 4096];
#pragma unroll
            for (int j = 0; j < 8; ++j) { base[(size_t)(n0 + j) * 4096] = st; st = st * cd + t[j]; } } }
}

__device__ __forceinline__ void act_pass(const Ctx& X, const Args& a, int l, int hb) {
    const bf16* UP = (const bf16*)(wsptr(a) + WS_UPH); bf16* ACT = (bf16*)(wsptr(a) + WS_ACT) + (size_t)hb * SEQ * DFF;
    const float* cw = (const float*)inptr(a, I_FCW) + (size_t)l * 3 * 5632; const float* cb = (const float*)inptr(a, I_FCB) + (size_t)l * 5632;
    const int nth = X.G * 512; constexpr int SEGR = 32, NSEG = SEQ / SEGR, NCH = DFF / 8;
    for (int idx = X.vcu * 512 + X.tid; idx < NSEG * NCH; idx += nth) { const int jc = idx % NCH, sg = idx / NCH, j0 = jc * 8, ucol = (j0 >> 7) * 256 + (j0 & 127), gcol = ucol + 128;
        float wu[3][8], wg[3][8], bu[8], bg[8];
#pragma unroll
        for (int k = 0; k < 3; ++k)
#pragma unroll
            for (int e = 0; e < 8; ++e) { wu[k][e] = cw[k * 5632 + j0 + e]; wg[k][e] = cw[k * 5632 + 2816 + j0 + e]; }
#pragma unroll
        for (int e = 0; e < 8; ++e) { bu[e] = cb[j0 + e]; bg[e] = cb[2816 + j0 + e]; }
        float u1[8], u2[8], g1[8], g2[8];
        const int s0 = sg * SEGR;
#pragma unroll
        for (int e = 0; e < 8; ++e) { u1[e] = 0.f; u2[e] = 0.f; g1[e] = 0.f; g2[e] = 0.f; }
        if (s0 >= 2) { unpack8(*(const v4u*)(UP + (size_t)(s0 - 1) * 5632 + ucol), u1); unpack8(*(const v4u*)(UP + (size_t)(s0 - 2) * 5632 + ucol), u2);
                       unpack8(*(const v4u*)(UP + (size_t)(s0 - 1) * 5632 + gcol), g1); unpack8(*(const v4u*)(UP + (size_t)(s0 - 2) * 5632 + gcol), g2); }
#pragma unroll 4
        for (int s = s0; s < s0 + SEGR; ++s) { float u0[8], g0[8], o[8];
            unpack8(*(const v4u*)(UP + (size_t)s * 5632 + ucol), u0); unpack8(*(const v4u*)(UP + (size_t)s * 5632 + gcol), g0);
#pragma unroll
            for (int e = 0; e < 8; ++e) { const float cu = bu[e] + wu[2][e] * u0[e] + wu[1][e] * u1[e] + wu[0][e] * u2[e], cg = bg[e] + wg[2][e] * g0[e] + wg[1][e] * g1[e] + wg[0][e] * g2[e];
                o[e] = gelu_tanh(cg) * cu; u2[e] = u1[e]; u1[e] = u0[e]; g2[e] = g1[e]; g1[e] = g0[e]; }
            *(v4u*)(ACT + (size_t)s * DFF + j0) = pack8f(o); } }
}

constexpr int PH_PER_LAYER = 16, NPH = 2 + PH_PER_LAYER * DEPTH;
constexpr int BIGT = 1 << 30;

__global__ void __launch_bounds__(NWAVES * 64, 2) mk_fwd(Args args) {
    unsigned char* lds = g_lds;
    LAS unsigned char* L3 = (LAS unsigned char*)lds;
    const int wave0 = __builtin_amdgcn_readfirstlane((int)threadIdx.x >> 6);
    const int lo = args.ph_lo, hi = args.ph_hi;
    for (int u = threadIdx.x; u < (LDS_BYTES - 131072) / 4; u += NWAVES * 64) ((LAS unsigned*)(L3 + 131072))[u] = 0u;
    __syncthreads();
    if (threadIdx.x < 31) ((LAS unsigned long long*)(L3 + ARGS_LDS_OFF))[threadIdx.x] = ((const unsigned long long*)&args)[threadIdx.x];
    __syncthreads();
    if (hi - lo > 1) (void)xcd_barrier_post((unsigned*)(wsptr(args) + WS_CTL) + 1024, (volatile LAS unsigned*)(L3 + MISC_OFF) + 8);
#ifndef PHMASK
#define PHMASK 0xFFFFFFFFu
#endif
#define PHON(j) ((PHMASK >> (2 + (j))) & 1u)
#define CTX Ctx X; int bx; LAS unsigned char* L3p; unsigned char* ldsp; \
        { int ln_; asm volatile("v_mbcnt_lo_u32_b32 %0, -1, 0\n\tv_mbcnt_hi_u32_b32 %0, -1, %0" : "=v"(ln_)); \
          const int w_ = opaque_u(wave0), g_ = opaque_u((int)gridDim.x), b_ = opaque_u((int)blockIdx.x), lz_ = opaque_u(0); \
          X.tid = w_ * 64 + ln_; X.lane = ln_; X.wave = w_; X.G = g_; bx = b_; X.vcu = (g_ % 8 == 0) ? (b_ % 8) * (g_ / 8) + b_ / 8 : b_; L3p = L3 + lz_; ldsp = lds + lz_; } \
        unsigned char* ws = wsptr(args); (void)bx; (void)L3p; (void)ldsp; (void)ws;
#define WPTR(off) ((const bf16*)(ws + WS_W + (off)))
#pragma unroll 1
    for (int ph = lo; ph < hi; ++ph) {
        const int j = ph < 2 ? ph - 2 : ((ph - 2) & 15), l = ph < 2 ? 0 : ((ph - 2) >> 4);

        if (j == -2 && PHON(-2)) { CTX p_mods(X, L3p, args); __syncthreads(); p_rope(X, args); convert_mixer(X, L3p, args, 0); }
        else if (j == -1 && PHON(-1)) { CTX const float* MOD = (const float*)(ws + WS_MOD);
            row_pass<0, true>(X, (const float*)inptr(args, I_X), nullptr, nullptr, nullptr, nullptr, (const float*)inptr(args, I_MIXPRE), MOD, MOD + 1024, (bf16*)(ws + WS_XN)); }
        else if (j == 0 && PHON(0)) { CTX
            pg8::Gemm g{(const bf16*)(ws + WS_XN), WPTR(WO_IN), M, 3840, 1024, 1024}; pg8::StaticOrder S; S.init(M, 3840, X.G, bx);
            typedef pg8::EpiRoute<0, WS_TL, 1024, 4, WS_TR, 2048, 12, WS_TM, 768> E_t; E_t E{&args};
            pg8::gemm_phase<E_t, pg8::StaticOrder, true, true>(L3p, g, S, E, X.tid);
        }
        else if (j == 1 && PHON(1)) { CTX lru_phase<1>(X, ldsp, args, l); __syncthreads(); ret_phase<1>(X, ldsp, args); p_mla_rstd(X, args); }
        else if (j == 2 && PHON(2)) { CTX lru_prefix(X, args); ret_prefix(X, args); }
        else if (j == 3 && PHON(3)) { CTX lru_phase<2>(X, ldsp, args, l); __syncthreads(); ret_phase<2>(X, ldsp, args); }
        else if (j == 4 && PHON(4)) {
            { CTX p_krope(X, args); }
            { CTX pg8::Gemm g{(const bf16*)(ws + WS_TM), WPTR(WO_UQ), M, 768, 384, 768}; pg8::StaticOrder S; S.init(M, 768, X.G, bx);
              pg8::EpiQ E{&args}; pg8::gemm_phase<pg8::EpiQ, pg8::StaticOrder, true, true>(L3p, g, S, E, X.tid); }
            { CTX pg8::Gemm g{(const bf16*)(ws + WS_TM) + 384, WPTR(WO_UKV), M, 1024, 256, 768}; pg8::StaticOrder S; S.init(M, 1024, X.G, bx);
              pg8::EpiKV E{&args}; pg8::gemm_phase<pg8::EpiKV, pg8::StaticOrder, true, true>(L3p, g, S, E, X.tid); }
        }
        else if (j == 5 && PHON(5)) { CTX
            const bf16* Qb = (const bf16*)(ws + WS_Q); const bf16* Kb = (const bf16*)(ws + WS_K); const bf16* Vb = (const bf16*)(ws + WS_V); bf16* YB = (bf16*)(ws + WS_YB);
            att::Seam S;
            for (int L = X.vcu; L < 256; L += X.G) {
                const int bh = L >> 4, xq = L & 15, b = bh >> 3, h = bh & 7, qb0 = xq, qb1 = 31 - xq;
                const bf16* Kh = Kb + (size_t)b * SEQ * 768 + h * 96; const bf16* Vh = Vb + (size_t)b * SEQ * 512 + h * 64;
                att::BlockRef r0{Qb + ((size_t)b * SEQ + qb0 * 256) * 768 + h * 96, Kh, Vh, YB + ((size_t)b * SEQ + qb0 * 256) * 1536 + 1024 + h * 64, qb0 * 256};
                att::BlockRef r1{Qb + ((size_t)b * SEQ + qb1 * 256) * 768 + h * 96, Kh, Vh, YB + ((size_t)b * SEQ + qb1 * 256) * 1536 + 1024 + h * 64, qb1 * 256};
                att::attn_prime(r0, (char*)ldsp, S, X.tid);
                att::attn_block(r0, r1, (char*)ldsp, S, X.tid);
                att::attn_block(r1, r1, (char*)ldsp, S, X.tid);
                asm volatile("s_waitcnt vmcnt(0)" ::: "memory"); __syncthreads();
            }
        }
        else if (j == 6 && PHON(6)) { CTX
            pg8::Gemm g{(const bf16*)(ws + WS_XN), WPTR(WO_G), M, 3072, 1024, 1024}; pg8::StaticOrder S; S.init(M, 3072, X.G, bx);
            typedef pg8::EpiRoute<2, WS_G, 3072, BIGT, 0, 0, BIGT, 0, 0> E_t; E_t E{&args};
            pg8::gemm_phase<E_t, pg8::StaticOrder, true, true>(L3p, g, S, E, X.tid);
        }
        else if (j == 7 && PHON(7)) { CTX
#pragma unroll 1
            for (int b = 0; b < 3; ++b) {
              pg8::Gemm g{(const bf16*)(ws + WS_YB) + 512 * b, WPTR(WO_O3) + (size_t)b * 1024 * 512, M, 1024, 512, 1536}; pg8::StaticOrder S; S.init(M, 1024, X.G, bx);
              pg8::EpiMerge E{&args, b}; pg8::gemm_phase<pg8::EpiMerge, pg8::StaticOrder, true, true>(L3p, g, S, E, X.tid);
              asm volatile("s_waitcnt vmcnt(0)" ::: "memory"); __syncthreads();
              __builtin_amdgcn_fence(__ATOMIC_ACQUIRE, "agent"); asm volatile("s_waitcnt vmcnt(0)" ::: "memory"); }
        }
        else if (j == 8 && PHON(8)) { CTX
            pg8::Gemm g{(const bf16*)(ws + WS_XN), WPTR(WO_OUT), M, 1024, 1024, 1024}; pg8::StaticOrder S; S.init(M, 1024, X.G, bx);
            pg8::EpiF32<WS_Y> E{&args}; pg8::gemm_phase<pg8::EpiF32<WS_Y>, pg8::StaticOrder, true, true>(L3p, g, S, E, X.tid);
        }
        else if (j == 9 && PHON(9)) { CTX float* out = outptr(args); const float* MODl = (const float*)(ws + WS_MOD) + (size_t)l * NB * 6144;
            row_pass<1, true>(X, l == 0 ? (const float*)inptr(args, I_X) : (const float*)out, out, (const float*)(ws + WS_Y), (const float*)inptr(args, I_MIXPOST) + l * 1024, MODl + 2048,
                              (const float*)inptr(args, I_FPRE) + l * 1024, MODl + 3072, MODl + 4096, (bf16*)(ws + WS_XN));
            convert_ffn(X, L3p, args, l);
        }
        else if ((j == 10 || j == 12) && PHON(10)) { CTX const int hb = (j - 10) >> 1;
            pg8::Gemm g{(const bf16*)(ws + WS_XN) + (size_t)hb * SEQ * 1024, WPTR(WO_UP), SEQ, 5632, 1024, 1024}; pg8::StaticOrder S; S.init(SEQ, 5632, X.G, bx);
            typedef pg8::EpiRoute<0, WS_UPH, 5632, BIGT, 0, 0, BIGT, 0, 0> E_t; E_t E{&args};
            pg8::gemm_phase<E_t, pg8::StaticOrder, true, true>(L3p, g, S, E, X.tid);
        }
        else if ((j == 11 || j == 13) && PHON(11)) { CTX act_pass(X, args, l, (j - 11) >> 1); }
        else if (j == 14 && PHON(14)) { CTX
            pg8::Gemm g{(const bf16*)(ws + WS_ACT), WPTR(WO_DOWN), M, 1024, 2816, 2816}; pg8::StaticOrder S; S.init(M, 1024, X.G, bx);
            pg8::EpiF32<WS_Y2> E{&args}; pg8::gemm_phase<pg8::EpiF32<WS_Y2>, pg8::StaticOrder, true, true>(L3p, g, S, E, X.tid);
        }
        else if (j == 15 && PHON(15)) { CTX float* out = outptr(args); const float* MOD = (const float*)(ws + WS_MOD); const float* MODl = MOD + (size_t)l * NB * 6144;
            if (l + 1 < DEPTH) {
                const float* MODn = MOD + (size_t)(l + 1) * NB * 6144;
                row_pass<1, true>(X, (const float*)out, out, (const float*)(ws + WS_Y2), (const float*)inptr(args, I_FPOST) + l * 1024, MODl + 5120,
                                  (const float*)inptr(args, I_MIXPRE) + (l + 1) * 1024, MODn, MODn + 1024, (bf16*)(ws + WS_XN));
                convert_mixer(X, L3p, args, l + 1);
            } else {
                row_pass<1, false>(X, (const float*)out, out, (const float*)(ws + WS_Y2), (const float*)inptr(args, I_FPOST) + l * 1024, MODl + 5120, nullptr, nullptr, nullptr, nullptr);
            }
        }
        if (ph + 1 < hi) {
            if (ph == lo) { cg::this_grid().sync(); }
            else { unsigned char* ws = wsptr(args); const int lz_ = opaque_u(0); XcdBarrier bar; bar.bar = (unsigned*)(ws + WS_CTL) + 1024; bar.x = xb_xcc_id(); bar.st = (volatile LAS unsigned*)(L3 + lz_ + MISC_OFF) + 8; xcd_barrier(bar); }
        }
    }
#undef PHON
#undef WPTR
#undef CTX
}


#ifdef DBG_K
__global__ void dbg_dump(const unsigned char* ws, float* out) {
    const bf16* buf = (const bf16*)(ws + (size_t)DBG_OFF);
    for (size_t i = (size_t)blockIdx.x * blockDim.x + threadIdx.x; i < (size_t)M * 1024; i += (size_t)gridDim.x * blockDim.x) {
        const size_t r = i >> 10; const int c = (int)(i & 1023);
        out[i] = c < DBG_NC ? __uint_as_float((unsigned)buf[r * DBG_LD + DBG_COL0 + c] << 16) : 0.f; }
}
#endif
extern "C" void kernel_launch(void* const* d_in, const int* in_sizes, int n_in, void* d_out, int out_size, void* d_ws, size_t ws_size, hipStream_t stream) {
    static int grid = 0;
    if (grid == 0) {
        if (n_in != 29 || in_sizes[0] != M * DM || out_size != M * DM || ws_size < WS_END) { fprintf(stderr, "kernel_launch: unexpected shapes (n_in %d, in0 %d, out %d, ws %zu)\n", n_in, n_in > 0 ? in_sizes[0] : -1, out_size, ws_size); grid = -1; return; }
        int dev = 0, cus = 0, per_cu = 0;
        if (hipGetDevice(&dev) != hipSuccess || hipDeviceGetAttribute(&cus, hipDeviceAttributeMultiprocessorCount, dev) != hipSuccess) { grid = -1; return; }
        if (hipFuncSetAttribute((const void*)mk_fwd, hipFuncAttributeMaxDynamicSharedMemorySize, LDS_BYTES) != hipSuccess) { fprintf(stderr, "kernel_launch: hipFuncSetAttribute failed\n"); grid = -1; return; }
        if (hipOccupancyMaxActiveBlocksPerMultiprocessor(&per_cu, (const void*)mk_fwd, NWAVES * 64, LDS_BYTES) != hipSuccess || per_cu < 1) { fprintf(stderr, "kernel_launch: occupancy query says %d blocks per CU\n", per_cu); per_cu = 1; }
        (void)hipGetLastError();
        grid = cus;
    }
    if (grid < 0) return;
    (void)hipMemsetAsync((char*)d_ws + WS_CTL, 0, CTL_ZERO_BYTES, stream);
    Args a{};
    for (int i = 0; i < 29; ++i) a.in[i] = d_in[i];
    a.out = (float*)d_out; a.ws = (unsigned char*)d_ws;
#if MK_ONE_LAUNCH
    a.ph_lo = 0; a.ph_hi = NPH;
    void* params[] = {&a};
    hipError_t e = hipLaunchCooperativeKernel((const void*)mk_fwd, dim3(grid), dim3(NWAVES * 64), params, LDS_BYTES, stream);
    if (e != hipSuccess) fprintf(stderr, "kernel_launch: cooperative launch failed: %s (grid %d)\n", hipGetErrorString(e), grid);
#else
#ifdef DBG_K
    for (int k = 0; k < DBG_K; ++k) { a.ph_lo = k; a.ph_hi = k + 1; hipLaunchKernelGGL(mk_fwd, dim3(grid), dim3(NWAVES * 64), LDS_BYTES, stream, a); }
    hipLaunchKernelGGL(dbg_dump, dim3(2048), dim3(256), 0, stream, (const unsigned char*)d_ws, (float*)d_out);
#else
    for (int k = 0; k < NPH; ++k) { a.ph_lo = k; a.ph_hi = k + 1; hipLaunchKernelGGL(mk_fwd, dim3(grid), dim3(NWAVES * 64), LDS_BYTES, stream, a); }
#endif
#endif
}
```

```cpp
#include <hip/hip_runtime.h>
#include <hip/hip_bf16.h>
#include <hip/hip_cooperative_groups.h>
#include <cstdio>
#include <cstdint>
namespace cg = cooperative_groups;

#ifndef MK_ONE_LAUNCH
#define MK_ONE_LAUNCH 1
#endif

constexpr int DM = 1024, NB = 2, SEQ = 8192, M = NB * SEQ, DEPTH = 2;
constexpr int LRU_W = 512, RET_H = 8, MLA_H = 8, QRANK = 384, KVRANK = 256, DFF = 2816;
constexpr int NIN = 6816;
constexpr float EPS = 1e-6f;

constexpr size_t MiB = 1u << 20;
constexpr size_t WS_CTL = 0, CTL_ZERO_BYTES = 64 * 1024;
constexpr size_t WS_MOD = 1 * MiB;
constexpr size_t WS_RSTD = WS_MOD + 128 * 1024;
constexpr size_t WS_LSA = WS_RSTD + 128 * 1024;
constexpr size_t WS_LSH = WS_LSA + 256 * 1024;
constexpr size_t WS_LC = WS_LSH + 256 * 1024;
constexpr size_t WS_ROPE = 3 * MiB;
constexpr size_t WS_W = 10 * MiB;
constexpr size_t WS_XN = 30 * MiB;
constexpr size_t WS_YB = 62 * MiB;
constexpr size_t WS_RS = 110 * MiB;
constexpr size_t WS_BIG = 126 * MiB;
constexpr size_t WS_TL = WS_BIG, WS_TR = WS_BIG + 32 * MiB, WS_TM = WS_BIG + 96 * MiB;
constexpr size_t WS_Q = WS_BIG, WS_K = WS_BIG + 24 * MiB, WS_V = WS_BIG + 48 * MiB;
constexpr size_t WS_G = WS_BIG, WS_Y = WS_BIG;
constexpr size_t WS_UPH = 62 * MiB, WS_ACT = 150 * MiB, WS_Y2 = 62 * MiB;
constexpr size_t WS_END = 256 * MiB;
constexpr size_t WO_IN = 0, WO_G = WO_IN + (size_t)3840 * 1024 * 2, WO_OUT = WO_G + (size_t)3072 * 1024 * 2, WO_O3 = WO_OUT + (size_t)1024 * 1024 * 2,
                 WO_UQ = WO_O3 + (size_t)3 * 1024 * 512 * 2, WO_UKV = WO_UQ + (size_t)768 * 384 * 2, WO_AT = WO_UKV + (size_t)1024 * 256 * 2, WO_XT = WO_AT + 65536, WO_MIX_END = WO_XT + 65536;
constexpr size_t WO_UP = 0, WO_DOWN = (size_t)5632 * 1024 * 2, WO_FFN_END = WO_DOWN + (size_t)1024 * 2816 * 2;
static_assert(WO_MIX_END <= 20 * MiB && WO_FFN_END <= 20 * MiB, "weight region");
static_assert(WS_ACT + (size_t)M * DFF * 2 <= WS_END && WS_UPH + (size_t)8192 * 5632 * 2 <= WS_ACT, "ffn map");

constexpr int LDS_BYTES = 147456;
constexpr int MISC_OFF = 131072 + 320;
constexpr int NWAVES = 8;

typedef float f32x16 __attribute__((ext_vector_type(16)));
typedef unsigned u32x2 __attribute__((ext_vector_type(2)));
typedef float f32x2 __attribute__((ext_vector_type(2)));

__device__ const double INVR[32] = {1.0, 0.7498942093324559, 0.5623413251903491, 0.4216965034285822, 0.31622776601683794, 0.23713737056616552, 0.1778279410038923, 0.1333521432163324, 0.1, 0.07498942093324558, 0.05623413251903491, 0.042169650342858224, 0.03162277660168379, 0.023713737056616554, 0.01778279410038923, 0.01333521432163324, 0.01, 0.007498942093324558, 0.005623413251903491, 0.004216965034285823, 0.0031622776601683794, 0.0023713737056616554, 0.0017782794100389228, 0.001333521432163324, 0.001, 0.0007498942093324559, 0.0005623413251903491, 0.00042169650342858224, 0.00031622776601683794, 0.00023713737056616554, 0.00017782794100389227, 0.0001333521432163324};
__device__ const float LG2G[8] = {-0.04580368961312479f, -0.02272007650008353f, -0.011315313227834146f, -0.005646563141142063f, -0.0028205190623786626f, -0.0014095702546713536f, -0.0007046129765893727f, -0.0003522634716290214f};

struct Ctx { int tid, lane, wave, G, vcu; };
struct Args { const void* in[29]; float* out; unsigned char* ws; int ph_lo, ph_hi; };
enum { I_X = 0, I_C, I_POS, I_ADAW, I_ADAB, I_MIXPRE, I_MIXPOST, I_WIN, I_LCW, I_LCB, I_LWA, I_LBA, I_LWX, I_LBX, I_LLAM, I_LWO, I_RWO, I_QNG, I_WUQ, I_KVNG, I_WUKV, I_MWO, I_WOUT,
       I_FPRE, I_FPOST, I_WUP, I_FCW, I_FCB, I_WDOWN };


#define GAS __attribute__((address_space(1)))
#define LAS __attribute__((address_space(3)))
extern __shared__ __attribute__((aligned(16))) unsigned char g_lds[];
constexpr int ARGS_LDS_OFF = 131072 + 1024;
__device__ __forceinline__ int opaque_u(int v) { int t; asm volatile("v_mov_b32 %0, %1" : "=v"(t) : "s"(v)); return __builtin_amdgcn_readfirstlane(t); }
__device__ __forceinline__ unsigned long long lds_arg(int idx) {
    const int z = opaque_u(0);
    volatile LAS unsigned* p = (volatile LAS unsigned*)((LAS unsigned char*)g_lds + z + ARGS_LDS_OFF) + 2 * idx;
    const unsigned lo = p[0], hi = p[1];
    return ((unsigned long long)(unsigned)__builtin_amdgcn_readfirstlane((int)hi) << 32) | (unsigned)__builtin_amdgcn_readfirstlane((int)lo);
}
__device__ __forceinline__ const void* inptr(const Args&, int i) { return (const void*)(GAS const void*)lds_arg(i); }
__device__ __forceinline__ unsigned char* wsptr(const Args&) { return (unsigned char*)(GAS unsigned char*)lds_arg(30); }
__device__ __forceinline__ float* outptr(const Args&) { return (float*)(GAS float*)lds_arg(29); }

namespace pg8 {
#define PG8_LAS __attribute__((address_space(3)))
typedef unsigned short bf16_t;
typedef short bf16x8 __attribute__((ext_vector_type(8)));
typedef float f32x4 __attribute__((ext_vector_type(4)));
typedef unsigned u32x4 __attribute__((ext_vector_type(4)));
typedef unsigned u32x2 __attribute__((ext_vector_type(2)));
constexpr int BM = 256, BK = 64, HALF = 128, HTB = HALF * BK * 2, STAGE_BYTES = 8 * HTB, NXCD = 8, WGM = 8;

__host__ __device__ __forceinline__ int lds_byte(int r, int c) { const int st = (r >> 4) * 2 + (c >> 5), rr = r & 15, cc = c & 31, ob = rr * 64 + cc * 2; return st * 1024 + (ob ^ (((ob >> 9) & 1) << 5)); }
__host__ __device__ __forceinline__ void stage_rc(int b, int& R, int& C) { const int st = b / 1024, sb = b % 1024, swz = sb ^ (((sb >> 9) & 1) << 5); R = (st >> 1) * 16 + swz / 64; C = (st & 1) * 32 + (swz % 64) / 2; }
__host__ __device__ __forceinline__ int perm32(int rho) { const int n = rho >> 4, i = rho & 15; return 8 * (i >> 2) + 4 * n + (i & 3); }

struct Unit { int pm, pn, ao; };
struct Gemm { const bf16_t* A; const bf16_t* Bt; int M, N, K, lda; };

struct StaticOrder {
    int nM, nN, nwg, G, c;
    __host__ __device__ void init(int M_, int N_, int G_, int c_) { nM = M_ / BM; nN = N_ / BM; nwg = nM * nN; G = G_; c = c_; }
    __host__ __device__ bool next(int i, Unit& u) const {
        const long L = (long)i * G + c; if (L >= nwg) return false;
        int wgid = (int)L; { const int q = nwg / NXCD, r = nwg % NXCD, xcd = wgid % NXCD, off = wgid / NXCD; wgid = (xcd < r ? xcd * (q + 1) : r * (q + 1) + (xcd - r) * q) + off; }
        const int nig = WGM * nN, gid = wgid / nig, fm = gid * WGM, gsz = (nM - fm) < WGM ? (nM - fm) : WGM;
        u.pm = fm + ((wgid % nig) % gsz); u.pn = (wgid % nig) / gsz; u.ao = 0; return true;
    }
    __device__ __forceinline__ void a_ready(const Unit&) const {}
    __device__ __forceinline__ void done(const Unit&) const {}
};


struct GateOrder {
    StaticOrder base;
    __host__ __device__ void init(int M_, int G_, int c_) { base.init(M_, 1024, G_, c_); }
    __host__ __device__ bool next(int i, Unit& u) const { if (i >= 3) return false; Unit t; if (!base.next(0, t)) return false; u.pm = t.pm; u.pn = t.pn + 4 * i; u.ao = 0; return true; }
    __device__ __forceinline__ void a_ready(const Unit&) const {}
    __device__ __forceinline__ void done(const Unit&) const {}
};
struct MergeOrder {
    StaticOrder base;
    __host__ __device__ void init(int M_, int G_, int c_) { base.init(M_, 1024, G_, c_); }
    __host__ __device__ bool next(int i, Unit& u) const { if (i >= 3) return false; Unit t; if (!base.next(0, t)) return false; u.pm = t.pm; u.pn = t.pn + 4 * i; u.ao = i * 1024; return true; }
    __device__ __forceinline__ void a_ready(const Unit&) const {}
    __device__ __forceinline__ void done(const Unit&) const {}
};
typedef float f32x2_t __attribute__((ext_vector_type(2))); typedef __bf16 bf16x2_t __attribute__((ext_vector_type(2)));
__device__ __forceinline__ unsigned cvt_pk_bf16(float lo, float hi) { f32x2_t v = {lo, hi}; bf16x2_t b = __builtin_convertvector(v, bf16x2_t); return __builtin_bit_cast(unsigned, b); }
__device__ __forceinline__ float bf_lo(unsigned w) { return __uint_as_float(w << 16); }
__device__ __forceinline__ float bf_hi(unsigned w) { return __uint_as_float(w & 0xffff0000u); }
__device__ __forceinline__ float sigmoidf_(float x) { return __builtin_amdgcn_rcpf(1.0f + __builtin_amdgcn_exp2f(-1.4426950408889634f * x)); }


template <int ACT, size_t O0, int LD0, int T1, size_t O1, int LD1, int T2, size_t O2, int LD2> struct EpiRoute {
    static constexpr bool PERM = true, AFTER_DRAIN = false;
    const Args* a;
    __device__ __forceinline__ void operator()(const f32x4 (&acc)[2][2][4][2], const Unit& u, int wr, int wc, int fr_, int fq_) const {
        (void)fr_; (void)fq_; int ln_; asm volatile("v_mbcnt_lo_u32_b32 %0, -1, 0\n\tv_mbcnt_hi_u32_b32 %0, -1, %0" : "=v"(ln_)); const int fr = ln_ & 15, fq = ln_ >> 4;
        unsigned char* ws = wsptr(*a);
        bf16_t* base; int ld, ct;
        if (u.pn < T1) { base = (bf16_t*)(ws + O0); ld = LD0; ct = u.pn; } else if (u.pn < T2) { base = (bf16_t*)(ws + O1); ld = LD1; ct = u.pn - T1; } else { base = (bf16_t*)(ws + O2); ld = LD2; ct = u.pn - T2; }
        int row0 = u.pm * BM + wr * 64 + fr, col0 = ct * BM + wc * 32 + 8 * fq; asm volatile("" : "+v"(row0), "+v"(col0));
#pragma unroll
        for (int ai = 0; ai < 2; ++ai)
#pragma unroll
            for (int m = 0; m < 4; ++m) { bf16_t* rowp = base + (size_t)(row0 + ai * HALF + m * 16) * ld + col0;
#pragma unroll
                for (int bj = 0; bj < 2; ++bj) { f32x4 v0 = acc[ai][bj][m][0], v1 = acc[ai][bj][m][1];
                    if (ACT == 2) {
#pragma unroll
                        for (int e = 0; e < 4; ++e) { v0[e] = sigmoidf_(v0[e]); v1[e] = sigmoidf_(v1[e]); } }
                    u32x4 w; w.x = cvt_pk_bf16(v0[0], v0[1]); w.y = cvt_pk_bf16(v0[2], v0[3]); w.z = cvt_pk_bf16(v1[0], v1[1]); w.w = cvt_pk_bf16(v1[2], v1[3]);
                    *(u32x4*)(rowp + bj * HALF) = w; } }
    }
};
struct EpiQ {
    static constexpr bool PERM = true, AFTER_DRAIN = false;
    const Args* a;
    __device__ __forceinline__ void operator()(const f32x4 (&acc)[2][2][4][2], const Unit& u, int wr, int wc, int fr_, int fq_) const {
        (void)fr_; (void)fq_; int ln_; asm volatile("v_mbcnt_lo_u32_b32 %0, -1, 0\n\tv_mbcnt_hi_u32_b32 %0, -1, %0" : "=v"(ln_)); const int fr = ln_ & 15, fq = ln_ >> 4;
        unsigned char* ws = wsptr(*a);
        const char* Qc = (const char*)(ws + WS_Q); const char* rstd = (const char*)(ws + WS_RSTD); const char* cosm = (const char*)(ws + WS_ROPE) + (size_t)M * 64 * 4; const char* sinm = cosm + (size_t)M * 16 * 4;
        int row0 = u.pm * BM + wr * 64 + fr, fq4 = fq; asm volatile("" : "+v"(row0), "+v"(fq4));
        const int g32 = u.pn * 8 + wc;
#pragma unroll
        for (int ai = 0; ai < 2; ++ai)
#pragma unroll
            for (int m = 0; m < 4; ++m) { const unsigned row = (unsigned)(row0 + ai * HALF + m * 16); const float rs = *(const float*)(rstd + row * 4u);
#pragma unroll
                for (int bj = 0; bj < 2; ++bj) { const int g = g32 + 4 * bj;
                    f32x4 v0 = acc[ai][bj][m][0] * rs, v1 = acc[ai][bj][m][1] * rs;
                    if ((g % 3) == 2) { const f32x4 cs = *(const f32x4*)(cosm + row * 64u + (unsigned)fq4 * 16u), sn = *(const f32x4*)(sinm + row * 64u + (unsigned)fq4 * 16u);
                        f32x4 p, b; p[0] = v0[0] * cs[0] - v0[1] * sn[0]; p[1] = v0[0] * sn[0] + v0[1] * cs[0]; p[2] = v0[2] * cs[1] - v0[3] * sn[1]; p[3] = v0[2] * sn[1] + v0[3] * cs[1];
                        b[0] = v1[0] * cs[2] - v1[1] * sn[2]; b[1] = v1[0] * sn[2] + v1[1] * cs[2]; b[2] = v1[2] * cs[3] - v1[3] * sn[3]; b[3] = v1[2] * sn[3] + v1[3] * cs[3]; v0 = p; v1 = b; }
                    u32x4 w; w.x = cvt_pk_bf16(v0[0], v0[1]); w.y = cvt_pk_bf16(v0[2], v0[3]); w.z = cvt_pk_bf16(v1[0], v1[1]); w.w = cvt_pk_bf16(v1[2], v1[3]);
                    *(u32x4*)(Qc + row * 1536u + (unsigned)(g * 64 + fq4 * 16)) = w; }
                asm volatile("" ::: "memory"); }
    }
};
struct EpiKV {
    static constexpr bool PERM = true, AFTER_DRAIN = false;
    const Args* a;
    __device__ __forceinline__ void operator()(const f32x4 (&acc)[2][2][4][2], const Unit& u, int wr, int wc, int fr_, int fq_) const {
        (void)fr_; (void)fq_; int ln_; asm volatile("v_mbcnt_lo_u32_b32 %0, -1, 0\n\tv_mbcnt_hi_u32_b32 %0, -1, %0" : "=v"(ln_)); const int fr = ln_ & 15, fq = ln_ >> 4;
        unsigned char* ws = wsptr(*a);
        bf16_t* Kp = (bf16_t*)(ws + WS_K); bf16_t* Vp = (bf16_t*)(ws + WS_V); const float* rstd = (const float*)(ws + WS_RSTD) + M;
        int row0 = u.pm * BM + wr * 64 + fr, col0 = u.pn * BM + wc * 32 + 8 * fq; asm volatile("" : "+v"(row0), "+v"(col0));
#pragma unroll
        for (int ai = 0; ai < 2; ++ai)
#pragma unroll
            for (int m = 0; m < 4; ++m) { const int row = row0 + ai * HALF + m * 16; const float rs = rstd[row];
#pragma unroll
                for (int bj = 0; bj < 2; ++bj) { const int c = col0 + bj * HALF, h = c >> 7, w = c & 127;
                    const f32x4 v0 = acc[ai][bj][m][0] * rs, v1 = acc[ai][bj][m][1] * rs;
                    u32x4 o; o.x = cvt_pk_bf16(v0[0], v0[1]); o.y = cvt_pk_bf16(v0[2], v0[3]); o.z = cvt_pk_bf16(v1[0], v1[1]); o.w = cvt_pk_bf16(v1[2], v1[3]);
                    bf16_t* dst = (w < 64) ? (Kp + (size_t)row * 768 + h * 96 + w) : (Vp + (size_t)row * 512 + h * 64 + (w - 64));
                    *(u32x4*)dst = o; }
                asm volatile("" ::: "memory"); }
    }
};
struct EpiMerge {
    static constexpr bool PERM = true, AFTER_DRAIN = false;
    const Args* a;
    __device__ __forceinline__ void operator()(const f32x4 (&acc)[2][2][4][2], const Unit& u, int wr, int wc, int fr_, int fq_) const {
        (void)fr_; (void)fq_; int ln_; asm volatile("v_mbcnt_lo_u32_b32 %0, -1, 0\n\tv_mbcnt_hi_u32_b32 %0, -1, %0" : "=v"(ln_)); const int fr = ln_ & 15, fq = ln_ >> 4;
        unsigned char* ws = wsptr(*a);
        const int b = u.pn >> 2, pn = u.pn & 3;
        bf16_t* O = (bf16_t*)(ws + WS_XN); const bf16_t* Gt = (const bf16_t*)(ws + WS_G) + 1024 * b; const bool accum = b > 0;
        int row0 = u.pm * BM + wr * 64 + fr, col0 = pn * BM + wc * 32 + 8 * fq; asm volatile("" : "+v"(row0), "+v"(col0));
#pragma unroll
        for (int ai = 0; ai < 2; ++ai)
#pragma unroll
            for (int m = 0; m < 4; ++m) { const int row = row0 + ai * HALF + m * 16;
#pragma unroll
                for (int bj = 0; bj < 2; ++bj) { const int c = col0 + bj * HALF;
                    const u32x4 gw = *(const u32x4*)(Gt + (size_t)row * 3072 + c);
                    f32x4 v0 = acc[ai][bj][m][0], v1 = acc[ai][bj][m][1];
                    v0[0] *= bf_lo(gw.x); v0[1] *= bf_hi(gw.x); v0[2] *= bf_lo(gw.y); v0[3] *= bf_hi(gw.y); v1[0] *= bf_lo(gw.z); v1[1] *= bf_hi(gw.z); v1[2] *= bf_lo(gw.w); v1[3] *= bf_hi(gw.w);
                    if (accum) { unsigned long long* op = (unsigned long long*)(O + (size_t)row * 1024 + c);
                        const unsigned long long o01 = __hip_atomic_load(op, __ATOMIC_RELAXED, __HIP_MEMORY_SCOPE_AGENT), o23 = __hip_atomic_load(op + 1, __ATOMIC_RELAXED, __HIP_MEMORY_SCOPE_AGENT);
                        const unsigned ox = (unsigned)o01, oy = (unsigned)(o01 >> 32), oz = (unsigned)o23, ow = (unsigned)(o23 >> 32);
                        v0[0] += bf_lo(ox); v0[1] += bf_hi(ox); v0[2] += bf_lo(oy); v0[3] += bf_hi(oy); v1[0] += bf_lo(oz); v1[1] += bf_hi(oz); v1[2] += bf_lo(ow); v1[3] += bf_hi(ow); }
                    u32x4 o; o.x = cvt_pk_bf16(v0[0], v0[1]); o.y = cvt_pk_bf16(v0[2], v0[3]); o.z = cvt_pk_bf16(v1[0], v1[1]); o.w = cvt_pk_bf16(v1[2], v1[3]);
                    *(u32x4*)(O + (size_t)row * 1024 + c) = o; }
                asm volatile("" ::: "memory"); }
    }
};
template <size_t OFF> struct EpiF32 {
    static constexpr bool PERM = false, AFTER_DRAIN = false;
    const Args* a;
    __device__ __forceinline__ void operator()(const f32x4 (&acc)[2][2][4][2], const Unit& u, int wr, int wc, int fr_, int fq_) const {
        (void)fr_; (void)fq_; int ln_; asm volatile("v_mbcnt_lo_u32_b32 %0, -1, 0\n\tv_mbcnt_hi_u32_b32 %0, -1, %0" : "=v"(ln_)); const int fr = ln_ & 15, fq = ln_ >> 4;
        float* O = (float*)(wsptr(*a) + OFF);
        int row0 = u.pm * BM + wr * 64 + fr, col0 = u.pn * BM + wc * 32 + 4 * fq; asm volatile("" : "+v"(row0), "+v"(col0));
#pragma unroll
        for (int ai = 0; ai < 2; ++ai)
#pragma unroll
            for (int m = 0; m < 4; ++m) { float* rowp = O + (size_t)(row0 + ai * HALF + m * 16) * 1024 + col0;
#pragma unroll
                for (int bj = 0; bj < 2; ++bj)
#pragma unroll
                    for (int n = 0; n < 2; ++n) *(f32x4*)(rowp + bj * HALF + n * 16) = acc[ai][bj][m][n]; }
    }
};

template <class Epi, class Sched, bool ALIGN_EPI = false, bool SP2 = false>
__device__ __forceinline__ void gemm_phase(PG8_LAS unsigned char* lds, const Gemm g, const Sched& S, const Epi& E, int tid_in) {
    int tid_ = tid_in; asm volatile("" : "+v"(tid_));
    const int tid = tid_, wid = __builtin_amdgcn_readfirstlane(tid >> 6), lane = tid & 63, wr = wid >> 2, wc = wid & 3, fr = lane & 15, fq = lane >> 4;
    const int K = g.K, nt = K / BK;
    unsigned voffA[2], voffB[2];
#pragma unroll
    for (int i = 0; i < 2; ++i) { int R, C; stage_rc(tid * 16 + i * 8192, R, C); const int Rb = Epi::PERM ? ((R & ~31) + perm32(R & 31)) : R;
        voffA[i] = (unsigned)(R * g.lda + C) * 2u; voffB[i] = (unsigned)(Rb * K + C) * 2u; }
    const size_t kstep = (size_t)(BK * 2);
    const size_t hstepA = (size_t)HALF * g.lda * 2, hstepB = (size_t)HALF * K * 2;
    const size_t tstepA = 2 * hstepA, tstepB = 2 * hstepB;
    const unsigned ldsw = (unsigned)wid * 1024u;
    const int aoff = lds_byte(wr * 64 + fr, fq * 8), boff = lds_byte(wc * 32 + fr, fq * 8);
#define PG8_SA(b, h) (((b) * 2 + (h)) * HTB)
#define PG8_SB(b, h) ((4 + (b) * 2 + (h)) * HTB)
#define PG8_STAGE(bufoff, gbase, voff) do { _Pragma("unroll") for (int _i = 0; _i < 2; ++_i) \
        __builtin_amdgcn_global_load_lds((const unsigned*)((const char*)(gbase) + (voff)[_i]), (PG8_LAS unsigned*)(lds + (bufoff) + ldsw + _i * 8192), 16, 0, 0); } while (0)
#define PG8_LDA(dst, b, h) do { _Pragma("unroll") for (int m = 0; m < 4; ++m) _Pragma("unroll") for (int k = 0; k < 2; ++k) dst[m][k] = *(const PG8_LAS bf16x8*)(lds + PG8_SA(b, h) + aoff + m * 2048 + k * 1024); } while (0)
#define PG8_LDB(dst, b, h) do { _Pragma("unroll") for (int n = 0; n < 2; ++n) _Pragma("unroll") for (int k = 0; k < 2; ++k) dst[n][k] = *(const PG8_LAS bf16x8*)(lds + PG8_SB(b, h) + boff + n * 2048 + k * 1024); } while (0)
#define PG8_MMA(ai, bj, At, Bt) do { __builtin_amdgcn_s_setprio(1); _Pragma("unroll") for (int m = 0; m < 4; ++m) _Pragma("unroll") for (int n = 0; n < 2; ++n) _Pragma("unroll") for (int k = 0; k < 2; ++k) \
        acc[ai][bj][m][n] = __builtin_amdgcn_mfma_f32_16x16x32_bf16(Bt[n][k], At[m][k], acc[ai][bj][m][n], 0, 0, 0); __builtin_amdgcn_s_setprio(0); } while (0)
#define PG8_WAIT_V(n) asm volatile("s_waitcnt vmcnt(" #n ")" ::: "memory")
#define PG8_WAIT_L(n) asm volatile("s_waitcnt lgkmcnt(" #n ")" ::: "memory")
#define PG8_BAR __builtin_amdgcn_s_barrier()
#define PG8_SCHED __builtin_amdgcn_sched_barrier(0)
    Unit cur, nxt; int ui = 0;
    if (!S.next(0, cur)) return;
    f32x4 acc[2][2][4][2];
#pragma unroll
    for (int a = 0; a < 2; ++a)
#pragma unroll
        for (int b = 0; b < 2; ++b)
#pragma unroll
            for (int m = 0; m < 4; ++m)
#pragma unroll
                for (int n = 0; n < 2; ++n) acc[a][b][m][n] = (f32x4){0.f, 0.f, 0.f, 0.f};
    bf16x8 At[4][2], B0[2][2], B1[2][2];
    const char* cA = (const char*)g.A + (size_t)cur.pm * tstepA + cur.ao; const char* cB = (const char*)g.Bt + (size_t)cur.pn * tstepB;
    S.a_ready(cur);
    if constexpr (SP2) {
        PG8_STAGE(PG8_SB(0, 0), cB, voffB); PG8_STAGE(PG8_SB(0, 1), cB + hstepB, voffB); PG8_STAGE(PG8_SA(0, 0), cA, voffA); PG8_STAGE(PG8_SA(0, 1), cA + hstepA, voffA);
        if (wr == 1) PG8_BAR;
        PG8_WAIT_V(2); PG8_BAR;
        PG8_STAGE(PG8_SB(1, 0), cB + kstep, voffB); PG8_STAGE(PG8_SA(1, 0), cA + kstep, voffA); PG8_STAGE(PG8_SB(1, 1), cB + hstepB + kstep, voffB);
        PG8_WAIT_V(6); PG8_BAR;
    } else {
        PG8_STAGE(PG8_SB(0, 0), cB, voffB); PG8_STAGE(PG8_SA(0, 0), cA, voffA); PG8_STAGE(PG8_SB(0, 1), cB + hstepB, voffB); PG8_STAGE(PG8_SA(0, 1), cA + hstepA, voffA);
        if (wr == 1) PG8_BAR;
        PG8_WAIT_V(4); PG8_BAR;
        PG8_STAGE(PG8_SB(1, 0), cB + kstep, voffB); PG8_STAGE(PG8_SA(1, 0), cA + kstep, voffA); PG8_STAGE(PG8_SB(1, 1), cB + hstepB + kstep, voffB);
        PG8_WAIT_V(6); PG8_BAR;
    }
    for (;;) {
        const bool has_next = S.next(ui + 1, nxt);
        const char* nA = has_next ? (const char*)g.A + (size_t)nxt.pm * tstepA + nxt.ao : cA; const char* nB = has_next ? (const char*)g.Bt + (size_t)nxt.pn * tstepB : cB;
        for (int t = 0; t < nt; t += 2) {
            const bool last = (t == nt - 2);
            const char* a1 = cA + (size_t)(t + 1) * kstep;
            const char* a2 = last ? nA : cA + (size_t)(t + 2) * kstep; const char* b2 = last ? nB : cB + (size_t)(t + 2) * kstep;
            const char* a3 = a2 + kstep; const char* b3 = b2 + kstep;
            if (last && has_next) S.a_ready(nxt);
            if constexpr (SP2) {
            PG8_LDB(B0, 0, 0); PG8_LDB(B1, 0, 1); PG8_SCHED; PG8_LDA(At, 0, 0); PG8_STAGE(PG8_SA(1, 1), a1 + hstepA, voffA);
            PG8_WAIT_V(8); PG8_WAIT_L(0); PG8_BAR; PG8_MMA(0, 0, At, B0); PG8_MMA(0, 1, At, B1); PG8_BAR; PG8_SCHED;
            PG8_LDA(At, 0, 1); PG8_STAGE(PG8_SB(0, 0), b2, voffB); PG8_STAGE(PG8_SB(0, 1), b2 + hstepB, voffB); PG8_STAGE(PG8_SA(0, 0), a2, voffA);
            PG8_WAIT_V(8); PG8_WAIT_L(0); PG8_BAR; PG8_MMA(1, 0, At, B0); PG8_MMA(1, 1, At, B1); PG8_BAR; PG8_SCHED;
            PG8_LDB(B0, 1, 0); PG8_LDB(B1, 1, 1); PG8_SCHED; PG8_LDA(At, 1, 0); PG8_STAGE(PG8_SA(0, 1), a2 + hstepA, voffA);
            PG8_WAIT_V(8); PG8_WAIT_L(0); PG8_BAR; PG8_MMA(0, 0, At, B0); PG8_MMA(0, 1, At, B1); PG8_BAR; PG8_SCHED;
            PG8_LDA(At, 1, 1); PG8_STAGE(PG8_SB(1, 0), b3, voffB); PG8_STAGE(PG8_SB(1, 1), b3 + hstepB, voffB); PG8_STAGE(PG8_SA(1, 0), a3, voffA);
            PG8_WAIT_V(8); PG8_WAIT_L(0); PG8_BAR; PG8_MMA(1, 0, At, B0); PG8_MMA(1, 1, At, B1); PG8_BAR; PG8_SCHED;
            } else {
            PG8_LDB(B0, 0, 0); PG8_SCHED; PG8_LDA(At, 0, 0); PG8_STAGE(PG8_SA(1, 1), a1 + hstepA, voffA);
            PG8_WAIT_L(8); PG8_BAR; PG8_WAIT_L(0); PG8_MMA(0, 0, At, B0); PG8_BAR; PG8_SCHED;
            PG8_LDB(B1, 0, 1); PG8_STAGE(PG8_SB(0, 0), b2, voffB);
            PG8_BAR; PG8_WAIT_L(0); PG8_MMA(0, 1, At, B1); PG8_BAR;
            PG8_LDA(At, 0, 1); PG8_STAGE(PG8_SA(0, 0), a2, voffA);
            PG8_BAR; PG8_WAIT_L(0); PG8_MMA(1, 0, At, B0); PG8_BAR; PG8_SCHED;
            PG8_STAGE(PG8_SB(0, 1), b2 + hstepB, voffB);
            PG8_WAIT_V(6); PG8_BAR; PG8_MMA(1, 1, At, B1); PG8_BAR;
            PG8_LDB(B0, 1, 0); PG8_SCHED; PG8_LDA(At, 1, 0); PG8_STAGE(PG8_SA(0, 1), a2 + hstepA, voffA);
            PG8_WAIT_L(8); PG8_BAR; PG8_WAIT_L(0); PG8_MMA(0, 0, At, B0); PG8_BAR; PG8_SCHED;
            PG8_LDB(B1, 1, 1); PG8_STAGE(PG8_SB(1, 0), b3, voffB);
            PG8_BAR; PG8_WAIT_L(0); PG8_MMA(0, 1, At, B1); PG8_BAR;
            PG8_LDA(At, 1, 1); PG8_STAGE(PG8_SA(1, 0), a3, voffA);
            PG8_BAR; PG8_WAIT_L(0); PG8_MMA(1, 0, At, B0); PG8_BAR; PG8_SCHED;
            PG8_STAGE(PG8_SB(1, 1), b3 + hstepB, voffB);
            PG8_WAIT_V(6); PG8_BAR; PG8_MMA(1, 1, At, B1); PG8_BAR;
            }
        }
        if constexpr (ALIGN_EPI) { if (wr == 0) PG8_BAR; }
        if constexpr (!Epi::AFTER_DRAIN) { E(acc, cur, wr, wc, fr, fq); S.done(cur); }
        if (!has_next) break;
#pragma unroll
        for (int a = 0; a < 2; ++a)
#pragma unroll
            for (int b = 0; b < 2; ++b)
#pragma unroll
                for (int m = 0; m < 4; ++m)
#pragma unroll
                    for (int n = 0; n < 2; ++n) acc[a][b][m][n] = (f32x4){0.f, 0.f, 0.f, 0.f};
        cur = nxt; cA = nA; cB = nB; ++ui;
        if constexpr (ALIGN_EPI) { if (wr == 1) PG8_BAR; }
    }
    PG8_WAIT_V(0);
    if constexpr (!ALIGN_EPI) { if (wr == 0) PG8_BAR; }
    PG8_BAR;
    if constexpr (Epi::AFTER_DRAIN) { E.fused(acc, cur, wr, wc, fr, fq, lds, wid, lane); S.done(cur); }
#undef PG8_SA
#undef PG8_SB
#undef PG8_STAGE
#undef PG8_LDA
#undef PG8_LDB
#undef PG8_MMA
#undef PG8_WAIT_V
#undef PG8_WAIT_L
#undef PG8_BAR
#undef PG8_SCHED
}
}

#define GAS __attribute__((address_space(1)))
#define LAS __attribute__((address_space(3)))
typedef unsigned short bf16;
typedef unsigned v4u __attribute__((ext_vector_type(4)));
typedef float f32x4 __attribute__((ext_vector_type(4)));
typedef short bf16x8 __attribute__((ext_vector_type(8)));
typedef GAS unsigned gu32;
typedef GAS unsigned long long gu64;
#define RLX_AGENT __ATOMIC_RELAXED, __HIP_MEMORY_SCOPE_AGENT
#define LDS_WAIT() asm volatile("s_waitcnt lgkmcnt(0)" ::: "memory")
#define VM_WAIT() asm volatile("s_waitcnt vmcnt(0)" ::: "memory")
__device__ __forceinline__ unsigned long long rt() { return __builtin_amdgcn_s_memrealtime(); }
__device__ __forceinline__ unsigned f2bf(float f) { unsigned u = __builtin_bit_cast(unsigned, f); return (u + 0x7fffu + ((u >> 16) & 1u)) >> 16; }
__device__ __forceinline__ unsigned pk2(float lo, float hi) { return f2bf(lo) | (f2bf(hi) << 16); }

#define XB_TMO      128
#define XB_XCNT(j)  (256  + 64 * (j))
#define XB_XSUB(j)  (1280 + 64 * (j))
#define XB_XGEN(j)  (2304 + 64 * (j))
#define XB_TOP      3328
#define XB_TOPGEN   3392
#define XCD_BAR_WORDS 3456
#define XB_SPIN_CAP (1u << 18)

__device__ __forceinline__ unsigned xb_ld(unsigned* p)              { return __hip_atomic_load(p, __ATOMIC_RELAXED, __HIP_MEMORY_SCOPE_AGENT); }
__device__ __forceinline__ unsigned xb_add(unsigned* p, unsigned v) { return __hip_atomic_fetch_add(p, v, __ATOMIC_RELAXED, __HIP_MEMORY_SCOPE_AGENT); }
__device__ __forceinline__ unsigned xb_xcc_id() { return (unsigned)__builtin_amdgcn_s_getreg((3 << 11) | 20) & 0xFu; }
#define XB_SPIN(cond, bar) do { unsigned _sp = 0; while (cond) { __builtin_amdgcn_s_sleep(1); \
    if ((++_sp & 255u) == 0u) { if (xb_ld(&(bar)[XB_TMO])) break; if (_sp > XB_SPIN_CAP) { atomicAdd(&(bar)[XB_TMO], 1u); break; } } } } while (0)

struct XcdBarrier {
    unsigned* bar; unsigned x;
    volatile LAS unsigned* st;
};

__device__ __forceinline__ XcdBarrier xcd_barrier_post(unsigned* bar, volatile LAS unsigned* st) {
    XcdBarrier b; b.bar = bar; b.x = xb_xcc_id(); b.st = st;
    if (threadIdx.x == 0) (void)xb_add(&bar[XB_XCNT(b.x)], 1u);
    return b;
}
__device__ __forceinline__ void xcd_barrier_complete(unsigned* bar, unsigned x, unsigned& nloc, unsigned& nx) {
    const unsigned G = gridDim.x * gridDim.y * gridDim.z;
    unsigned sum, cnt, mine, sp = 0u;
    for (;;) {
        sum = 0u; cnt = 0u; mine = 0u;
#pragma unroll
        for (unsigned j = 0; j < 16; ++j) { const unsigned c = xb_ld(&bar[XB_XCNT(j)]); sum += c; cnt += (c > 0u) ? 1u : 0u; mine = (j == x) ? c : mine; }
        if (sum == G) break;
        __builtin_amdgcn_s_sleep(1);
        if ((++sp & 255u) == 0u) { if (xb_ld(&bar[XB_TMO])) break; if (sp > XB_SPIN_CAP) { atomicAdd(&bar[XB_TMO], 1u); break; } }
    }
    nloc = mine > 0u ? mine : 1u; nx = cnt > 0u ? cnt : 1u;
}

__device__ __forceinline__ void xcd_barrier(const XcdBarrier& b) {
    asm volatile("s_waitcnt vmcnt(0)" ::: "memory");
    __syncthreads();
    if (threadIdx.x == 0) {
        unsigned* bar = b.bar;
        __builtin_amdgcn_s_waitcnt(0);
        unsigned nloc = b.st[0], nx = b.st[1];
        if (nloc == 0u) { xcd_barrier_complete(bar, b.x, nloc, nx); b.st[0] = nloc; b.st[1] = nx; }
        const unsigned old = xb_add(&bar[XB_XSUB(b.x)], 1u);
        const unsigned gen = old / nloc;
        if (old + 1u == (gen + 1u) * nloc) {
            __builtin_amdgcn_fence(__ATOMIC_RELEASE, "agent");
            asm volatile("s_waitcnt vmcnt(0)" ::: "memory");
            const unsigned og = xb_add(&bar[XB_TOP], 1u);
            const unsigned tg = og / nx;
            if (og + 1u == (tg + 1u) * nx) xb_add(&bar[XB_TOPGEN], 1u);
            else XB_SPIN(xb_ld(&bar[XB_TOPGEN]) == tg, bar);
            __builtin_amdgcn_fence(__ATOMIC_ACQUIRE, "agent");
            xb_add(&bar[XB_XGEN(b.x)], 1u);
            asm volatile("s_waitcnt vmcnt(0)" ::: "memory");
        } else {
            XB_SPIN(xb_ld(&bar[XB_XGEN(b.x)]) == gen, bar);
            __builtin_amdgcn_fence(__ATOMIC_ACQUIRE, "agent");
            asm volatile("s_waitcnt vmcnt(0)" ::: "memory");
        }
    }
    __syncthreads();
}

namespace att {
using bf16 = unsigned short;
typedef short bf16x8 __attribute__((ext_vector_type(8)));
typedef short s16x4 __attribute__((ext_vector_type(4)));
typedef float f32x16 __attribute__((ext_vector_type(16)));
typedef float f32x4 __attribute__((ext_vector_type(4)));
typedef unsigned u32x4 __attribute__((ext_vector_type(4)));
constexpr int DQK = 96, DV = 64, NW = 8, QBLK = 32, KVBLK = 64, QB = NW * QBLK;
constexpr int QP = 768, KP = 768, VP = 512, OP = 1536;
constexpr int SHM_V = KVBLK * DV * 2  , SHM_K = KVBLK * 256  ;
constexpr int LDS_BYTES = 2 * SHM_V + 2 * SHM_K + NW * 64 * 4;
constexpr float SCALE = 0.10206207261596575f;
constexpr float THR = 8.f;
#define KSWZ(row, colB) ((row) * 256 + ((colB) ^ (((row) & 7) << 4)))
#define SBAR() __builtin_amdgcn_sched_barrier(0)
__device__ __forceinline__ int v_st(int k, int c) { const int kk = (k & ~0xC) | ((k & 4) << 1) | ((k & 8) >> 1); return ((kk >> 3) * 2 + (c >> 5)) * 512 + ((kk & 7) * 32 + (c & 31)) * 2; }
__device__ __forceinline__ int v_rd_base(int lane) { return ((lane & 3) << 3) | (((lane >> 2) & 3) << 6) | (((lane >> 4) & 1) << 5) | (((lane >> 5) & 1) << 8); }
__device__ __forceinline__ int crow(int r, int hi) { return (r & 3) + 8 * (r >> 2) + 4 * hi; }
typedef float f32x2_t __attribute__((ext_vector_type(2))); typedef __bf16 bf16x2_t __attribute__((ext_vector_type(2)));
__device__ __forceinline__ unsigned cvtpk(float lo, float hi) { f32x2_t v = {lo, hi}; bf16x2_t b = __builtin_convertvector(v, bf16x2_t); return __builtin_bit_cast(unsigned, b); }
__device__ __forceinline__ void mask_tile(f32x16& p0, f32x16& p1, int dq) {
    const float NEG = -__builtin_inff();
#pragma unroll
    for (int r = 0; r < 16; ++r) { const int c = (r & 3) + 8 * (r >> 2); if (dq - c < 0) p0[r] = NEG; if (dq - c - 32 < 0) p1[r] = NEG; }
}
__device__ __forceinline__ void partialSM(f32x16& p0, f32x16& p1, float& m_reg, float& mn, float& alpha) {
    float pmax = p0[0];
#pragma unroll
    for (int r = 1; r < 16; ++r) pmax = fmaxf(pmax, p0[r]);
#pragma unroll
    for (int r = 0; r < 16; ++r) pmax = fmaxf(pmax, p1[r]);
    { auto rr = __builtin_amdgcn_permlane32_swap(__float_as_uint(pmax), __float_as_uint(pmax), false, false);
      pmax = fmaxf(__uint_as_float(rr[0]), __uint_as_float(rr[1])); }
    constexpr float C2 = 1.4426950408889634f * SCALE;
    if (__builtin_expect(__all((pmax - m_reg) * SCALE <= THR), 1)) { mn = m_reg; alpha = 1.f; }
    else { mn = fmaxf(m_reg, pmax); alpha = __builtin_amdgcn_exp2f((m_reg - mn) * C2); m_reg = mn; }
    const float mnL = -mn * C2;
#pragma unroll
    for (int r = 0; r < 16; ++r) p0[r] = fmaf(p0[r], C2, mnL);
#pragma unroll
    for (int r = 0; r < 16; ++r) p1[r] = fmaf(p1[r], C2, mnL);
#pragma unroll
    for (int r = 0; r < 16; ++r) p0[r] = __builtin_amdgcn_exp2f(p0[r]);
}
__device__ __forceinline__ void finishSM(f32x16& p0, f32x16& p1, float alpha, float& l_reg, bf16x8& pa0, bf16x8& pa1, bf16x8& pa2, bf16x8& pa3) {
#pragma unroll
    for (int r = 0; r < 16; ++r) p1[r] = __builtin_amdgcn_exp2f(p1[r]);
    float ps = 0;
#pragma unroll
    for (int r = 0; r < 16; ++r) ps += p0[r];
#pragma unroll
    for (int r = 0; r < 16; ++r) ps += p1[r];
    { auto rr = __builtin_amdgcn_permlane32_swap(__float_as_uint(ps), __float_as_uint(ps), false, false);
      ps = __uint_as_float(rr[0]) + __uint_as_float(rr[1]); }
    l_reg = l_reg * alpha + ps;
#define PK4(P, B_, OUT) do { unsigned a0 = cvtpk(P[B_+0], P[B_+1]), a1 = cvtpk(P[B_+2], P[B_+3]);                          \
        unsigned b0 = cvtpk(P[B_+4], P[B_+5]), b1 = cvtpk(P[B_+6], P[B_+7]);                                             \
        auto r0 = __builtin_amdgcn_permlane32_swap(a0, b0, false, false); auto r1 = __builtin_amdgcn_permlane32_swap(a1, b1, false, false); \
        u32x4 w = {r0[0], r1[0], r0[1], r1[1]}; OUT = *reinterpret_cast<bf16x8*>(&w); } while (0)
    PK4(p0, 0, pa0); PK4(p0, 8, pa1); PK4(p1, 0, pa2); PK4(p1, 8, pa3);
#undef PK4
}
template <int KB>
__device__ __forceinline__ void qkt(f32x16& p0, f32x16& p1, const char* K_lds, int r32, int hi, const bf16x8* qr) {
    p0 = f32x16{}; p1 = f32x16{};
    const char* kb[4];
#pragma unroll
    for (int dd = 0; dd < 4; ++dd) kb[dd] = K_lds + KB * SHM_K + KSWZ(r32, (dd * 16 + hi * 8) * 2);
#pragma unroll
    for (int d0 = 0; d0 < 6; ++d0) { const char* a = kb[d0 & 3] + (d0 >> 2) * 128;
        bf16x8 b0 = *reinterpret_cast<const bf16x8*>(a);
        bf16x8 b1 = *reinterpret_cast<const bf16x8*>(a + 32 * 256);
        p0 = __builtin_amdgcn_mfma_f32_32x32x16_bf16(b0, qr[d0], p0, 0, 0, 0);
        p1 = __builtin_amdgcn_mfma_f32_32x32x16_bf16(b1, qr[d0], p1, 0, 0, 0); }
}
template <int VB>
__device__ __forceinline__ void pv_tile(f32x16* o, int vb0, bf16x8 pa0, bf16x8 pa1, bf16x8 pa2, bf16x8 pa3) {
#define TRRD(dst, off) asm volatile("ds_read_b64_tr_b16 %0, %1 offset:%2" : "=&v"(dst) : "v"(vb0), "i"(off) : "memory")
#define PV_D0(d0) do { s16x4 l0, l1, l2, l3, h0, h1, h2, h3; constexpr int b_ = VB * SHM_V + (d0) * 512;   \
        TRRD(l0, b_); TRRD(h0, b_ + 1024); TRRD(l1, b_ + 2048); TRRD(h1, b_ + 3072); TRRD(l2, b_ + 4096); TRRD(h2, b_ + 5120); TRRD(l3, b_ + 6144); TRRD(h3, b_ + 7168); \
        asm volatile("s_waitcnt lgkmcnt(0)" ::: "memory"); SBAR();   \
        o[d0] = __builtin_amdgcn_mfma_f32_32x32x16_bf16(pa0, (bf16x8){l0[0], l0[1], l0[2], l0[3], h0[0], h0[1], h0[2], h0[3]}, o[d0], 0, 0, 0);   \
        o[d0] = __builtin_amdgcn_mfma_f32_32x32x16_bf16(pa1, (bf16x8){l1[0], l1[1], l1[2], l1[3], h1[0], h1[1], h1[2], h1[3]}, o[d0], 0, 0, 0);   \
        o[d0] = __builtin_amdgcn_mfma_f32_32x32x16_bf16(pa2, (bf16x8){l2[0], l2[1], l2[2], l2[3], h2[0], h2[1], h2[2], h2[3]}, o[d0], 0, 0, 0);   \
        o[d0] = __builtin_amdgcn_mfma_f32_32x32x16_bf16(pa3, (bf16x8){l3[0], l3[1], l3[2], l3[3], h3[0], h3[1], h3[2], h3[3]}, o[d0], 0, 0, 0); } while (0)
    PV_D0(0); PV_D0(1);
#undef PV_D0
#undef TRRD
}
struct BlockRef { const bf16* Q; const bf16* K; const bf16* V; bf16* O; int P0; };
struct Seam { bf16x8 qr[6]; bf16x8 st_v, st_k0, st_k1; };
#define VMW() asm volatile("s_waitcnt vmcnt(0)" ::: "memory")
#define VMWN(n) asm volatile("s_waitcnt vmcnt(%0)" :: "i"(n) : "memory")
#define SLOAD(Kp_, Vp_, k0) do { S.st_v = *(const bf16x8*)((Vp_) + (size_t)((k0) + vr) * VP + vc);                                   \
        if (kact) { S.st_k0 = *(const bf16x8*)((Kp_) + (size_t)((k0) + sr) * KP + kc); S.st_k1 = *(const bf16x8*)((Kp_) + (size_t)((k0) + 32 + sr) * KP + kc); } } while (0)
#define SWRITE_K(bf) do { if (kact) { *(bf16x8*)(K_lds + (bf) * SHM_K + kws) = S.st_k0; *(bf16x8*)(K_lds + (bf) * SHM_K + kws + 32 * 256) = S.st_k1; } } while (0)
#define SWRITE_V(bf) do { *(bf16x8*)(V_lds + (bf) * SHM_V + vst) = S.st_v; } while (0)
#define STG_DECL const int sr = tid >> 4, kc = ((tid & 15) < 12 ? (tid & 15) : 11) * 8; const bool kact = true; const int kws = KSWZ(sr, kc * 2); \
        const int vr = tid >> 3, vc = (tid & 7) * 8, vst = v_st(vr, vc);
__device__ __forceinline__ void attn_prime(const BlockRef& cur, char* lds, Seam& S, int tid_in) {
    int tid_ = tid_in; asm volatile("" : "+v"(tid_)); const int tid = tid_, wid = __builtin_amdgcn_readfirstlane(tid >> 6), lane = tid & 63, r32 = lane & 31, hi = lane >> 5;
    STG_DECL; (void)vst; char* K_lds = lds + 2 * SHM_V;
#pragma unroll
    for (int d0 = 0; d0 < 6; ++d0) S.qr[d0] = *(const bf16x8*)(cur.Q + (size_t)(wid * QBLK + r32) * QP + d0 * 16 + hi * 8);
    SLOAD(cur.K, cur.V, 0); VMW(); SWRITE_K(0);
    __syncthreads();
}
__device__ __forceinline__ void attn_block(const BlockRef& cur, const BlockRef& nxt, char* lds, Seam& S, int tid_in) {
    int tid_ = tid_in; asm volatile("" : "+v"(tid_)); const int tid = tid_, wid = __builtin_amdgcn_readfirstlane(tid >> 6), lane = tid & 63, r32 = lane & 31, hi = lane >> 5;
    const int NT = (cur.P0 + QB) / KVBLK;
    const int qlo = cur.P0 + wid * QBLK, qm = qlo + r32 - 4 * hi;
    char* V_lds = lds; char* K_lds = lds + 2 * SHM_V;
    float* ws = (float*)(lds + 2 * SHM_V + 2 * SHM_K) + wid * 64; float* li_l = ws, * al_l = ws + 32;
    float m_reg = -1e30f, l_reg = 0; f32x16 o[2] = {};
    STG_DECL;
    const int vb0 = (int)(uintptr_t)V_lds + v_rd_base(lane);
    const bf16* Kh = cur.K; const bf16* Vh = cur.V;
#define RESC(a) do { if (__any((a) < 1.f)) { if (hi == 0) al_l[r32] = (a); asm volatile("s_waitcnt lgkmcnt(0)" ::: "memory");              \
                     _Pragma("unroll") for (int d_ = 0; d_ < 2; ++d_) _Pragma("unroll") for (int r = 0; r < 16; ++r) o[d_][r] *= al_l[crow(r, hi)]; } } while (0)
#define KBASE(t) ((t) * KVBLK)
#define MASKT(P0_, P1_, t) do { const int kb_ = KBASE(t); if (kb_ + KVBLK - 1 > qlo) mask_tile(P0_, P1_, qm - kb_); } while (0)
    constexpr int NQL = 6;
#define SEAM_K0() do { VMWN(NQL); SWRITE_K(0); SBAR(); } while (0)
    f32x16 pA0, pA1, pB0, pB1; float mnA, mnB, alA, alB; bf16x8 pa0, pa1, pa2, pa3;
    SWRITE_V(0); SBAR();
    if (NT > 1) { SLOAD(Kh, Vh, KBASE(1)); }
    SBAR(); qkt<0>(pA0, pA1, K_lds, r32, hi, S.qr);
    MASKT(pA0, pA1, 0); partialSM(pA0, pA1, m_reg, mnA, alA);
    if (NT > 1) { VMW(); SWRITE_V(1); SWRITE_K(1); }
    __syncthreads();
#define HALF_STEP(PX0, PX1, mnX, alX, PY0, PY1, alY, t, KB, VB, SB) do {                                                      \
        SBAR(); qkt<KB>(PX0, PX1, K_lds, r32, hi, S.qr);                                                                      \
        finishSM(PY0, PY1, alY, l_reg, pa0, pa1, pa2, pa3); SBAR();                                                           \
        if ((t) + 1 < NT) { SLOAD(Kh, Vh, KBASE((t) + 1)); SBAR(); }                                                          \
        pv_tile<VB>(o, vb0, pa0, pa1, pa2, pa3); MASKT(PX0, PX1, (t)); partialSM(PX0, PX1, m_reg, mnX, alX);                  \
        __syncthreads();                                                                                                      \
        if ((t) + 1 < NT) { VMW(); SWRITE_V(SB); SWRITE_K(SB); }                                                              \
        RESC(alX); __syncthreads(); } while (0)
    for (int t = 1; t + 1 < NT; t += 2) {
        HALF_STEP(pB0, pB1, mnB, alB, pA0, pA1, alA, t, 1, 0, 0);
        HALF_STEP(pA0, pA1, mnA, alA, pB0, pB1, alB, t + 1, 0, 1, 1);
    }
    SBAR(); qkt<1>(pB0, pB1, K_lds, r32, hi, S.qr); SBAR();
    SLOAD(nxt.K, nxt.V, 0); SBAR();
#pragma unroll
    for (int d0 = 0; d0 < 6; ++d0) S.qr[d0] = *(const bf16x8*)(nxt.Q + (size_t)(wid * QBLK + r32) * QP + d0 * 16 + hi * 8);
    SBAR();
    finishSM(pA0, pA1, alA, l_reg, pa0, pa1, pa2, pa3); SBAR();
    pv_tile<0>(o, vb0, pa0, pa1, pa2, pa3);
    MASKT(pB0, pB1, NT - 1); partialSM(pB0, pB1, m_reg, mnB, alB); __syncthreads(); RESC(alB);
    finishSM(pB0, pB1, alB, l_reg, pa0, pa1, pa2, pa3); SBAR(); pv_tile<1>(o, vb0, pa0, pa1, pa2, pa3);
    SBAR(); SEAM_K0();
    if (hi == 0) li_l[r32] = l_reg; asm volatile("s_waitcnt lgkmcnt(0)" ::: "memory");
    float rli[16];
#pragma unroll
    for (int r = 0; r < 16; ++r) rli[r] = __builtin_amdgcn_rcpf(li_l[crow(r, hi)]);
    bf16* Ow = cur.O + (size_t)(wid * QBLK) * OP;
#pragma unroll
    for (int r = 0; r < 16; ++r) { const int orow = crow(r, hi);
#pragma unroll
        for (int d0 = 0; d0 < 2; ++d0) { const float v = o[d0][r] * rli[r];
            const float vn = __int_as_float(__builtin_amdgcn_mov_dpp(__float_as_int(v), 0xB1, 0xf, 0xf, true));
            if ((r32 & 1) == 0) *(unsigned*)(Ow + (size_t)orow * OP + d0 * 32 + r32) = cvtpk(v, vn); } }
    __syncthreads();
#undef RESC
#undef KBASE
#undef MASKT
#undef SEAM_K0
#undef HALF_STEP
}
#undef VMW
#undef VMWN
#undef SLOAD
#undef SWRITE_K
#undef SWRITE_V
#undef STG_DECL
#undef SBAR
}


template <int O> __device__ __forceinline__ float swz_xor(float v) { return __int_as_float(__builtin_amdgcn_ds_swizzle(__float_as_int(v), (O << 10) | 0x1f)); }
__device__ __forceinline__ float half_sum(float v) { auto rr = __builtin_amdgcn_permlane32_swap(__float_as_uint(v), __float_as_uint(v), false, false); return __uint_as_float(rr[0]) + __uint_as_float(rr[1]); }
__device__ __forceinline__ float wave_sum(float v) {
    v += swz_xor<1>(v); v += swz_xor<2>(v); v += swz_xor<4>(v); v += swz_xor<8>(v); v += swz_xor<16>(v);
    return half_sum(v);
}
__device__ __forceinline__ float bf2f(bf16 h) { return __uint_as_float((unsigned)h << 16); }
__device__ __forceinline__ float gelu_tanh(float x) { const float z = 1.5957691216057308f * (x + 0.044715f * x * x * x); return x * __builtin_amdgcn_rcpf(1.0f + __builtin_amdgcn_exp2f(-1.4426950408889634f * z)); }
__device__ __forceinline__ float sigm(float x) { return __builtin_amdgcn_rcpf(1.0f + __builtin_amdgcn_exp2f(-1.4426950408889634f * x)); }
__device__ __forceinline__ void unpack8(const v4u w, float* f) { f[0] = __uint_as_float(w.x << 16); f[1] = __uint_as_float(w.x & 0xffff0000u); f[2] = __uint_as_float(w.y << 16); f[3] = __uint_as_float(w.y & 0xffff0000u);
    f[4] = __uint_as_float(w.z << 16); f[5] = __uint_as_float(w.z & 0xffff0000u); f[6] = __uint_as_float(w.w << 16); f[7] = __uint_as_float(w.w & 0xffff0000u); }
__device__ __forceinline__ v4u pack8f(const float* f) { v4u o; o.x = pk2(f[0], f[1]); o.y = pk2(f[2], f[3]); o.z = pk2(f[4], f[5]); o.w = pk2(f[6], f[7]); return o; }

__device__ __forceinline__ int il2(int i, int half) { return i < half ? 2 * i : 2 * (i - half) + 1; }
__device__ __forceinline__ int dstrow(int kind, int s) {
    if (kind == 0) return s;
    if (kind == 1) {
        if (s < 1024) return s;
        if (s < 2048) { const int base = s < 1536 ? 1024 : 1536, w = s - base; return base + (w & ~63) + il2(w & 63, 32); }
        if (s < 3712) return s;
        if (s < 3744) return 3712 + il2(s - 3712, 16);
        return 3840 + (s - 3744);
    }
    if (kind == 3) { const int hd = s / 96, w = s - hd * 96; return w < 64 ? s : hd * 96 + 64 + il2(w - 64, 16); }
    { const int t = s < 2816 ? s : s - 2816; return (t >> 7) * 256 + (t & 127) + (s < 2816 ? 0 : 128); }
}
__device__ __forceinline__ void conv_item(const float* W, int K, int Nsrc, bf16* WT, int kind, const float* ksc, LAS float* scr, int item, int nblk, int lane) {
    const int kb = item / nblk, nb = item - kb * nblk, k0 = 64 * kb, s0 = 32 * nb;
    const int j4 = (lane & 7) * 4, kr = lane >> 3;
#pragma unroll
    for (int i = 0; i < 8; ++i) { const int kk = 8 * i + kr; f32x4 v = *(const f32x4*)(W + (size_t)(k0 + kk) * Nsrc + s0 + j4); if (ksc) v = v * ksc[k0 + kk];
        scr[kk * 33 + j4] = v.x; scr[kk * 33 + j4 + 1] = v.y; scr[kk * 33 + j4 + 2] = v.z; scr[kk * 33 + j4 + 3] = v.w; }
    LDS_WAIT(); asm volatile("" ::: "memory");
    const int c = lane & 7;
#pragma unroll
    for (int j = 0; j < 4; ++j) { const int n = (lane >> 3) + 8 * j; const LAS float* s = scr + (8 * c) * 33 + n;
        v4u o; o.x = pk2(s[0 * 33], s[1 * 33]); o.y = pk2(s[2 * 33], s[3 * 33]); o.z = pk2(s[4 * 33], s[5 * 33]); o.w = pk2(s[6 * 33], s[7 * 33]);
        *(GAS v4u*)(WT + (size_t)dstrow(kind, s0 + n) * K + k0 + 8 * c) = o; }
    LDS_WAIT(); asm volatile("" ::: "memory");
}
__device__ __forceinline__ int conv_matrix(const Ctx& X, LAS unsigned char* lds, int base, const float* W, int K, int Nsrc, bf16* WT, int kind, const float* ksc) {
    LAS float* scr = (LAS float*)(lds + X.wave * 16384);
    const int gw = X.vcu * NWAVES + X.wave, NGW = X.G * NWAVES, nblk = Nsrc / 32, nitems = (K / 64) * nblk;
    int first = (gw - base) % NGW; if (first < 0) first += NGW;
    for (int it = first; it < nitems; it += NGW) conv_item(W, K, Nsrc, WT, kind, ksc, scr, it, nblk, X.lane);
    return base + nitems;
}
__device__ __forceinline__ void convert_mixer(const Ctx& X, LAS unsigned char* lds, const Args& a, int l) {
    bf16* Wb = (bf16*)(wsptr(a) + WS_W); int base = 0;
    base = conv_matrix(X, lds, base, (const float*)inptr(a, I_WIN) + (size_t)l * 1024 * NIN, 1024, NIN, (bf16*)((char*)Wb + WO_IN), 1, nullptr);
    base = conv_matrix(X, lds, base, (const float*)inptr(a, I_WOUT) + (size_t)l * 1024 * 1024, 1024, 1024, (bf16*)((char*)Wb + WO_OUT), 0, nullptr);
    base = conv_matrix(X, lds, base, (const float*)inptr(a, I_LWO) + (size_t)l * 512 * 1024, 512, 1024, (bf16*)((char*)Wb + WO_O3), 0, nullptr);
    base = conv_matrix(X, lds, base, (const float*)inptr(a, I_RWO) + (size_t)l * 512 * 1024, 512, 1024, (bf16*)((char*)Wb + WO_O3) + 1024 * 512, 0, nullptr);
    base = conv_matrix(X, lds, base, (const float*)inptr(a, I_MWO) + (size_t)l * 512 * 1024, 512, 1024, (bf16*)((char*)Wb + WO_O3) + 2 * 1024 * 512, 0, nullptr);
    base = conv_matrix(X, lds, base, (const float*)inptr(a, I_WUQ) + (size_t)l * 384 * 768, 384, 768, (bf16*)((char*)Wb + WO_UQ), 3, (const float*)inptr(a, I_QNG) + l * 384);
    base = conv_matrix(X, lds, base, (const float*)inptr(a, I_WUKV) + (size_t)l * 256 * 1024, 256, 1024, (bf16*)((char*)Wb + WO_UKV), 0, (const float*)inptr(a, I_KVNG) + l * 256);
#pragma unroll 1
    for (int blk = 0; blk < 8; ++blk) {
        base = conv_matrix(X, lds, base, (const float*)inptr(a, I_LWA) + (size_t)(l * 8 + blk) * 4096, 64, 64, (bf16*)((char*)Wb + WO_AT) + blk * 4096, 0, nullptr);
        base = conv_matrix(X, lds, base, (const float*)inptr(a, I_LWX) + (size_t)(l * 8 + blk) * 4096, 64, 64, (bf16*)((char*)Wb + WO_XT) + blk * 4096, 0, nullptr);
    }
    { const int gt = X.vcu * 512 + X.tid, nth = X.G * 512; const unsigned zz = (unsigned)opaque_u(0); v4u z; z.x = zz; z.y = zz; z.z = zz; z.w = zz;
      for (int i = gt; i < 96 * 128; i += nth) *(GAS v4u*)((bf16*)((char*)Wb + WO_IN) + (size_t)3744 * 1024 + (size_t)i * 8) = z; }
}
__device__ __forceinline__ void convert_ffn(const Ctx& X, LAS unsigned char* lds, const Args& a, int l) {
    bf16* Wb = (bf16*)(wsptr(a) + WS_W); int base = 0;
    base = conv_matrix(X, lds, base, (const float*)inptr(a, I_WUP) + (size_t)l * 1024 * 5632, 1024, 5632, (bf16*)((char*)Wb + WO_UP), 4, nullptr);
    base = conv_matrix(X, lds, base, (const float*)inptr(a, I_WDOWN) + (size_t)l * 2816 * 1024, 2816, 1024, (bf16*)((char*)Wb + WO_DOWN), 0, nullptr);
}

__device__ __forceinline__ void p_mods(const Ctx& X, LAS unsigned char* lds, const Args& a) {
    LAS float* cact = (LAS float*)lds; LAS float* red = (LAS float*)(lds + 8192);
    const float* c = (const float*)inptr(a, I_C);
    for (int i = X.tid; i < NB * 1024; i += 512) { const float v = c[i]; cact[i] = v * sigm(v); }
    __syncthreads();
    float* MOD = (float*)(wsptr(a) + WS_MOD);
    const float* adaw = (const float*)inptr(a, I_ADAW); const float* adab = (const float*)inptr(a, I_ADAB);
    for (int it = X.vcu; it < DEPTH * 96; it += X.G) {
        const int l = it / 96, j0 = (it - l * 96) * 64, cl = X.tid & 63, ks = X.tid >> 6;
        const float* w = adaw + (size_t)l * 1024 * 6144 + j0 + cl;
        float a0 = 0.f, a1 = 0.f;
#pragma unroll 8
        for (int k = ks * 128; k < ks * 128 + 128; ++k) { const float wv = w[(size_t)k * 6144]; a0 += cact[k] * wv; a1 += cact[1024 + k] * wv; }
        red[(ks * 64 + cl) * 2] = a0; red[(ks * 64 + cl) * 2 + 1] = a1;
        __syncthreads();
        if (X.tid < 128) { const int cc = X.tid & 63, b = X.tid >> 6; float s = 0.f;
#pragma unroll
            for (int q = 0; q < 8; ++q) s += red[(q * 64 + cc) * 2 + b];
            MOD[(size_t)(l * NB + b) * 6144 + j0 + cc] = s + adab[l * 6144 + j0 + cc]; }
        __syncthreads();
    }
}
__device__ __forceinline__ void p_rope(const Ctx& X, const Args& a) {
    float* cr = (float*)(wsptr(a) + WS_ROPE); float* sr = cr + (size_t)M * 32; float* cm = sr + (size_t)M * 32; float* sm = cm + (size_t)M * 16;
    const int* pos = (const int*)inptr(a, I_POS);
    const int nth = X.G * 512;
    for (int idx = X.vcu * 512 + X.tid; idx < M * 32; idx += nth) {
        const int row = idx >> 5, i = idx & 31;
        const double ang = (double)pos[row] * INVR[i];
        const double k = __builtin_rint(ang * 0.15915494309189535);
        double r = __builtin_fma(-k, 6.283185307179586, ang); r = __builtin_fma(-k, 2.4492935982947064e-16, r);
        const float rf = (float)r; const float sn = sinf(rf), cs = cosf(rf);
        cr[idx] = cs; sr[idx] = sn;
        if ((i & 1) == 0) { cm[row * 16 + (i >> 1)] = cs; sm[row * 16 + (i >> 1)] = sn; }
    }
}

template <int MODE, bool HAS_NEXT>
__device__ __forceinline__ void row_pass(const Ctx& X, const float* xin, float* xout, const float* Y, const float* gpost, const float* gate  ,
                                         const float* gpre, const float* shift, const float* scale, bf16* XN) {
    const int gw = X.vcu * NWAVES + X.wave, NGW = X.G * NWAVES, lane = X.lane;
    for (int b = 0; b < NB; ++b) {
        f32x4 vgp[4], vgt[4], vpre[4], vsh[4], vsc[4];
#pragma unroll
        for (int j = 0; j < 4; ++j) { const int cidx = 4 * lane + 256 * j;
            if (MODE == 1) { vgp[j] = *(const f32x4*)(gpost + cidx); vgt[j] = *(const f32x4*)(gate + (size_t)b * 6144 + cidx); }
            if (MODE == 0 || HAS_NEXT) { vpre[j] = *(const f32x4*)(gpre + cidx); vsh[j] = *(const f32x4*)(shift + (size_t)b * 6144 + cidx); vsc[j] = *(const f32x4*)(scale + (size_t)b * 6144 + cidx) + 1.0f; } }
        for (int m = gw; m < SEQ; m += NGW) { const size_t row = (size_t)b * SEQ + m;
            f32x4 xv[4];
#pragma unroll
            for (int j = 0; j < 4; ++j) xv[j] = *(const f32x4*)(xin + row * 1024 + 4 * lane + 256 * j);
            if (MODE == 1) { f32x4 yv[4]; float s = 0.f;
#pragma unroll
                for (int j = 0; j < 4; ++j) { yv[j] = *(const f32x4*)(Y + row * 1024 + 4 * lane + 256 * j); s += (yv[j].x * yv[j].x + yv[j].y * yv[j].y) + (yv[j].z * yv[j].z + yv[j].w * yv[j].w); }
                const float rs = __builtin_amdgcn_rsqf(wave_sum(s) * (1.0f / 1024.0f) + EPS);
#pragma unroll
                for (int j = 0; j < 4; ++j) { xv[j] = xv[j] + vgt[j] * (yv[j] * rs * vgp[j]); *(f32x4*)(xout + row * 1024 + 4 * lane + 256 * j) = xv[j]; } }
            if (MODE == 0 || HAS_NEXT) { float s = 0.f;
#pragma unroll
                for (int j = 0; j < 4; ++j) s += (xv[j].x * xv[j].x + xv[j].y * xv[j].y) + (xv[j].z * xv[j].z + xv[j].w * xv[j].w);
                const float rs = __builtin_amdgcn_rsqf(wave_sum(s) * (1.0f / 1024.0f) + EPS);
#pragma unroll
                for (int j = 0; j < 4; ++j) { const f32x4 h = (xv[j] * rs * vpre[j]) * vsc[j] + vsh[j];
                    u32x2 w; w.x = pk2(h.x, h.y); w.y = pk2(h.z, h.w); *(u32x2*)(XN + row * 1024 + 4 * lane + 256 * j) = w; } }
        }
    }
}

__device__ __forceinline__ void p_mla_rstd(const Ctx& X, const Args& a) {
    const bf16* TM = (const bf16*)(wsptr(a) + WS_TM); float* RSTD = (float*)(wsptr(a) + WS_RSTD);
    const int gw = X.vcu * NWAVES + X.wave, NGW = X.G * NWAVES, lane = X.lane;
    for (int m0 = gw * 4; m0 < M; m0 += NGW * 4) {
        u32x2 w[4][3];
#pragma unroll
        for (int r = 0; r < 4; ++r)
#pragma unroll
            for (int k = 0; k < 3; ++k) w[r][k] = *(const u32x2*)(TM + (size_t)(m0 + r) * 768 + k * 256 + lane * 4);
#pragma unroll
        for (int r = 0; r < 4; ++r) { float sq = 0.f, skv = 0.f;
#pragma unroll
            for (int k = 0; k < 3; ++k) { const float f0 = __uint_as_float(w[r][k].x << 16), f1 = __uint_as_float(w[r][k].x & 0xffff0000u), f2 = __uint_as_float(w[r][k].y << 16), f3 = __uint_as_float(w[r][k].y & 0xffff0000u);
                const float s = (f0 * f0 + f1 * f1) + (f2 * f2 + f3 * f3);
                if (k == 0) sq += s; else if (k == 1) { if (lane < 32) sq += s; else skv += s; } else { if (lane < 32) skv += s; } }
            sq = wave_sum(sq); skv = wave_sum(skv);
            if (lane == 0) { RSTD[m0 + r] = __builtin_amdgcn_rsqf(sq * (1.0f / 384.0f) + EPS); RSTD[M + m0 + r] = __builtin_amdgcn_rsqf(skv * (1.0f / 256.0f) + EPS); } }
    }
}
__device__ __forceinline__ void p_krope(const Ctx& X, const Args& a) {
    const bf16* TM = (const bf16*)(wsptr(a) + WS_TM); bf16* Kp = (bf16*)(wsptr(a) + WS_K);
    const float* cm = (const float*)(wsptr(a) + WS_ROPE) + (size_t)M * 64; const float* sm = cm + (size_t)M * 16;
    const int nth = X.G * 512;
    for (int idx = X.vcu * 512 + X.tid; idx < M * 4; idx += nth) { const int row = idx >> 2, cc = idx & 3;
        const v4u w = *(const v4u*)(TM + (size_t)row * 768 + 640 + cc * 8); float f[8]; unpack8(w, f);
        const f32x4 cs = *(const f32x4*)(cm + (size_t)row * 16 + cc * 4), sn = *(const f32x4*)(sm + (size_t)row * 16 + cc * 4);
        float o[8];
#pragma unroll
        for (int p = 0; p < 4; ++p) { o[2 * p] = f[2 * p] * cs[p] - f[2 * p + 1] * sn[p]; o[2 * p + 1] = f[2 * p] * sn[p] + f[2 * p + 1] * cs[p]; }
        const v4u ow = pack8f(o);
#pragma unroll
        for (int h = 0; h < 8; ++h) *(v4u*)(Kp + (size_t)row * 768 + h * 96 + 64 + cc * 8) = ow; }
}

__device__ __forceinline__ float log1p_small(float e) { return e < 0.03f ? e * (1.0f + e * (-0.5f + e * (0.33333334f + e * (-0.25f + e * 0.2f)))) : 0.6931471805599453f * __builtin_amdgcn_logf(1.0f + e); }
__device__ __forceinline__ float softplus_neg(float x) { const float z = -x, e = __builtin_amdgcn_exp2f(-1.4426950408889634f * __builtin_fabsf(z)); return __builtin_fmaxf(z, 0.0f) + log1p_small(e); }
__device__ __forceinline__ float neg_expm1(float y) { return y > -0.1f ? -y * (1.0f + y * (0.5f + y * (0.16666667f + y * (0.041666668f + y * 0.008333334f)))) : 1.0f - __builtin_amdgcn_exp2f(1.4426950408889634f * y); }
constexpr int LRU_XS = 0, LRU_XC = 33792, LRU_XCB = LRU_XC + 32768, LRU_SEG = LRU_XCB + 18432, LRU_GS = LRU_SEG + 4096, LRU_END = LRU_GS + 16384;
static_assert(LRU_END <= 131072, "lru lds");
template <int PASS>
__device__ __forceinline__ void lru_phase(const Ctx& X, unsigned char* ldsg, const Args& a, int l) {
    float* XS = (float*)(ldsg + LRU_XS); float* XC = (float*)(ldsg + LRU_XC); bf16* XCB = (bf16*)(ldsg + LRU_XCB); float* AA = (float*)(ldsg + LRU_XS); float* SEG = (float*)(ldsg + LRU_SEG); bf16* GS = (bf16*)(ldsg + LRU_GS);
    const bf16* TL = (const bf16*)(wsptr(a) + WS_TL); bf16* YB = (bf16*)(wsptr(a) + WS_YB);
    const bf16* WaT = (const bf16*)(wsptr(a) + WS_W + WO_AT); const bf16* WxT = (const bf16*)(wsptr(a) + WS_W + WO_XT);
    float* LSA = (float*)(wsptr(a) + WS_LSA); float* LSH = (float*)(wsptr(a) + WS_LSH); const float* LC = (const float*)(wsptr(a) + WS_LC);
    const float* cw = (const float*)inptr(a, I_LCW) + l * 4 * 512; const float* cbv = (const float*)inptr(a, I_LCB) + l * 512;
    const float* ba = (const float*)inptr(a, I_LBA) + l * 512; const float* bx = (const float*)inptr(a, I_LBX) + l * 512; const float* lam = (const float*)inptr(a, I_LLAM) + l * 512;
    const int tid = X.tid, lane = X.lane, wave = X.wave, r32 = lane & 31, hi = lane >> 5;
    constexpr int NU = NB * 64 * 8;
    v4u px0, px1, px2, pg0, pg1;
#define LRU_ISSUE(u_) do { const int blk_ = (u_) & 7, n_ = ((u_) >> 3) & 63, b_ = (u_) >> 9; const v4u z_ = {0u, 0u, 0u, 0u}; \
        { const int c_ = tid, r_ = c_ >> 3, cc_ = (c_ & 7) * 8, s_ = n_ * 128 + r_ - 3; px0 = z_; if (s_ >= 0) px0 = *(const v4u*)(TL + ((size_t)b_ * SEQ + s_) * 1024 + blk_ * 64 + cc_); } \
        { const int c_ = tid + 512, r_ = c_ >> 3, cc_ = (c_ & 7) * 8, s_ = n_ * 128 + r_ - 3; px1 = z_; if (s_ >= 0) px1 = *(const v4u*)(TL + ((size_t)b_ * SEQ + s_) * 1024 + blk_ * 64 + cc_); } \
        { const int c_ = tid + 1024, r_ = c_ >> 3, cc_ = (c_ & 7) * 8, s_ = n_ * 128 + r_ - 3; px2 = z_; if (c_ < 131 * 8 && s_ >= 0) px2 = *(const v4u*)(TL + ((size_t)b_ * SEQ + s_) * 1024 + blk_ * 64 + cc_); } \
        if (PASS == 2) { const size_t row0_ = (size_t)b_ * SEQ + n_ * 128; \
          pg0 = *(const v4u*)(TL + (row0_ + (tid >> 3)) * 1024 + 512 + blk_ * 64 + (tid & 7) * 8); pg1 = *(const v4u*)(TL + (row0_ + 64 + (tid >> 3)) * 1024 + 512 + blk_ * 64 + (tid & 7) * 8); } } while (0)
    int u = X.vcu;
    if (u < NU) LRU_ISSUE(u);
    for (; u < NU; u += X.G) {
        const int blk = u & 7, n = (u >> 3) & 63, b = u >> 9, ch0 = blk * 64; const size_t row0 = (size_t)b * SEQ + n * 128;
        { float f[8]; unpack8(px0, f); { const int c = tid, r = c >> 3, cc = (c & 7) * 8;
#pragma unroll
            for (int e = 0; e < 8; ++e) XS[r * 64 + cc + e] = f[e]; }
          unpack8(px1, f); { const int c = tid + 512, r = c >> 3, cc = (c & 7) * 8;
#pragma unroll
            for (int e = 0; e < 8; ++e) XS[r * 64 + cc + e] = f[e]; }
          if (tid + 1024 < 131 * 8) { unpack8(px2, f); const int c = tid + 1024, r = c >> 3, cc = (c & 7) * 8;
#pragma unroll
            for (int e = 0; e < 8; ++e) XS[r * 64 + cc + e] = f[e]; }
          if (PASS == 2) { *(v4u*)(GS + (tid >> 3) * 64 + (tid & 7) * 8) = pg0; *(v4u*)(GS + (64 + (tid >> 3)) * 64 + (tid & 7) * 8) = pg1; } }
        __syncthreads();
        { const int c = tid & 63, rg = tid >> 6; const float w0 = cw[ch0 + c], w1 = cw[512 + ch0 + c], w2 = cw[1024 + ch0 + c], w3 = cw[1536 + ch0 + c], bb = cbv[ch0 + c];
#pragma unroll 4
            for (int r = 0; r < 16; ++r) { const int t = rg * 16 + r; const float v = bb + w0 * XS[t * 64 + c] + w1 * XS[(t + 1) * 64 + c] + w2 * XS[(t + 2) * 64 + c] + w3 * XS[(t + 3) * 64 + c];
                XC[t * 64 + c] = v; XCB[t * 72 + c] = (bf16)f2bf(v); } }
        __syncthreads();
        if (u + X.G < NU) LRU_ISSUE(u + X.G);
        { const int tb = wave >> 1, cb = wave & 1; f32x16 R = {}, I = {};
#pragma unroll
            for (int ks = 0; ks < 4; ++ks) { const bf16x8 A = *(const bf16x8*)(XCB + (32 * tb + r32) * 72 + 16 * ks + 8 * hi);
                const bf16x8 Ba = *(const bf16x8*)(WaT + (size_t)(blk * 64 + 32 * cb + r32) * 64 + 16 * ks + 8 * hi), Bx = *(const bf16x8*)(WxT + (size_t)(blk * 64 + 32 * cb + r32) * 64 + 16 * ks + 8 * hi);
                R = __builtin_amdgcn_mfma_f32_32x32x16_bf16(A, Ba, R, 0, 0, 0); I = __builtin_amdgcn_mfma_f32_32x32x16_bf16(A, Bx, I, 0, 0, 0); }
            const int c = 32 * cb + r32; const float bav = ba[ch0 + c], bxv = bx[ch0 + c], sp = softplus_neg(lam[ch0 + c]);
#pragma unroll
            for (int r = 0; r < 16; ++r) { const int t = 32 * tb + (r & 3) + 8 * (r >> 2) + 4 * hi;
                const float rr = sigm(R[r] + bav), ii = sigm(I[r] + bxv), la = -8.0f * rr * sp, av = __builtin_amdgcn_exp2f(1.4426950408889634f * la), mult = __builtin_amdgcn_sqrtf(neg_expm1(2.0f * la));
                AA[t * 64 + c] = av; XC[t * 64 + c] = mult * ii * XC[t * 64 + c]; } }
        __syncthreads();
        { const int c = tid & 63, sg = tid >> 6; float Ap = 1.f, Hp = 0.f;
#pragma unroll 4
            for (int i = 0; i < 16; ++i) { const int t = sg * 16 + i; const float av = AA[t * 64 + c]; Hp = av * Hp + XC[t * 64 + c]; Ap *= av; }
            SEG[sg * 64 + c] = Ap; SEG[512 + sg * 64 + c] = Hp;
            __syncthreads();
            if (PASS == 1) { if (tid < 64) { float A2 = 1.f, H2 = 0.f;
#pragma unroll
                    for (int s = 0; s < 8; ++s) { const float sa = SEG[s * 64 + c]; H2 = sa * H2 + SEG[512 + s * 64 + c]; A2 *= sa; }
                    LSA[(size_t)(b * 64 + n) * 512 + ch0 + c] = A2; LSH[(size_t)(b * 64 + n) * 512 + ch0 + c] = H2; } }
            else { float hin = LC[(size_t)(b * 64 + n) * 512 + ch0 + c];
                for (int s = 0; s < sg; ++s) hin = SEG[s * 64 + c] * hin + SEG[512 + s * 64 + c];
#pragma unroll 4
                for (int i = 0; i < 16; ++i) { const int t = sg * 16 + i; hin = AA[t * 64 + c] * hin + XC[t * 64 + c];
                    const float g = bf2f(GS[t * 64 + c]);
                    YB[(row0 + t) * 1536 + ch0 + c] = (bf16)f2bf(hin * gelu_tanh(g)); } }
        }
        __syncthreads();
    }
#undef LRU_ISSUE
}
__device__ __forceinline__ void lru_prefix(const Ctx& X, const Args& a) {
    const float* LSA = (const float*)(wsptr(a) + WS_LSA); const float* LSH = (const float*)(wsptr(a) + WS_LSH); float* LC = (float*)(wsptr(a) + WS_LC);
    const int idx = X.vcu * 512 + X.tid;
    if (idx < NB * 512) { const int b = idx >> 9, ch = idx & 511; float h = 0.f;
        for (int n0 = 0; n0 < 64; n0 += 8) { float av[8], hv[8];
#pragma unroll
            for (int j = 0; j < 8; ++j) { av[j] = LSA[(size_t)(b * 64 + n0 + j) * 512 + ch]; hv[j] = LSH[(size_t)(b * 64 + n0 + j) * 512 + ch]; }
#pragma unroll
            for (int j = 0; j < 8; ++j) { LC[(size_t)(b * 64 + n0 + j) * 512 + ch] = h; h = av[j] * h + hv[j]; } } }
}

constexpr int RT_Q = 0, RT_K = 18432, RT_V = 36864, RT_S = 55296, RT_HALF = 64512, RT_P = 72;
template <int PASS>
__device__ __forceinline__ void ret_phase(const Ctx& X, unsigned char* ldsg, const Args& a) {
    const bf16* TR = (const bf16*)(wsptr(a) + WS_TR); bf16* YB = (bf16*)(wsptr(a) + WS_YB); float* RS = (float*)(wsptr(a) + WS_RS);
    const float* cr = (const float*)(wsptr(a) + WS_ROPE); const float* sr = cr + (size_t)M * 32;
    const int tid = X.tid, lane = X.lane, wave = X.wave, r32 = lane & 31, hi = lane >> 5, half = wave >> 2, w4 = wave & 3, t2 = tid & 255;
    bf16* Qs = (bf16*)(ldsg + half * RT_HALF + RT_Q); bf16* Ks = (bf16*)(ldsg + half * RT_HALF + RT_K); bf16* Vs = (bf16*)(ldsg + half * RT_HALF + RT_V); bf16* Ss = (bf16*)(ldsg + half * RT_HALF + RT_S);
    for (int u = X.vcu; u < NB * 64 * 4; u += X.G) {
        const int hp = u & 3, n = (u >> 2) & 63, b = u >> 8, h = 2 * hp + half; const size_t row0 = (size_t)b * SEQ + n * 128; const float lg = LG2G[h];
        for (int c = t2; c < 1024; c += 256) { const int r = c >> 3, cc = (c & 7) * 8; const size_t grow = row0 + r;
            const f32x4 cs = *(const f32x4*)(cr + grow * 32 + (cc >> 1)), sn = *(const f32x4*)(sr + grow * 32 + (cc >> 1));
            { const v4u w = *(const v4u*)(TR + grow * 2048 + 512 + h * 64 + cc); float f[8], o[8]; unpack8(w, f);
              const float kd = (PASS == 1) ? 0.125f * __builtin_amdgcn_exp2f((float)(127 - r) * lg) : 0.125f;
#pragma unroll
              for (int p = 0; p < 4; ++p) { o[2 * p] = (f[2 * p] * cs[p] - f[2 * p + 1] * sn[p]) * kd; o[2 * p + 1] = (f[2 * p] * sn[p] + f[2 * p + 1] * cs[p]) * kd; }
              *(v4u*)(Ks + r * RT_P + cc) = pack8f(o); }
            *(v4u*)(Vs + r * RT_P + cc) = *(const v4u*)(TR + grow * 2048 + 1024 + h * 64 + cc);
            if (PASS == 2) { const v4u w = *(const v4u*)(TR + grow * 2048 + h * 64 + cc); float f[8], o[8]; unpack8(w, f);
#pragma unroll
              for (int p = 0; p < 4; ++p) { o[2 * p] = f[2 * p] * cs[p] - f[2 * p + 1] * sn[p]; o[2 * p + 1] = f[2 * p] * sn[p] + f[2 * p + 1] * cs[p]; }
              *(v4u*)(Qs + r * RT_P + cc) = pack8f(o); } }
        if (PASS == 2) { const float* sp = RS + ((size_t)(b * 8 + h) * 64 + n) * 4096;
            for (int c = t2; c < 1024; c += 256) { const int d = c >> 4, e0 = (c & 15) * 4; const f32x4 v = *(const f32x4*)(sp + d * 64 + e0);
                Ss[(e0 + 0) * RT_P + d] = (bf16)f2bf(v.x); Ss[(e0 + 1) * RT_P + d] = (bf16)f2bf(v.y); Ss[(e0 + 2) * RT_P + d] = (bf16)f2bf(v.z); Ss[(e0 + 3) * RT_P + d] = (bf16)f2bf(v.w); } }
        __syncthreads();
        if (PASS == 1) {
            const int db = w4 >> 1, eb = w4 & 1; f32x16 acc = {};
#pragma unroll
            for (int ks = 0; ks < 8; ++ks) { bf16x8 A, B;
#pragma unroll
                for (int j = 0; j < 8; ++j) { A[j] = (short)Ks[(16 * ks + 8 * hi + j) * RT_P + 32 * db + r32]; B[j] = (short)Vs[(16 * ks + 8 * hi + j) * RT_P + 32 * eb + r32]; }
                acc = __builtin_amdgcn_mfma_f32_32x32x16_bf16(A, B, acc, 0, 0, 0); }
            float* dst = RS + ((size_t)(b * 8 + h) * 64 + n) * 4096;
#pragma unroll
            for (int r = 0; r < 16; ++r) dst[(32 * db + (r & 3) + 8 * (r >> 2) + 4 * hi) * 64 + 32 * eb + r32] = acc[r];
        } else {
            const int cb = w4; bf16x8 qf[4];
#pragma unroll
            for (int ks = 0; ks < 4; ++ks) qf[ks] = *(const bf16x8*)(Qs + (32 * cb + r32) * RT_P + 16 * ks + 8 * hi);
            f32x16 yin[2] = {}, ycr[2] = {};
            for (int sb = 0; sb <= cb; ++sb) { f32x16 st = {};
#pragma unroll
                for (int ks = 0; ks < 4; ++ks) { const bf16x8 A = *(const bf16x8*)(Ks + (32 * sb + r32) * RT_P + 16 * ks + 8 * hi); st = __builtin_amdgcn_mfma_f32_32x32x16_bf16(A, qf[ks], st, 0, 0, 0); }
#pragma unroll
                for (int r = 0; r < 16; ++r) { const int d = (32 * cb + r32) - (32 * sb + (r & 3) + 8 * (r >> 2) + 4 * hi); st[r] = d >= 0 ? st[r] * __builtin_amdgcn_exp2f((float)d * lg) : 0.f; }
#pragma unroll
                for (int t = 0; t < 2; ++t) { v4u pw; pw.x = pk2(st[8 * t], st[8 * t + 1]); pw.y = pk2(st[8 * t + 2], st[8 * t + 3]); pw.z = pk2(st[8 * t + 4], st[8 * t + 5]); pw.w = pk2(st[8 * t + 6], st[8 * t + 7]);
                    const bf16x8 Bf = __builtin_bit_cast(bf16x8, pw);
#pragma unroll
                    for (int eb = 0; eb < 2; ++eb) { bf16x8 A;
#pragma unroll
                        for (int j = 0; j < 8; ++j) A[j] = (short)Vs[(32 * sb + 16 * t + 8 * (j >> 2) + 4 * hi + (j & 3)) * RT_P + 32 * eb + r32];
                        yin[eb] = __builtin_amdgcn_mfma_f32_32x32x16_bf16(A, Bf, yin[eb], 0, 0, 0); } } }
#pragma unroll
            for (int eb = 0; eb < 2; ++eb)
#pragma unroll
                for (int ks = 0; ks < 4; ++ks) { const bf16x8 A = *(const bf16x8*)(Ss + (32 * eb + r32) * RT_P + 16 * ks + 8 * hi); ycr[eb] = __builtin_amdgcn_mfma_f32_32x32x16_bf16(A, qf[ks], ycr[eb], 0, 0, 0); }
            const float qd = __builtin_amdgcn_exp2f((float)(32 * cb + r32 + 1) * lg);
            float s = 0.f;
#pragma unroll
            for (int eb = 0; eb < 2; ++eb)
#pragma unroll
                for (int r = 0; r < 16; ++r) { yin[eb][r] += qd * ycr[eb][r]; s += yin[eb][r]; }
            s = half_sum(s); const float mu = s * (1.0f / 64.0f); float q = 0.f;
#pragma unroll
            for (int eb = 0; eb < 2; ++eb)
#pragma unroll
                for (int r = 0; r < 16; ++r) { const float dlt = yin[eb][r] - mu; yin[eb][r] = dlt; q += dlt * dlt; }
            q = half_sum(q); const float rstd = __builtin_amdgcn_rsqf(q * (1.0f / 64.0f) + EPS);
            const size_t grow = row0 + 32 * cb + r32;
#pragma unroll
            for (int eb = 0; eb < 2; ++eb)
#pragma unroll
                for (int qd4 = 0; qd4 < 4; ++qd4) { const int e0 = 32 * eb + 8 * qd4 + 4 * hi;
                    const u32x2 gw = *(const u32x2*)(TR + grow * 2048 + 1536 + h * 64 + e0);
                    const float g0 = __uint_as_float(gw.x << 16), g1 = __uint_as_float(gw.x & 0xffff0000u), g2 = __uint_as_float(gw.y << 16), g3 = __uint_as_float(gw.y & 0xffff0000u);
                    u32x2 ow; ow.x = pk2(g0 * sigm(g0) * yin[eb][4 * qd4] * rstd, g1 * sigm(g1) * yin[eb][4 * qd4 + 1] * rstd); ow.y = pk2(g2 * sigm(g2) * yin[eb][4 * qd4 + 2] * rstd, g3 * sigm(g3) * yin[eb][4 * qd4 + 3] * rstd);
                    *(u32x2*)(YB + grow * 1536 + 512 + h * 64 + e0) = ow; }
        }
        __syncthreads();
    }
}
__device__ __forceinline__ void ret_prefix(const Ctx& X, const Args& a) {
    float* RS = (float*)(wsptr(a) + WS_RS);
    const int nth = X.G * 512;
    for (int idx = X.vcu * 512 + X.tid; idx < NB * 8 * 4096; idx += nth) { const int bh = idx >> 12, off = idx & 4095, h = bh & 7;
        const float cd = __builtin_amdgcn_exp2f(128.0f * LG2G[h]); float* base = RS + (size_t)bh * 64 * 4096 + off; float st = 0.f;
        for (int n0 = 0; n0 < 64; n0 += 8) { float t[8];
#pragma unroll
            for (int j = 0; j < 8; ++j) t[j] = base[(size_t)(n0 + j) * 4096];
#pragma unroll
            for (int j = 0; j < 8; ++j) { base[(size_t)(n0 + j) * 4096] = st; st = st * cd + t[j]; } } }
}

__device__ __forceinline__ void act_pass(const Ctx& X, const Args& a, int l, int hb) {
    const bf16* UP = (const bf16*)(wsptr(a) + WS_UPH); bf16* ACT = (bf16*)(wsptr(a) + WS_ACT) + (size_t)hb * SEQ * DFF;
    const float* cw = (const float*)inptr(a, I_FCW) + (size_t)l * 3 * 5632; const float* cb = (const float*)inptr(a, I_FCB) + (size_t)l * 5632;
    const int nth = X.G * 512; constexpr int SEGR = 32, NSEG = SEQ / SEGR, NCH = DFF / 8;
    for (int idx = X.vcu * 512 + X.tid; idx < NSEG * NCH; idx += nth) { const int jc = idx % NCH, sg = idx / NCH, j0 = jc * 8, ucol = (j0 >> 7) * 256 + (j0 & 127), gcol = ucol + 128;
        float wu[3][8], wg[3][8], bu[8], bg[8];
#pragma unroll
        for (int k = 0; k < 3; ++k)
#pragma unroll
            for (int e = 0; e < 8; ++e) { wu[k][e] = cw[k * 5632 + j0 + e]; wg[k][e] = cw[k * 5632 + 2816 + j0 + e]; }
#pragma unroll
        for (int e = 0; e < 8; ++e) { bu[e] = cb[j0 + e]; bg[e] = cb[2816 + j0 + e]; }
        float u1[8], u2[8], g1[8], g2[8];
        const int s0 = sg * SEGR;
#pragma unroll
        for (int e = 0; e < 8; ++e) { u1[e] = 0.f; u2[e] = 0.f; g1[e] = 0.f; g2[e] = 0.f; }
        if (s0 >= 2) { unpack8(*(const v4u*)(UP + (size_t)(s0 - 1) * 5632 + ucol), u1); unpack8(*(const v4u*)(UP + (size_t)(s0 - 2) * 5632 + ucol), u2);
                       unpack8(*(const v4u*)(UP + (size_t)(s0 - 1) * 5632 + gcol), g1); unpack8(*(const v4u*)(UP + (size_t)(s0 - 2) * 5632 + gcol), g2); }
#pragma unroll 4
        for (int s = s0; s < s0 + SEGR; ++s) { float u0[8], g0[8], o[8];
            unpack8(*(const v4u*)(UP + (size_t)s * 5632 + ucol), u0); unpack8(*(const v4u*)(UP + (size_t)s * 5632 + gcol), g0);
#pragma unroll
            for (int e = 0; e < 8; ++e) { const float cu = bu[e] + wu[2][e] * u0[e] + wu[1][e] * u1[e] + wu[0][e] * u2[e], cg = bg[e] + wg[2][e] * g0[e] + wg[1][e] * g1[e] + wg[0][e] * g2[e];
                o[e] = gelu_tanh(cg) * cu; u2[e] = u1[e]; u1[e] = u0[e]; g2[e] = g1[e]; g1[e] = g0[e]; }
            *(v4u*)(ACT + (size_t)s * DFF + j0) = pack8f(o); } }
}

constexpr int PH_PER_LAYER = 15, NPH = 2 + PH_PER_LAYER * DEPTH;
constexpr int BIGT = 1 << 30;

__global__ void __launch_bounds__(NWAVES * 64, 2) mk_fwd(Args args) {
    unsigned char* lds = g_lds;
    LAS unsigned char* L3 = (LAS unsigned char*)lds;
    const int wave0 = __builtin_amdgcn_readfirstlane((int)threadIdx.x >> 6);
    const int lo = args.ph_lo, hi = args.ph_hi;
    for (int u = threadIdx.x; u < (LDS_BYTES - 131072) / 4; u += NWAVES * 64) ((LAS unsigned*)(L3 + 131072))[u] = 0u;
    __syncthreads();
    if (threadIdx.x < 31) ((LAS unsigned long long*)(L3 + ARGS_LDS_OFF))[threadIdx.x] = ((const unsigned long long*)&args)[threadIdx.x];
    __syncthreads();
    if (hi - lo > 1) (void)xcd_barrier_post((unsigned*)(wsptr(args) + WS_CTL) + 1024, (volatile LAS unsigned*)(L3 + MISC_OFF) + 8);
#ifndef PHMASK
#define PHMASK 0xFFFFFFFFu
#endif
#define PHON(j) ((PHMASK >> (2 + (j))) & 1u)
#define CTX Ctx X; int bx; LAS unsigned char* L3p; unsigned char* ldsp; \
        { int ln_; asm volatile("v_mbcnt_lo_u32_b32 %0, -1, 0\n\tv_mbcnt_hi_u32_b32 %0, -1, %0" : "=v"(ln_)); \
          const int w_ = opaque_u(wave0), g_ = opaque_u((int)gridDim.x), b_ = opaque_u((int)blockIdx.x), lz_ = opaque_u(0); \
          X.tid = w_ * 64 + ln_; X.lane = ln_; X.wave = w_; X.G = g_; bx = b_; X.vcu = (g_ % 8 == 0) ? (b_ % 8) * (g_ / 8) + b_ / 8 : b_; L3p = L3 + lz_; ldsp = lds + lz_; } \
        unsigned char* ws = wsptr(args); (void)bx; (void)L3p; (void)ldsp; (void)ws;
#define WPTR(off) ((const bf16*)(ws + WS_W + (off)))
#pragma unroll 1
    for (int ph = lo, rep = 0; ph < hi; ++ph) {
        const int l = ph < 2 ? 0 : (ph - 2) / PH_PER_LAYER, j = ph < 2 ? ph - 2 : (ph - 2) - l * PH_PER_LAYER;
#ifdef AMP_MASK
        const unsigned long long amp_t0 = __builtin_amdgcn_s_memrealtime();
#endif

#ifndef REPMASK
#define REPMASK 0u
#endif
        if (j == -2 && PHON(-2)) { CTX p_mods(X, L3p, args); __syncthreads(); p_rope(X, args); convert_mixer(X, L3p, args, 0); }
        else if (j == -1 && PHON(-1)) { CTX const float* MOD = (const float*)(ws + WS_MOD);
            row_pass<0, true>(X, (const float*)inptr(args, I_X), nullptr, nullptr, nullptr, nullptr, (const float*)inptr(args, I_MIXPRE), MOD, MOD + 1024, (bf16*)(ws + WS_XN)); }
        else if (j == 0 && PHON(0)) { CTX
            pg8::Gemm g{(const bf16*)(ws + WS_XN), WPTR(WO_IN), M, 3840, 1024, 1024}; pg8::StaticOrder S; S.init(M, 3840, X.G, bx);
            typedef pg8::EpiRoute<0, WS_TL, 1024, 4, WS_TR, 2048, 12, WS_TM, 768> E_t; E_t E{&args};
            pg8::gemm_phase<E_t, pg8::StaticOrder, true, true>(L3p, g, S, E, X.tid);
        }
        else if (j == 1 && PHON(1)) { CTX lru_phase<1>(X, ldsp, args, l); __syncthreads(); ret_phase<1>(X, ldsp, args); p_mla_rstd(X, args); }
        else if (j == 2 && PHON(2)) { CTX lru_prefix(X, args); ret_prefix(X, args); }
        else if (j == 3 && PHON(3)) { CTX lru_phase<2>(X, ldsp, args, l); __syncthreads(); ret_phase<2>(X, ldsp, args); }
        else if (j == 4 && PHON(4)) {
            { CTX p_krope(X, args); }
            { CTX pg8::Gemm g{(const bf16*)(ws + WS_TM), WPTR(WO_UQ), M, 768, 384, 768}; pg8::StaticOrder S; S.init(M, 768, X.G, bx);
              pg8::EpiQ E{&args}; pg8::gemm_phase<pg8::EpiQ, pg8::StaticOrder, true, true>(L3p, g, S, E, X.tid); }
            { CTX pg8::Gemm g{(const bf16*)(ws + WS_TM) + 384, WPTR(WO_UKV), M, 1024, 256, 768}; pg8::StaticOrder S; S.init(M, 1024, X.G, bx);
              pg8::EpiKV E{&args}; pg8::gemm_phase<pg8::EpiKV, pg8::StaticOrder, true, true>(L3p, g, S, E, X.tid); }
        }
        else if (j == 5 && PHON(5)) { CTX
            const bf16* Qb = (const bf16*)(ws + WS_Q); const bf16* Kb = (const bf16*)(ws + WS_K); const bf16* Vb = (const bf16*)(ws + WS_V); bf16* YB = (bf16*)(ws + WS_YB);
            att::Seam S;
            for (int L = X.vcu; L < 256; L += X.G) {
                const int bh = L >> 4, xq = L & 15, b = bh >> 3, h = bh & 7, qb0 = xq, qb1 = 31 - xq;
                const bf16* Kh = Kb + (size_t)b * SEQ * 768 + h * 96; const bf16* Vh = Vb + (size_t)b * SEQ * 512 + h * 64;
                att::BlockRef r0{Qb + ((size_t)b * SEQ + qb0 * 256) * 768 + h * 96, Kh, Vh, YB + ((size_t)b * SEQ + qb0 * 256) * 1536 + 1024 + h * 64, qb0 * 256};
                att::BlockRef r1{Qb + ((size_t)b * SEQ + qb1 * 256) * 768 + h * 96, Kh, Vh, YB + ((size_t)b * SEQ + qb1 * 256) * 1536 + 1024 + h * 64, qb1 * 256};
                att::attn_prime(r0, (char*)ldsp, S, X.tid);
                att::attn_block(r0, r1, (char*)ldsp, S, X.tid);
                att::attn_block(r1, r1, (char*)ldsp, S, X.tid);
                asm volatile("s_waitcnt vmcnt(0)" ::: "memory"); __syncthreads();
            }
        }
        else if (j == 6 && PHON(6)) {
            { CTX pg8::Gemm g{(const bf16*)(ws + WS_XN), WPTR(WO_G), M, 3072, 1024, 1024}; pg8::GateOrder S; S.init(M, X.G, bx);
              typedef pg8::EpiRoute<2, WS_G, 3072, BIGT, 0, 0, BIGT, 0, 0> E_t; E_t E{&args};
              pg8::gemm_phase<E_t, pg8::GateOrder, true, true>(L3p, g, S, E, X.tid);
              asm volatile("s_waitcnt vmcnt(0)" ::: "memory"); __syncthreads();
              __builtin_amdgcn_fence(__ATOMIC_ACQUIRE, "agent"); asm volatile("s_waitcnt vmcnt(0)" ::: "memory"); }
            { CTX pg8::Gemm g{(const bf16*)(ws + WS_YB), WPTR(WO_O3), M, 3072, 512, 1536}; pg8::MergeOrder S; S.init(M, X.G, bx);
              pg8::EpiMerge E{&args}; pg8::gemm_phase<pg8::EpiMerge, pg8::MergeOrder, true, true>(L3p, g, S, E, X.tid); }
        }
        else if (j == 7 && PHON(7)) { CTX
            pg8::Gemm g{(const bf16*)(ws + WS_XN), WPTR(WO_OUT), M, 1024, 1024, 1024}; pg8::StaticOrder S; S.init(M, 1024, X.G, bx);
            pg8::EpiF32<WS_Y> E{&args}; pg8::gemm_phase<pg8::EpiF32<WS_Y>, pg8::StaticOrder, true, true>(L3p, g, S, E, X.tid);
        }
        else if (j == 8 && PHON(8)) { CTX float* out = outptr(args); const float* MODl = (const float*)(ws + WS_MOD) + (size_t)l * NB * 6144;
            row_pass<1, true>(X, l == 0 ? (const float*)inptr(args, I_X) : (const float*)out, out, (const float*)(ws + WS_Y), (const float*)inptr(args, I_MIXPOST) + l * 1024, MODl + 2048,
                              (const float*)inptr(args, I_FPRE) + l * 1024, MODl + 3072, MODl + 4096, (bf16*)(ws + WS_XN));
            convert_ffn(X, L3p, args, l);
#ifdef REP_CONV
            convert_ffn(X, L3p, args, l);
#endif
        }
        else if ((j == 9 || j == 11) && PHON(9)) { CTX const int hb = (j - 9) >> 1;
            pg8::Gemm g{(const bf16*)(ws + WS_XN) + (size_t)hb * SEQ * 1024, WPTR(WO_UP), SEQ, 5632, 1024, 1024}; pg8::StaticOrder S; S.init(SEQ, 5632, X.G, bx);
            typedef pg8::EpiRoute<0, WS_UPH, 5632, BIGT, 0, 0, BIGT, 0, 0> E_t; E_t E{&args};
            pg8::gemm_phase<E_t, pg8::StaticOrder, true, true>(L3p, g, S, E, X.tid);
        }
        else if ((j == 10 || j == 12) && PHON(10)) { CTX act_pass(X, args, l, (j - 10) >> 1); }
        else if (j == 13 && PHON(13)) { CTX
            pg8::Gemm g{(const bf16*)(ws + WS_ACT), WPTR(WO_DOWN), M, 1024, 2816, 2816}; pg8::StaticOrder S; S.init(M, 1024, X.G, bx);
            pg8::EpiF32<WS_Y2> E{&args}; pg8::gemm_phase<pg8::EpiF32<WS_Y2>, pg8::StaticOrder, true, true>(L3p, g, S, E, X.tid);
        }
        else if (j == 14 && PHON(14)) { CTX float* out = outptr(args); const float* MOD = (const float*)(ws + WS_MOD); const float* MODl = MOD + (size_t)l * NB * 6144;
            if (l + 1 < DEPTH) {
                const float* MODn = MOD + (size_t)(l + 1) * NB * 6144;
                row_pass<1, true>(X, (const float*)out, out, (const float*)(ws + WS_Y2), (const float*)inptr(args, I_FPOST) + l * 1024, MODl + 5120,
                                  (const float*)inptr(args, I_MIXPRE) + (l + 1) * 1024, MODn, MODn + 1024, (bf16*)(ws + WS_XN));
                convert_mixer(X, L3p, args, l + 1);
#ifdef REP_CONV
                convert_mixer(X, L3p, args, l + 1);
#endif
            } else {
                row_pass<1, false>(X, (const float*)out, out, (const float*)(ws + WS_Y2), (const float*)inptr(args, I_FPOST) + l * 1024, MODl + 5120, nullptr, nullptr, nullptr, nullptr);
            }
        }
        if (REPMASK != 0u) { const int nrep = ((REPMASK >> (j + 2)) & 1u) ? 2 : 1; if (++rep < nrep) { --ph; continue; } rep = 0; }
        if (ph + 1 < hi) {
            if (ph == lo) { cg::this_grid().sync(); }
            else { unsigned char* ws = wsptr(args); const int lz_ = opaque_u(0); XcdBarrier bar; bar.bar = (unsigned*)(ws + WS_CTL) + 1024; bar.x = xb_xcc_id(); bar.st = (volatile LAS unsigned*)(L3 + lz_ + MISC_OFF) + 8; xcd_barrier(bar);
#ifdef REP_BAR
                   xcd_barrier(bar);
#endif
            }
        }
#ifdef AMP_MASK
        if ((AMP_MASK >> (j + 2)) & 1u) {
            const unsigned long long t1 = __builtin_amdgcn_s_memrealtime(), target = t1 + (unsigned long long)(AMP_N - 1) * (t1 - amp_t0);
            while (__builtin_amdgcn_s_memrealtime() < target) __builtin_amdgcn_s_sleep(8);
        }
#endif
    }
#undef PHON
#undef WPTR
#undef CTX
}


#ifdef DBG_K
__global__ void dbg_dump(const unsigned char* ws, float* out) {
    const bf16* buf = (const bf16*)(ws + (size_t)DBG_OFF);
    for (size_t i = (size_t)blockIdx.x * blockDim.x + threadIdx.x; i < (size_t)M * 1024; i += (size_t)gridDim.x * blockDim.x) {
        const size_t r = i >> 10; const int c = (int)(i & 1023);
        out[i] = c < DBG_NC ? __uint_as_float((unsigned)buf[r * DBG_LD + DBG_COL0 + c] << 16) : 0.f; }
}
#endif
extern "C" void kernel_launch(void* const* d_in, const int* in_sizes, int n_in, void* d_out, int out_size, void* d_ws, size_t ws_size, hipStream_t stream) {
    static int grid = 0;
    if (grid == 0) {
        if (n_in != 29 || in_sizes[0] != M * DM || out_size != M * DM || ws_size < WS_END) { fprintf(stderr, "kernel_launch: unexpected shapes (n_in %d, in0 %d, out %d, ws %zu)\n", n_in, n_in > 0 ? in_sizes[0] : -1, out_size, ws_size); grid = -1; return; }
        int dev = 0, cus = 0, per_cu = 0;
        if (hipGetDevice(&dev) != hipSuccess || hipDeviceGetAttribute(&cus, hipDeviceAttributeMultiprocessorCount, dev) != hipSuccess) { grid = -1; return; }
        if (hipFuncSetAttribute((const void*)mk_fwd, hipFuncAttributeMaxDynamicSharedMemorySize, LDS_BYTES) != hipSuccess) { fprintf(stderr, "kernel_launch: hipFuncSetAttribute failed\n"); grid = -1; return; }
        if (hipOccupancyMaxActiveBlocksPerMultiprocessor(&per_cu, (const void*)mk_fwd, NWAVES * 64, LDS_BYTES) != hipSuccess || per_cu < 1) { fprintf(stderr, "kernel_launch: occupancy query says %d blocks per CU\n", per_cu); per_cu = 1; }
        (void)hipGetLastError();
        grid = cus;
    }
    if (grid < 0) return;
    (void)hipMemsetAsync((char*)d_ws + WS_CTL, 0, CTL_ZERO_BYTES, stream);
    Args a{};
    for (int i = 0; i < 29; ++i) a.in[i] = d_in[i];
    a.out = (float*)d_out; a.ws = (unsigned char*)d_ws;
#if MK_ONE_LAUNCH
    a.ph_lo = 0; a.ph_hi = NPH;
    void* params[] = {&a};
    hipError_t e = hipLaunchCooperativeKernel((const void*)mk_fwd, dim3(grid), dim3(NWAVES * 64), params, LDS_BYTES, stream);
    if (e != hipSuccess) fprintf(stderr, "kernel_launch: cooperative launch failed: %s (grid %d)\n", hipGetErrorString(e), grid);
#else
#ifdef DBG_K
    for (int k = 0; k < DBG_K; ++k) { a.ph_lo = k; a.ph_hi = k + 1; hipLaunchKernelGGL(mk_fwd, dim3(grid), dim3(NWAVES * 64), LDS_BYTES, stream, a); }
    hipLaunchKernelGGL(dbg_dump, dim3(2048), dim3(256), 0, stream, (const unsigned char*)d_ws, (float*)d_out);
#else
    for (int k = 0; k < NPH; ++k) { a.ph_lo = k; a.ph_hi = k + 1; hipLaunchKernelGGL(mk_fwd, dim3(grid), dim3(NWAVES * 64), LDS_BYTES, stream, a); }
#endif
#endif
}
```

```cpp
#include <hip/hip_runtime.h>
#include <hip/hip_bf16.h>
#include <hip/hip_cooperative_groups.h>
#include <cstdio>
#include <cstdint>
namespace cg = cooperative_groups;

#ifndef MK_ONE_LAUNCH
#define MK_ONE_LAUNCH 1
#endif

constexpr int DM = 1024, NB = 2, SEQ = 8192, M = NB * SEQ, DEPTH = 2;
constexpr int LRU_W = 512, RET_H = 8, MLA_H = 8, QRANK = 384, KVRANK = 256, DFF = 2816;
constexpr int NIN = 6816;
constexpr float EPS = 1e-6f;

constexpr size_t MiB = 1u << 20;
constexpr size_t WS_CTL = 0, CTL_ZERO_BYTES = 64 * 1024;
constexpr size_t WS_MOD = 1 * MiB;
constexpr size_t WS_RSTD = WS_MOD + 128 * 1024;
constexpr size_t WS_LSA = WS_RSTD + 128 * 1024;
constexpr size_t WS_LSH = WS_LSA + 256 * 1024;
constexpr size_t WS_LC = WS_LSH + 256 * 1024;
constexpr size_t WS_ROPE = 3 * MiB;
constexpr size_t WS_W = 10 * MiB;
constexpr size_t WS_XN = 30 * MiB;
constexpr size_t WS_YB = 62 * MiB;
constexpr size_t WS_RS = 110 * MiB;
constexpr size_t WS_BIG = 126 * MiB;
constexpr size_t WS_TL = WS_BIG, WS_TR = WS_BIG + 32 * MiB, WS_TM = WS_BIG + 96 * MiB;
constexpr size_t WS_Q = WS_BIG, WS_K = WS_BIG + 24 * MiB, WS_V = WS_BIG + 48 * MiB;
constexpr size_t WS_G = WS_BIG, WS_Y = WS_BIG;
constexpr size_t WS_UPH = 62 * MiB, WS_ACT = 150 * MiB, WS_Y2 = 62 * MiB;
constexpr size_t WS_END = 256 * MiB;
constexpr size_t WO_IN = 0, WO_G = WO_IN + (size_t)3840 * 1024 * 2, WO_OUT = WO_G + (size_t)3072 * 1024 * 2, WO_O3 = WO_OUT + (size_t)1024 * 1024 * 2,
                 WO_UQ = WO_O3 + (size_t)3 * 1024 * 512 * 2, WO_UKV = WO_UQ + (size_t)768 * 384 * 2, WO_AT = WO_UKV + (size_t)1024 * 256 * 2, WO_XT = WO_AT + 65536, WO_MIX_END = WO_XT + 65536;
constexpr size_t WO_UP = 0, WO_DOWN = (size_t)5632 * 1024 * 2, WO_FFN_END = WO_DOWN + (size_t)1024 * 2816 * 2;
static_assert(WO_MIX_END <= 20 * MiB && WO_FFN_END <= 20 * MiB, "weight region");
static_assert(WS_ACT + (size_t)M * DFF * 2 <= WS_END && WS_UPH + (size_t)8192 * 5632 * 2 <= WS_ACT, "ffn map");

constexpr int LDS_BYTES = 147456;
constexpr int MISC_OFF = 131072 + 320;
constexpr int NWAVES = 8;

typedef float f32x16 __attribute__((ext_vector_type(16)));
typedef unsigned u32x2 __attribute__((ext_vector_type(2)));
typedef float f32x2 __attribute__((ext_vector_type(2)));

__device__ const double INVR[32] = {1.0, 0.7498942093324559, 0.5623413251903491, 0.4216965034285822, 0.31622776601683794, 0.23713737056616552, 0.1778279410038923, 0.1333521432163324, 0.1, 0.07498942093324558, 0.05623413251903491, 0.042169650342858224, 0.03162277660168379, 0.023713737056616554, 0.01778279410038923, 0.01333521432163324, 0.01, 0.007498942093324558, 0.005623413251903491, 0.004216965034285823, 0.0031622776601683794, 0.0023713737056616554, 0.0017782794100389228, 0.001333521432163324, 0.001, 0.0007498942093324559, 0.0005623413251903491, 0.00042169650342858224, 0.00031622776601683794, 0.00023713737056616554, 0.00017782794100389227, 0.0001333521432163324};
__device__ const float LG2G[8] = {-0.04580368961312479f, -0.02272007650008353f, -0.011315313227834146f, -0.005646563141142063f, -0.0028205190623786626f, -0.0014095702546713536f, -0.0007046129765893727f, -0.0003522634716290214f};

struct Ctx { int tid, lane, wave, G, vcu; };
struct Args { const void* in[29]; float* out; unsigned char* ws; int ph_lo, ph_hi; };
enum { I_X = 0, I_C, I_POS, I_ADAW, I_ADAB, I_MIXPRE, I_MIXPOST, I_WIN, I_LCW, I_LCB, I_LWA, I_LBA, I_LWX, I_LBX, I_LLAM, I_LWO, I_RWO, I_QNG, I_WUQ, I_KVNG, I_WUKV, I_MWO, I_WOUT,
       I_FPRE, I_FPOST, I_WUP, I_FCW, I_FCB, I_WDOWN };


#define GAS __attribute__((address_space(1)))
#define LAS __attribute__((address_space(3)))
extern __shared__ __attribute__((aligned(16))) unsigned char g_lds[];
constexpr int ARGS_LDS_OFF = 131072 + 1024;
__device__ __forceinline__ int opaque_u(int v) { int t; asm volatile("v_mov_b32 %0, %1" : "=v"(t) : "s"(v)); return __builtin_amdgcn_readfirstlane(t); }
__device__ __forceinline__ unsigned long long lds_arg(int idx) {
    const int z = opaque_u(0);
    volatile LAS unsigned* p = (volatile LAS unsigned*)((LAS unsigned char*)g_lds + z + ARGS_LDS_OFF) + 2 * idx;
    const unsigned lo = p[0], hi = p[1];
    return ((unsigned long long)(unsigned)__builtin_amdgcn_readfirstlane((int)hi) << 32) | (unsigned)__builtin_amdgcn_readfirstlane((int)lo);
}
__device__ __forceinline__ const void* inptr(const Args&, int i) { return (const void*)(GAS const void*)lds_arg(i); }
__device__ __forceinline__ unsigned char* wsptr(const Args&) { return (unsigned char*)(GAS unsigned char*)lds_arg(30); }
__device__ __forceinline__ float* outptr(const Args&) { return (float*)(GAS float*)lds_arg(29); }

namespace pg8 {
#define PG8_LAS __attribute__((address_space(3)))
typedef unsigned short bf16_t;
typedef short bf16x8 __attribute__((ext_vector_type(8)));
typedef float f32x4 __attribute__((ext_vector_type(4)));
typedef unsigned u32x4 __attribute__((ext_vector_type(4)));
typedef unsigned u32x2 __attribute__((ext_vector_type(2)));
constexpr int BM = 256, BK = 64, HALF = 128, HTB = HALF * BK * 2, STAGE_BYTES = 8 * HTB, NXCD = 8, WGM = 8;

__host__ __device__ __forceinline__ int lds_byte(int r, int c) { const int st = (r >> 4) * 2 + (c >> 5), rr = r & 15, cc = c & 31, ob = rr * 64 + cc * 2; return st * 1024 + (ob ^ (((ob >> 9) & 1) << 5)); }
__host__ __device__ __forceinline__ void stage_rc(int b, int& R, int& C) { const int st = b / 1024, sb = b % 1024, swz = sb ^ (((sb >> 9) & 1) << 5); R = (st >> 1) * 16 + swz / 64; C = (st & 1) * 32 + (swz % 64) / 2; }
__host__ __device__ __forceinline__ int perm32(int rho) { const int n = rho >> 4, i = rho & 15; return 8 * (i >> 2) + 4 * n + (i & 3); }

struct Unit { int pm, pn, ao; };
struct Gemm { const bf16_t* A; const bf16_t* Bt; int M, N, K, lda; };

struct StaticOrder {
    int nM, nN, nwg, G, c;
    __host__ __device__ void init(int M_, int N_, int G_, int c_) { nM = M_ / BM; nN = N_ / BM; nwg = nM * nN; G = G_; c = c_; }
    __host__ __device__ bool next(int i, Unit& u) const {
        const long L = (long)i * G + c; if (L >= nwg) return false;
        int wgid = (int)L; { const int q = nwg / NXCD, r = nwg % NXCD, xcd = wgid % NXCD, off = wgid / NXCD; wgid = (xcd < r ? xcd * (q + 1) : r * (q + 1) + (xcd - r) * q) + off; }
        const int nig = WGM * nN, gid = wgid / nig, fm = gid * WGM, gsz = (nM - fm) < WGM ? (nM - fm) : WGM;
        u.pm = fm + ((wgid % nig) % gsz); u.pn = (wgid % nig) / gsz; u.ao = 0; return true;
    }
    __device__ __forceinline__ void a_ready(const Unit&) const {}
    __device__ __forceinline__ void done(const Unit&) const {}
};


struct GateOrder {
    StaticOrder base;
    __host__ __device__ void init(int M_, int G_, int c_) { base.init(M_, 1024, G_, c_); }
    __host__ __device__ bool next(int i, Unit& u) const { if (i >= 3) return false; Unit t; if (!base.next(0, t)) return false; u.pm = t.pm; u.pn = t.pn + 4 * i; u.ao = 0; return true; }
    __device__ __forceinline__ void a_ready(const Unit&) const {}
    __device__ __forceinline__ void done(const Unit&) const {}
};
struct MergeOrder {
    StaticOrder base;
    __host__ __device__ void init(int M_, int G_, int c_) { base.init(M_, 1024, G_, c_); }
    __host__ __device__ bool next(int i, Unit& u) const { if (i >= 3) return false; Unit t; if (!base.next(0, t)) return false; u.pm = t.pm; u.pn = t.pn + 4 * i; u.ao = i * 1024; return true; }
    __device__ __forceinline__ void a_ready(const Unit&) const {}
    __device__ __forceinline__ void done(const Unit&) const {}
};
typedef float f32x2_t __attribute__((ext_vector_type(2))); typedef __bf16 bf16x2_t __attribute__((ext_vector_type(2)));
__device__ __forceinline__ unsigned cvt_pk_bf16(float lo, float hi) { f32x2_t v = {lo, hi}; bf16x2_t b = __builtin_convertvector(v, bf16x2_t); return __builtin_bit_cast(unsigned, b); }
__device__ __forceinline__ float bf_lo(unsigned w) { return __uint_as_float(w << 16); }
__device__ __forceinline__ float bf_hi(unsigned w) { return __uint_as_float(w & 0xffff0000u); }
__device__ __forceinline__ float sigmoidf_(float x) { return __builtin_amdgcn_rcpf(1.0f + __builtin_amdgcn_exp2f(-1.4426950408889634f * x)); }


template <int ACT, size_t O0, int LD0, int T1, size_t O1, int LD1, int T2, size_t O2, int LD2> struct EpiRoute {
    static constexpr bool PERM = true, AFTER_DRAIN = false;
    const Args* a;
    __device__ __forceinline__ void operator()(const f32x4 (&acc)[2][2][4][2], const Unit& u, int wr, int wc, int fr_, int fq_) const {
        (void)fr_; (void)fq_; int ln_; asm volatile("v_mbcnt_lo_u32_b32 %0, -1, 0\n\tv_mbcnt_hi_u32_b32 %0, -1, %0" : "=v"(ln_)); const int fr = ln_ & 15, fq = ln_ >> 4;
        unsigned char* ws = wsptr(*a);
        bf16_t* base; int ld, ct;
        if (u.pn < T1) { base = (bf16_t*)(ws + O0); ld = LD0; ct = u.pn; } else if (u.pn < T2) { base = (bf16_t*)(ws + O1); ld = LD1; ct = u.pn - T1; } else { base = (bf16_t*)(ws + O2); ld = LD2; ct = u.pn - T2; }
        int row0 = u.pm * BM + wr * 64 + fr, col0 = ct * BM + wc * 32 + 8 * fq; asm volatile("" : "+v"(row0), "+v"(col0));
#pragma unroll
        for (int ai = 0; ai < 2; ++ai)
#pragma unroll
            for (int m = 0; m < 4; ++m) { bf16_t* rowp = base + (size_t)(row0 + ai * HALF + m * 16) * ld + col0;
#pragma unroll
                for (int bj = 0; bj < 2; ++bj) { f32x4 v0 = acc[ai][bj][m][0], v1 = acc[ai][bj][m][1];
                    if (ACT == 2) {
#pragma unroll
                        for (int e = 0; e < 4; ++e) { v0[e] = sigmoidf_(v0[e]); v1[e] = sigmoidf_(v1[e]); } }
                    u32x4 w; w.x = cvt_pk_bf16(v0[0], v0[1]); w.y = cvt_pk_bf16(v0[2], v0[3]); w.z = cvt_pk_bf16(v1[0], v1[1]); w.w = cvt_pk_bf16(v1[2], v1[3]);
                    *(u32x4*)(rowp + bj * HALF) = w; } }
    }
};
struct EpiQ {
    static constexpr bool PERM = true, AFTER_DRAIN = false;
    const Args* a;
    __device__ __forceinline__ void operator()(const f32x4 (&acc)[2][2][4][2], const Unit& u, int wr, int wc, int fr_, int fq_) const {
        (void)fr_; (void)fq_; int ln_; asm volatile("v_mbcnt_lo_u32_b32 %0, -1, 0\n\tv_mbcnt_hi_u32_b32 %0, -1, %0" : "=v"(ln_)); const int fr = ln_ & 15, fq = ln_ >> 4;
        unsigned char* ws = wsptr(*a);
        const char* Qc = (const char*)(ws + WS_Q); const char* rstd = (const char*)(ws + WS_RSTD); const char* cosm = (const char*)(ws + WS_ROPE) + (size_t)M * 64 * 4; const char* sinm = cosm + (size_t)M * 16 * 4;
        int row0 = u.pm * BM + wr * 64 + fr, fq4 = fq; asm volatile("" : "+v"(row0), "+v"(fq4));
        const int g32 = u.pn * 8 + wc;
#pragma unroll
        for (int ai = 0; ai < 2; ++ai)
#pragma unroll
            for (int m = 0; m < 4; ++m) { const unsigned row = (unsigned)(row0 + ai * HALF + m * 16); const float rs = *(const float*)(rstd + row * 4u);
#pragma unroll
                for (int bj = 0; bj < 2; ++bj) { const int g = g32 + 4 * bj;
                    f32x4 v0 = acc[ai][bj][m][0] * rs, v1 = acc[ai][bj][m][1] * rs;
                    if ((g % 3) == 2) { const f32x4 cs = *(const f32x4*)(cosm + row * 64u + (unsigned)fq4 * 16u), sn = *(const f32x4*)(sinm + row * 64u + (unsigned)fq4 * 16u);
                        f32x4 p, b; p[0] = v0[0] * cs[0] - v0[1] * sn[0]; p[1] = v0[0] * sn[0] + v0[1] * cs[0]; p[2] = v0[2] * cs[1] - v0[3] * sn[1]; p[3] = v0[2] * sn[1] + v0[3] * cs[1];
                        b[0] = v1[0] * cs[2] - v1[1] * sn[2]; b[1] = v1[0] * sn[2] + v1[1] * cs[2]; b[2] = v1[2] * cs[3] - v1[3] * sn[3]; b[3] = v1[2] * sn[3] + v1[3] * cs[3]; v0 = p; v1 = b; }
                    u32x4 w; w.x = cvt_pk_bf16(v0[0], v0[1]); w.y = cvt_pk_bf16(v0[2], v0[3]); w.z = cvt_pk_bf16(v1[0], v1[1]); w.w = cvt_pk_bf16(v1[2], v1[3]);
                    *(u32x4*)(Qc + row * 1536u + (unsigned)(g * 64 + fq4 * 16)) = w; }
                asm volatile("" ::: "memory"); }
    }
};
struct EpiKV {
    static constexpr bool PERM = true, AFTER_DRAIN = false;
    const Args* a;
    __device__ __forceinline__ void operator()(const f32x4 (&acc)[2][2][4][2], const Unit& u, int wr, int wc, int fr_, int fq_) const {
        (void)fr_; (void)fq_; int ln_; asm volatile("v_mbcnt_lo_u32_b32 %0, -1, 0\n\tv_mbcnt_hi_u32_b32 %0, -1, %0" : "=v"(ln_)); const int fr = ln_ & 15, fq = ln_ >> 4;
        unsigned char* ws = wsptr(*a);
        bf16_t* Kp = (bf16_t*)(ws + WS_K); bf16_t* Vp = (bf16_t*)(ws + WS_V); const float* rstd = (const float*)(ws + WS_RSTD) + M;
        int row0 = u.pm * BM + wr * 64 + fr, col0 = u.pn * BM + wc * 32 + 8 * fq; asm volatile("" : "+v"(row0), "+v"(col0));
#pragma unroll
        for (int ai = 0; ai < 2; ++ai)
#pragma unroll
            for (int m = 0; m < 4; ++m) { const int row = row0 + ai * HALF + m * 16; const float rs = rstd[row];
#pragma unroll
                for (int bj = 0; bj < 2; ++bj) { const int c = col0 + bj * HALF, h = c >> 7, w = c & 127;
                    const f32x4 v0 = acc[ai][bj][m][0] * rs, v1 = acc[ai][bj][m][1] * rs;
                    u32x4 o; o.x = cvt_pk_bf16(v0[0], v0[1]); o.y = cvt_pk_bf16(v0[2], v0[3]); o.z = cvt_pk_bf16(v1[0], v1[1]); o.w = cvt_pk_bf16(v1[2], v1[3]);
                    bf16_t* dst = (w < 64) ? (Kp + (size_t)row * 768 + h * 96 + w) : (Vp + (size_t)row * 512 + h * 64 + (w - 64));
                    *(u32x4*)dst = o; }
                asm volatile("" ::: "memory"); }
    }
};
struct EpiMerge {
    static constexpr bool PERM = true, AFTER_DRAIN = false;
    const Args* a;
    __device__ __forceinline__ void operator()(const f32x4 (&acc)[2][2][4][2], const Unit& u, int wr, int wc, int fr_, int fq_) const {
        (void)fr_; (void)fq_; int ln_; asm volatile("v_mbcnt_lo_u32_b32 %0, -1, 0\n\tv_mbcnt_hi_u32_b32 %0, -1, %0" : "=v"(ln_)); const int fr = ln_ & 15, fq = ln_ >> 4;
        unsigned char* ws = wsptr(*a);
        const int b = u.pn >> 2, pn = u.pn & 3;
        bf16_t* O = (bf16_t*)(ws + WS_XN); const bf16_t* Gt = (const bf16_t*)(ws + WS_G) + 1024 * b; const bool accum = b > 0;
        int row0 = u.pm * BM + wr * 64 + fr, col0 = pn * BM + wc * 32 + 8 * fq; asm volatile("" : "+v"(row0), "+v"(col0));
#pragma unroll
        for (int ai = 0; ai < 2; ++ai)
#pragma unroll
            for (int m = 0; m < 4; ++m) { const int row = row0 + ai * HALF + m * 16;
#pragma unroll
                for (int bj = 0; bj < 2; ++bj) { const int c = col0 + bj * HALF;
                    const u32x4 gw = *(const u32x4*)(Gt + (size_t)row * 3072 + c);
                    f32x4 v0 = acc[ai][bj][m][0], v1 = acc[ai][bj][m][1];
                    v0[0] *= bf_lo(gw.x); v0[1] *= bf_hi(gw.x); v0[2] *= bf_lo(gw.y); v0[3] *= bf_hi(gw.y); v1[0] *= bf_lo(gw.z); v1[1] *= bf_hi(gw.z); v1[2] *= bf_lo(gw.w); v1[3] *= bf_hi(gw.w);
                    if (accum) { unsigned long long* op = (unsigned long long*)(O + (size_t)row * 1024 + c);
                        const unsigned long long o01 = __hip_atomic_load(op, __ATOMIC_RELAXED, __HIP_MEMORY_SCOPE_AGENT), o23 = __hip_atomic_load(op + 1, __ATOMIC_RELAXED, __HIP_MEMORY_SCOPE_AGENT);
                        const unsigned ox = (unsigned)o01, oy = (unsigned)(o01 >> 32), oz = (unsigned)o23, ow = (unsigned)(o23 >> 32);
                        v0[0] += bf_lo(ox); v0[1] += bf_hi(ox); v0[2] += bf_lo(oy); v0[3] += bf_hi(oy); v1[0] += bf_lo(oz); v1[1] += bf_hi(oz); v1[2] += bf_lo(ow); v1[3] += bf_hi(ow); }
                    u32x4 o; o.x = cvt_pk_bf16(v0[0], v0[1]); o.y = cvt_pk_bf16(v0[2], v0[3]); o.z = cvt_pk_bf16(v1[0], v1[1]); o.w = cvt_pk_bf16(v1[2], v1[3]);
                    *(u32x4*)(O + (size_t)row * 1024 + c) = o; }
                asm volatile("" ::: "memory"); }
    }
};
template <size_t OFF> struct EpiF32 {
    static constexpr bool PERM = false, AFTER_DRAIN = false;
    const Args* a;
    __device__ __forceinline__ void operator()(const f32x4 (&acc)[2][2][4][2], const Unit& u, int wr, int wc, int fr_, int fq_) const {
        (void)fr_; (void)fq_; int ln_; asm volatile("v_mbcnt_lo_u32_b32 %0, -1, 0\n\tv_mbcnt_hi_u32_b32 %0, -1, %0" : "=v"(ln_)); const int fr = ln_ & 15, fq = ln_ >> 4;
        float* O = (float*)(wsptr(*a) + OFF);
        int row0 = u.pm * BM + wr * 64 + fr, col0 = u.pn * BM + wc * 32 + 4 * fq; asm volatile("" : "+v"(row0), "+v"(col0));
#pragma unroll
        for (int ai = 0; ai < 2; ++ai)
#pragma unroll
            for (int m = 0; m < 4; ++m) { float* rowp = O + (size_t)(row0 + ai * HALF + m * 16) * 1024 + col0;
#pragma unroll
                for (int bj = 0; bj < 2; ++bj)
#pragma unroll
                    for (int n = 0; n < 2; ++n) *(f32x4*)(rowp + bj * HALF + n * 16) = acc[ai][bj][m][n]; }
    }
};

template <class Epi, class Sched, bool ALIGN_EPI = false, bool SP2 = false>
__device__ __forceinline__ void gemm_phase(PG8_LAS unsigned char* lds, const Gemm g, const Sched& S, const Epi& E, int tid_in) {
    int tid_ = tid_in; asm volatile("" : "+v"(tid_));
    const int tid = tid_, wid = __builtin_amdgcn_readfirstlane(tid >> 6), lane = tid & 63, wr = wid >> 2, wc = wid & 3, fr = lane & 15, fq = lane >> 4;
    const int K = g.K, nt = K / BK;
    unsigned voffA[2], voffB[2];
#pragma unroll
    for (int i = 0; i < 2; ++i) { int R, C; stage_rc(tid * 16 + i * 8192, R, C); const int Rb = Epi::PERM ? ((R & ~31) + perm32(R & 31)) : R;
        voffA[i] = (unsigned)(R * g.lda + C) * 2u; voffB[i] = (unsigned)(Rb * K + C) * 2u; }
    const size_t kstep = (size_t)(BK * 2);
    const size_t hstepA = (size_t)HALF * g.lda * 2, hstepB = (size_t)HALF * K * 2;
    const size_t tstepA = 2 * hstepA, tstepB = 2 * hstepB;
    const unsigned ldsw = (unsigned)wid * 1024u;
    const int aoff = lds_byte(wr * 64 + fr, fq * 8), boff = lds_byte(wc * 32 + fr, fq * 8);
#define PG8_SA(b, h) (((b) * 2 + (h)) * HTB)
#define PG8_SB(b, h) ((4 + (b) * 2 + (h)) * HTB)
#define PG8_STAGE(bufoff, gbase, voff) do { _Pragma("unroll") for (int _i = 0; _i < 2; ++_i) \
        __builtin_amdgcn_global_load_lds((const unsigned*)((const char*)(gbase) + (voff)[_i]), (PG8_LAS unsigned*)(lds + (bufoff) + ldsw + _i * 8192), 16, 0, 0); } while (0)
#define PG8_LDA(dst, b, h) do { _Pragma("unroll") for (int m = 0; m < 4; ++m) _Pragma("unroll") for (int k = 0; k < 2; ++k) dst[m][k] = *(const PG8_LAS bf16x8*)(lds + PG8_SA(b, h) + aoff + m * 2048 + k * 1024); } while (0)
#define PG8_LDB(dst, b, h) do { _Pragma("unroll") for (int n = 0; n < 2; ++n) _Pragma("unroll") for (int k = 0; k < 2; ++k) dst[n][k] = *(const PG8_LAS bf16x8*)(lds + PG8_SB(b, h) + boff + n * 2048 + k * 1024); } while (0)
#define PG8_MMA(ai, bj, At, Bt) do { __builtin_amdgcn_s_setprio(1); _Pragma("unroll") for (int m = 0; m < 4; ++m) _Pragma("unroll") for (int n = 0; n < 2; ++n) _Pragma("unroll") for (int k = 0; k < 2; ++k) \
        acc[ai][bj][m][n] = __builtin_amdgcn_mfma_f32_16x16x32_bf16(Bt[n][k], At[m][k], acc[ai][bj][m][n], 0, 0, 0); __builtin_amdgcn_s_setprio(0); } while (0)
#define PG8_WAIT_V(n) asm volatile("s_waitcnt vmcnt(" #n ")" ::: "memory")
#define PG8_WAIT_L(n) asm volatile("s_waitcnt lgkmcnt(" #n ")" ::: "memory")
#define PG8_BAR __builtin_amdgcn_s_barrier()
#define PG8_SCHED __builtin_amdgcn_sched_barrier(0)
    Unit cur, nxt; int ui = 0;
    if (!S.next(0, cur)) return;
    f32x4 acc[2][2][4][2];
#pragma unroll
    for (int a = 0; a < 2; ++a)
#pragma unroll
        for (int b = 0; b < 2; ++b)
#pragma unroll
            for (int m = 0; m < 4; ++m)
#pragma unroll
                for (int n = 0; n < 2; ++n) acc[a][b][m][n] = (f32x4){0.f, 0.f, 0.f, 0.f};
    bf16x8 At[4][2], B0[2][2], B1[2][2];
    const char* cA = (const char*)g.A + (size_t)cur.pm * tstepA + cur.ao; const char* cB = (const char*)g.Bt + (size_t)cur.pn * tstepB;
    S.a_ready(cur);
    if constexpr (SP2) {
        PG8_STAGE(PG8_SB(0, 0), cB, voffB); PG8_STAGE(PG8_SB(0, 1), cB + hstepB, voffB); PG8_STAGE(PG8_SA(0, 0), cA, voffA); PG8_STAGE(PG8_SA(0, 1), cA + hstepA, voffA);
        if (wr == 1) PG8_BAR;
        PG8_WAIT_V(2); PG8_BAR;
        PG8_STAGE(PG8_SB(1, 0), cB + kstep, voffB); PG8_STAGE(PG8_SA(1, 0), cA + kstep, voffA); PG8_STAGE(PG8_SB(1, 1), cB + hstepB + kstep, voffB);
        PG8_WAIT_V(6); PG8_BAR;
    } else {
        PG8_STAGE(PG8_SB(0, 0), cB, voffB); PG8_STAGE(PG8_SA(0, 0), cA, voffA); PG8_STAGE(PG8_SB(0, 1), cB + hstepB, voffB); PG8_STAGE(PG8_SA(0, 1), cA + hstepA, voffA);
        if (wr == 1) PG8_BAR;
        PG8_WAIT_V(4); PG8_BAR;
        PG8_STAGE(PG8_SB(1, 0), cB + kstep, voffB); PG8_STAGE(PG8_SA(1, 0), cA + kstep, voffA); PG8_STAGE(PG8_SB(1, 1), cB + hstepB + kstep, voffB);
        PG8_WAIT_V(6); PG8_BAR;
    }
    for (;;) {
        const bool has_next = S.next(ui + 1, nxt);
        const char* nA = has_next ? (const char*)g.A + (size_t)nxt.pm * tstepA + nxt.ao : cA; const char* nB = has_next ? (const char*)g.Bt + (size_t)nxt.pn * tstepB : cB;
        for (int t = 0; t < nt; t += 2) {
            const bool last = (t == nt - 2);
            const char* a1 = cA + (size_t)(t + 1) * kstep;
            const char* a2 = last ? nA : cA + (size_t)(t + 2) * kstep; const char* b2 = last ? nB : cB + (size_t)(t + 2) * kstep;
            const char* a3 = a2 + kstep; const char* b3 = b2 + kstep;
            if (last && has_next) S.a_ready(nxt);
            if constexpr (SP2) {
            PG8_LDB(B0, 0, 0); PG8_LDB(B1, 0, 1); PG8_SCHED; PG8_LDA(At, 0, 0); PG8_STAGE(PG8_SA(1, 1), a1 + hstepA, voffA);
            PG8_WAIT_V(8); PG8_WAIT_L(0); PG8_BAR; PG8_MMA(0, 0, At, B0); PG8_MMA(0, 1, At, B1); PG8_BAR; PG8_SCHED;
            PG8_LDA(At, 0, 1); PG8_STAGE(PG8_SB(0, 0), b2, voffB); PG8_STAGE(PG8_SB(0, 1), b2 + hstepB, voffB); PG8_STAGE(PG8_SA(0, 0), a2, voffA);
            PG8_WAIT_V(8); PG8_WAIT_L(0); PG8_BAR; PG8_MMA(1, 0, At, B0); PG8_MMA(1, 1, At, B1); PG8_BAR; PG8_SCHED;
            PG8_LDB(B0, 1, 0); PG8_LDB(B1, 1, 1); PG8_SCHED; PG8_LDA(At, 1, 0); PG8_STAGE(PG8_SA(0, 1), a2 + hstepA, voffA);
            PG8_WAIT_V(8); PG8_WAIT_L(0); PG8_BAR; PG8_MMA(0, 0, At, B0); PG8_MMA(0, 1, At, B1); PG8_BAR; PG8_SCHED;
            PG8_LDA(At, 1, 1); PG8_STAGE(PG8_SB(1, 0), b3, voffB); PG8_STAGE(PG8_SB(1, 1), b3 + hstepB, voffB); PG8_STAGE(PG8_SA(1, 0), a3, voffA);
            PG8_WAIT_V(8); PG8_WAIT_L(0); PG8_BAR; PG8_MMA(1, 0, At, B0); PG8_MMA(1, 1, At, B1); PG8_BAR; PG8_SCHED;
            } else {
            PG8_LDB(B0, 0, 0); PG8_SCHED; PG8_LDA(At, 0, 0); PG8_STAGE(PG8_SA(1, 1), a1 + hstepA, voffA);
            PG8_WAIT_L(8); PG8_BAR; PG8_WAIT_L(0); PG8_MMA(0, 0, At, B0); PG8_BAR; PG8_SCHED;
            PG8_LDB(B1, 0, 1); PG8_STAGE(PG8_SB(0, 0), b2, voffB);
            PG8_BAR; PG8_WAIT_L(0); PG8_MMA(0, 1, At, B1); PG8_BAR;
            PG8_LDA(At, 0, 1); PG8_STAGE(PG8_SA(0, 0), a2, voffA);
            PG8_BAR; PG8_WAIT_L(0); PG8_MMA(1, 0, At, B0); PG8_BAR; PG8_SCHED;
            PG8_STAGE(PG8_SB(0, 1), b2 + hstepB, voffB);
            PG8_WAIT_V(6); PG8_BAR; PG8_MMA(1, 1, At, B1); PG8_BAR;
            PG8_LDB(B0, 1, 0); PG8_SCHED; PG8_LDA(At, 1, 0); PG8_STAGE(PG8_SA(0, 1), a2 + hstepA, voffA);
            PG8_WAIT_L(8); PG8_BAR; PG8_WAIT_L(0); PG8_MMA(0, 0, At, B0); PG8_BAR; PG8_SCHED;
            PG8_LDB(B1, 1, 1); PG8_STAGE(PG8_SB(1, 0), b3, voffB);
            PG8_BAR; PG8_WAIT_L(0); PG8_MMA(0, 1, At, B1); PG8_BAR;
            PG8_LDA(At, 1, 1); PG8_STAGE(PG8_SA(1, 0), a3, voffA);
            PG8_BAR; PG8_WAIT_L(0); PG8_MMA(1, 0, At, B0); PG8_BAR; PG8_SCHED;
            PG8_STAGE(PG8_SB(1, 1), b3 + hstepB, voffB);
            PG8_WAIT_V(6); PG8_BAR; PG8_MMA(1, 1, At, B1); PG8_BAR;
            }
        }
        if constexpr (ALIGN_EPI) { if (wr == 0) PG8_BAR; }
        if constexpr (!Epi::AFTER_DRAIN) { E(acc, cur, wr, wc, fr, fq); S.done(cur); }
        if (!has_next) break;
#pragma unroll
        for (int a = 0; a < 2; ++a)
#pragma unroll
            for (int b = 0; b < 2; ++b)
#pragma unroll
                for (int m = 0; m < 4; ++m)
#pragma unroll
                    for (int n = 0; n < 2; ++n) acc[a][b][m][n] = (f32x4){0.f, 0.f, 0.f, 0.f};
        cur = nxt; cA = nA; cB = nB; ++ui;
        if constexpr (ALIGN_EPI) { if (wr == 1) PG8_BAR; }
    }
    PG8_WAIT_V(0);
    if constexpr (!ALIGN_EPI) { if (wr == 0) PG8_BAR; }
    PG8_BAR;
    if constexpr (Epi::AFTER_DRAIN) { E.fused(acc, cur, wr, wc, fr, fq, lds, wid, lane); S.done(cur); }
#undef PG8_SA
#undef PG8_SB
#undef PG8_STAGE
#undef PG8_LDA
#undef PG8_LDB
#undef PG8_MMA
#undef PG8_WAIT_V
#undef PG8_WAIT_L
#undef PG8_BAR
#undef PG8_SCHED
}
}

#define GAS __attribute__((address_space(1)))
#define LAS __attribute__((address_space(3)))
typedef unsigned short bf16;
typedef unsigned v4u __attribute__((ext_vector_type(4)));
typedef float f32x4 __attribute__((ext_vector_type(4)));
typedef short bf16x8 __attribute__((ext_vector_type(8)));
typedef GAS unsigned gu32;
typedef GAS unsigned long long gu64;
#define RLX_AGENT __ATOMIC_RELAXED, __HIP_MEMORY_SCOPE_AGENT
#define LDS_WAIT() asm volatile("s_waitcnt lgkmcnt(0)" ::: "memory")
#define VM_WAIT() asm volatile("s_waitcnt vmcnt(0)" ::: "memory")
__device__ __forceinline__ unsigned long long rt() { return __builtin_amdgcn_s_memrealtime(); }
__device__ __forceinline__ unsigned f2bf(float f) { unsigned u = __builtin_bit_cast(unsigned, f); return (u + 0x7fffu + ((u >> 16) & 1u)) >> 16; }
__device__ __forceinline__ unsigned pk2(float lo, float hi) { return f2bf(lo) | (f2bf(hi) << 16); }

#define XB_TMO      128
#define XB_XCNT(j)  (256  + 64 * (j))
#define XB_XSUB(j)  (1280 + 64 * (j))
#define XB_XGEN(j)  (2304 + 64 * (j))
#define XB_TOP      3328
#define XB_TOPGEN   3392
#define XCD_BAR_WORDS 3456
#define XB_SPIN_CAP (1u << 18)

__device__ __forceinline__ unsigned xb_ld(unsigned* p)              { return __hip_atomic_load(p, __ATOMIC_RELAXED, __HIP_MEMORY_SCOPE_AGENT); }
__device__ __forceinline__ unsigned xb_add(unsigned* p, unsigned v) { return __hip_atomic_fetch_add(p, v, __ATOMIC_RELAXED, __HIP_MEMORY_SCOPE_AGENT); }
__device__ __forceinline__ unsigned xb_xcc_id() { return (unsigned)__builtin_amdgcn_s_getreg((3 << 11) | 20) & 0xFu; }
#define XB_SPIN(cond, bar) do { unsigned _sp = 0; while (cond) { __builtin_amdgcn_s_sleep(1); \
    if ((++_sp & 255u) == 0u) { if (xb_ld(&(bar)[XB_TMO])) break; if (_sp > XB_SPIN_CAP) { atomicAdd(&(bar)[XB_TMO], 1u); break; } } } } while (0)

struct XcdBarrier {
    unsigned* bar; unsigned x;
    volatile LAS unsigned* st;
};

__device__ __forceinline__ XcdBarrier xcd_barrier_post(unsigned* bar, volatile LAS unsigned* st) {
    XcdBarrier b; b.bar = bar; b.x = xb_xcc_id(); b.st = st;
    if (threadIdx.x == 0) (void)xb_add(&bar[XB_XCNT(b.x)], 1u);
    return b;
}
__device__ __forceinline__ void xcd_barrier_complete(unsigned* bar, unsigned x, unsigned& nloc, unsigned& nx) {
    const unsigned G = gridDim.x * gridDim.y * gridDim.z;
    unsigned sum, cnt, mine, sp = 0u;
    for (;;) {
        sum = 0u; cnt = 0u; mine = 0u;
#pragma unroll
        for (unsigned j = 0; j < 16; ++j) { const unsigned c = xb_ld(&bar[XB_XCNT(j)]); sum += c; cnt += (c > 0u) ? 1u : 0u; mine = (j == x) ? c : mine; }
        if (sum == G) break;
        __builtin_amdgcn_s_sleep(1);
        if ((++sp & 255u) == 0u) { if (xb_ld(&bar[XB_TMO])) break; if (sp > XB_SPIN_CAP) { atomicAdd(&bar[XB_TMO], 1u); break; } }
    }
    nloc = mine > 0u ? mine : 1u; nx = cnt > 0u ? cnt : 1u;
}

__device__ __forceinline__ void xcd_barrier(const XcdBarrier& b) {
    asm volatile("s_waitcnt vmcnt(0)" ::: "memory");
    __syncthreads();
    if (threadIdx.x == 0) {
        unsigned* bar = b.bar;
        __builtin_amdgcn_s_waitcnt(0);
        unsigned nloc = b.st[0], nx = b.st[1];
        if (nloc == 0u) { xcd_barrier_complete(bar, b.x, nloc, nx); b.st[0] = nloc; b.st[1] = nx; }
        const unsigned old = xb_add(&bar[XB_XSUB(b.x)], 1u);
        const unsigned gen = old / nloc;
        if (old + 1u == (gen + 1u) * nloc) {
            __builtin_amdgcn_fence(__ATOMIC_RELEASE, "agent");
            asm volatile("s_waitcnt vmcnt(0)" ::: "memory");
            const unsigned og = xb_add(&bar[XB_TOP], 1u);
            const unsigned tg = og / nx;
            if (og + 1u == (tg + 1u) * nx) xb_add(&bar[XB_TOPGEN], 1u);
            else XB_SPIN(xb_ld(&bar[XB_TOPGEN]) == tg, bar);
            __builtin_amdgcn_fence(__ATOMIC_ACQUIRE, "agent");
            xb_add(&bar[XB_XGEN(b.x)], 1u);
            asm volatile("s_waitcnt vmcnt(0)" ::: "memory");
        } else {
            XB_SPIN(xb_ld(&bar[XB_XGEN(b.x)]) == gen, bar);
            __builtin_amdgcn_fence(__ATOMIC_ACQUIRE, "agent");
            asm volatile("s_waitcnt vmcnt(0)" ::: "memory");
        }
    }
    __syncthreads();
}

namespace att {
using bf16 = unsigned short;
typedef short bf16x8 __attribute__((ext_vector_type(8)));
typedef short s16x4 __attribute__((ext_vector_type(4)));
typedef float f32x16 __attribute__((ext_vector_type(16)));
typedef float f32x4 __attribute__((ext_vector_type(4)));
typedef unsigned u32x4 __attribute__((ext_vector_type(4)));
constexpr int DQK = 96, DV = 64, NW = 8, QBLK = 32, KVBLK = 64, QB = NW * QBLK;
constexpr int QP = 768, KP = 768, VP = 512, OP = 1536;
constexpr int SHM_V = KVBLK * DV * 2  , SHM_K = KVBLK * 256  ;
constexpr int LDS_BYTES = 2 * SHM_V + 2 * SHM_K + NW * 64 * 4;
constexpr float SCALE = 0.10206207261596575f;
constexpr float THR = 8.f;
#define KSWZ(row, colB) ((row) * 256 + ((colB) ^ (((row) & 7) << 4)))
#define SBAR() __builtin_amdgcn_sched_barrier(0)
__device__ __forceinline__ int v_st(int k, int c) { const int kk = (k & ~0xC) | ((k & 4) << 1) | ((k & 8) >> 1); return ((kk >> 3) * 2 + (c >> 5)) * 512 + ((kk & 7) * 32 + (c & 31)) * 2; }
__device__ __forceinline__ int v_rd_base(int lane) { return ((lane & 3) << 3) | (((lane >> 2) & 3) << 6) | (((lane >> 4) & 1) << 5) | (((lane >> 5) & 1) << 8); }
__device__ __forceinline__ int crow(int r, int hi) { return (r & 3) + 8 * (r >> 2) + 4 * hi; }
typedef float f32x2_t __attribute__((ext_vector_type(2))); typedef __bf16 bf16x2_t __attribute__((ext_vector_type(2)));
__device__ __forceinline__ unsigned cvtpk(float lo, float hi) { f32x2_t v = {lo, hi}; bf16x2_t b = __builtin_convertvector(v, bf16x2_t); return __builtin_bit_cast(unsigned, b); }
__device__ __forceinline__ void mask_tile(f32x16& p0, f32x16& p1, int dq) {
    const float NEG = -__builtin_inff();
#pragma unroll
    for (int r = 0; r < 16; ++r) { const int c = (r & 3) + 8 * (r >> 2); if (dq - c < 0) p0[r] = NEG; if (dq - c - 32 < 0) p1[r] = NEG; }
}
__device__ __forceinline__ void partialSM(f32x16& p0, f32x16& p1, float& m_reg, float& mn, float& alpha) {
    float pmax = p0[0];
#pragma unroll
    for (int r = 1; r < 16; ++r) pmax = fmaxf(pmax, p0[r]);
#pragma unroll
    for (int r = 0; r < 16; ++r) pmax = fmaxf(pmax, p1[r]);
    { auto rr = __builtin_amdgcn_permlane32_swap(__float_as_uint(pmax), __float_as_uint(pmax), false, false);
      pmax = fmaxf(__uint_as_float(rr[0]), __uint_as_float(rr[1])); }
    constexpr float C2 = 1.4426950408889634f * SCALE;
    if (__builtin_expect(__all((pmax - m_reg) * SCALE <= THR), 1)) { mn = m_reg; alpha = 1.f; }
    else { mn = fmaxf(m_reg, pmax); alpha = __builtin_amdgcn_exp2f((m_reg - mn) * C2); m_reg = mn; }
    const float mnL = -mn * C2;
#pragma unroll
    for (int r = 0; r < 16; ++r) p0[r] = fmaf(p0[r], C2, mnL);
#pragma unroll
    for (int r = 0; r < 16; ++r) p1[r] = fmaf(p1[r], C2, mnL);
#pragma unroll
    for (int r = 0; r < 16; ++r) p0[r] = __builtin_amdgcn_exp2f(p0[r]);
}
__device__ __forceinline__ void finishSM(f32x16& p0, f32x16& p1, float alpha, float& l_reg, bf16x8& pa0, bf16x8& pa1, bf16x8& pa2, bf16x8& pa3) {
#pragma unroll
    for (int r = 0; r < 16; ++r) p1[r] = __builtin_amdgcn_exp2f(p1[r]);
    float ps = 0;
#pragma unroll
    for (int r = 0; r < 16; ++r) ps += p0[r];
#pragma unroll
    for (int r = 0; r < 16; ++r) ps += p1[r];
    { auto rr = __builtin_amdgcn_permlane32_swap(__float_as_uint(ps), __float_as_uint(ps), false, false);
      ps = __uint_as_float(rr[0]) + __uint_as_float(rr[1]); }
    l_reg = l_reg * alpha + ps;
#define PK4(P, B_, OUT) do { unsigned a0 = cvtpk(P[B_+0], P[B_+1]), a1 = cvtpk(P[B_+2], P[B_+3]);                          \
        unsigned b0 = cvtpk(P[B_+4], P[B_+5]), b1 = cvtpk(P[B_+6], P[B_+7]);                                             \
        auto r0 = __builtin_amdgcn_permlane32_swap(a0, b0, false, false); auto r1 = __builtin_amdgcn_permlane32_swap(a1, b1, false, false); \
        u32x4 w = {r0[0], r1[0], r0[1], r1[1]}; OUT = *reinterpret_cast<bf16x8*>(&w); } while (0)
    PK4(p0, 0, pa0); PK4(p0, 8, pa1); PK4(p1, 0, pa2); PK4(p1, 8, pa3);
#undef PK4
}
template <int KB>
__device__ __forceinline__ void qkt(f32x16& p0, f32x16& p1, const char* K_lds, int r32, int hi, const bf16x8* qr) {
    p0 = f32x16{}; p1 = f32x16{};
    const char* kb[4];
#pragma unroll
    for (int dd = 0; dd < 4; ++dd) kb[dd] = K_lds + KB * SHM_K + KSWZ(r32, (dd * 16 + hi * 8) * 2);
#pragma unroll
    for (int d0 = 0; d0 < 6; ++d0) { const char* a = kb[d0 & 3] + (d0 >> 2) * 128;
        bf16x8 b0 = *reinterpret_cast<const bf16x8*>(a);
        bf16x8 b1 = *reinterpret_cast<const bf16x8*>(a + 32 * 256);
        p0 = __builtin_amdgcn_mfma_f32_32x32x16_bf16(b0, qr[d0], p0, 0, 0, 0);
        p1 = __builtin_amdgcn_mfma_f32_32x32x16_bf16(b1, qr[d0], p1, 0, 0, 0); }
}
template <int VB>
__device__ __forceinline__ void pv_tile(f32x16* o, int vb0, bf16x8 pa0, bf16x8 pa1, bf16x8 pa2, bf16x8 pa3) {
#define TRRD(dst, off) asm volatile("ds_read_b64_tr_b16 %0, %1 offset:%2" : "=&v"(dst) : "v"(vb0), "i"(off) : "memory")
#define PV_D0(d0) do { s16x4 l0, l1, l2, l3, h0, h1, h2, h3; constexpr int b_ = VB * SHM_V + (d0) * 512;   \
        TRRD(l0, b_); TRRD(h0, b_ + 1024); TRRD(l1, b_ + 2048); TRRD(h1, b_ + 3072); TRRD(l2, b_ + 4096); TRRD(h2, b_ + 5120); TRRD(l3, b_ + 6144); TRRD(h3, b_ + 7168); \
        asm volatile("s_waitcnt lgkmcnt(0)" ::: "memory"); SBAR();   \
        o[d0] = __builtin_amdgcn_mfma_f32_32x32x16_bf16(pa0, (bf16x8){l0[0], l0[1], l0[2], l0[3], h0[0], h0[1], h0[2], h0[3]}, o[d0], 0, 0, 0);   \
        o[d0] = __builtin_amdgcn_mfma_f32_32x32x16_bf16(pa1, (bf16x8){l1[0], l1[1], l1[2], l1[3], h1[0], h1[1], h1[2], h1[3]}, o[d0], 0, 0, 0);   \
        o[d0] = __builtin_amdgcn_mfma_f32_32x32x16_bf16(pa2, (bf16x8){l2[0], l2[1], l2[2], l2[3], h2[0], h2[1], h2[2], h2[3]}, o[d0], 0, 0, 0);   \
        o[d0] = __builtin_amdgcn_mfma_f32_32x32x16_bf16(pa3, (bf16x8){l3[0], l3[1], l3[2], l3[3], h3[0], h3[1], h3[2], h3[3]}, o[d0], 0, 0, 0); } while (0)
    PV_D0(0); PV_D0(1);
#undef PV_D0
#undef TRRD
}
struct BlockRef { const bf16* Q; const bf16* K; const bf16* V; bf16* O; int P0; };
struct Seam { bf16x8 qr[6]; bf16x8 st_v, st_k0, st_k1; };
#define VMW() asm volatile("s_waitcnt vmcnt(0)" ::: "memory")
#define VMWN(n) asm volatile("s_waitcnt vmcnt(%0)" :: "i"(n) : "memory")
#define SLOAD(Kp_, Vp_, k0) do { S.st_v = *(const bf16x8*)((Vp_) + (size_t)((k0) + vr) * VP + vc);                                   \
        if (kact) { S.st_k0 = *(const bf16x8*)((Kp_) + (size_t)((k0) + sr) * KP + kc); S.st_k1 = *(const bf16x8*)((Kp_) + (size_t)((k0) + 32 + sr) * KP + kc); } } while (0)
#define SWRITE_K(bf) do { if (kact) { *(bf16x8*)(K_lds + (bf) * SHM_K + kws) = S.st_k0; *(bf16x8*)(K_lds + (bf) * SHM_K + kws + 32 * 256) = S.st_k1; } } while (0)
#define SWRITE_V(bf) do { *(bf16x8*)(V_lds + (bf) * SHM_V + vst) = S.st_v; } while (0)
#define STG_DECL const int sr = tid >> 4, kc = ((tid & 15) < 12 ? (tid & 15) : 11) * 8; const bool kact = true; const int kws = KSWZ(sr, kc * 2); \
        const int vr = tid >> 3, vc = (tid & 7) * 8, vst = v_st(vr, vc);
__device__ __forceinline__ void attn_prime(const BlockRef& cur, char* lds, Seam& S, int tid_in) {
    int tid_ = tid_in; asm volatile("" : "+v"(tid_)); const int tid = tid_, wid = __builtin_amdgcn_readfirstlane(tid >> 6), lane = tid & 63, r32 = lane & 31, hi = lane >> 5;
    STG_DECL; (void)vst; char* K_lds = lds + 2 * SHM_V;
#pragma unroll
    for (int d0 = 0; d0 < 6; ++d0) S.qr[d0] = *(const bf16x8*)(cur.Q + (size_t)(wid * QBLK + r32) * QP + d0 * 16 + hi * 8);
    SLOAD(cur.K, cur.V, 0); VMW(); SWRITE_K(0);
    __syncthreads();
}
__device__ __forceinline__ void attn_block(const BlockRef& cur, const BlockRef& nxt, char* lds, Seam& S, int tid_in) {
    int tid_ = tid_in; asm volatile("" : "+v"(tid_)); const int tid = tid_, wid = __builtin_amdgcn_readfirstlane(tid >> 6), lane = tid & 63, r32 = lane & 31, hi = lane >> 5;
    const int NT = (cur.P0 + QB) / KVBLK;
    const int qlo = cur.P0 + wid * QBLK, qm = qlo + r32 - 4 * hi;
    char* V_lds = lds; char* K_lds = lds + 2 * SHM_V;
    float* ws = (float*)(lds + 2 * SHM_V + 2 * SHM_K) + wid * 64; float* li_l = ws, * al_l = ws + 32;
    float m_reg = -1e30f, l_reg = 0; f32x16 o[2] = {};
    STG_DECL;
    const int vb0 = (int)(uintptr_t)V_lds + v_rd_base(lane);
    const bf16* Kh = cur.K; const bf16* Vh = cur.V;
#define RESC(a) do { if (__any((a) < 1.f)) { if (hi == 0) al_l[r32] = (a); asm volatile("s_waitcnt lgkmcnt(0)" ::: "memory");              \
                     _Pragma("unroll") for (int d_ = 0; d_ < 2; ++d_) _Pragma("unroll") for (int r = 0; r < 16; ++r) o[d_][r] *= al_l[crow(r, hi)]; } } while (0)
#define KBASE(t) ((t) * KVBLK)
#define MASKT(P0_, P1_, t) do { const int kb_ = KBASE(t); if (kb_ + KVBLK - 1 > qlo) mask_tile(P0_, P1_, qm - kb_); } while (0)
    constexpr int NQL = 6;
#define SEAM_K0() do { VMWN(NQL); SWRITE_K(0); SBAR(); } while (0)
    f32x16 pA0, pA1, pB0, pB1; float mnA, mnB, alA, alB; bf16x8 pa0, pa1, pa2, pa3;
    SWRITE_V(0); SBAR();
    if (NT > 1) { SLOAD(Kh, Vh, KBASE(1)); }
    SBAR(); qkt<0>(pA0, pA1, K_lds, r32, hi, S.qr);
    MASKT(pA0, pA1, 0); partialSM(pA0, pA1, m_reg, mnA, alA);
    if (NT > 1) { VMW(); SWRITE_V(1); SWRITE_K(1); }
    __syncthreads();
#define HALF_STEP(PX0, PX1, mnX, alX, PY0, PY1, alY, t, KB, VB, SB) do {                                                      \
        SBAR(); qkt<KB>(PX0, PX1, K_lds, r32, hi, S.qr);                                                                      \
        finishSM(PY0, PY1, alY, l_reg, pa0, pa1, pa2, pa3); SBAR();                                                           \
        if ((t) + 1 < NT) { SLOAD(Kh, Vh, KBASE((t) + 1)); SBAR(); }                                                          \
        pv_tile<VB>(o, vb0, pa0, pa1, pa2, pa3); MASKT(PX0, PX1, (t)); partialSM(PX0, PX1, m_reg, mnX, alX);                  \
        __syncthreads();                                                                                                      \
        if ((t) + 1 < NT) { VMW(); SWRITE_V(SB); SWRITE_K(SB); }                                                              \
        RESC(alX); __syncthreads(); } while (0)
    for (int t = 1; t + 1 < NT; t += 2) {
        HALF_STEP(pB0, pB1, mnB, alB, pA0, pA1, alA, t, 1, 0, 0);
        HALF_STEP(pA0, pA1, mnA, alA, pB0, pB1, alB, t + 1, 0, 1, 1);
    }
    SBAR(); qkt<1>(pB0, pB1, K_lds, r32, hi, S.qr); SBAR();
    SLOAD(nxt.K, nxt.V, 0); SBAR();
#pragma unroll
    for (int d0 = 0; d0 < 6; ++d0) S.qr[d0] = *(const bf16x8*)(nxt.Q + (size_t)(wid * QBLK + r32) * QP + d0 * 16 + hi * 8);
    SBAR();
    finishSM(pA0, pA1, alA, l_reg, pa0, pa1, pa2, pa3); SBAR();
    pv_tile<0>(o, vb0, pa0, pa1, pa2, pa3);
    MASKT(pB0, pB1, NT - 1); partialSM(pB0, pB1, m_reg, mnB, alB); __syncthreads(); RESC(alB);
    finishSM(pB0, pB1, alB, l_reg, pa0, pa1, pa2, pa3); SBAR(); pv_tile<1>(o, vb0, pa0, pa1, pa2, pa3);
    SBAR(); SEAM_K0();
    if (hi == 0) li_l[r32] = l_reg; asm volatile("s_waitcnt lgkmcnt(0)" ::: "memory");
    float rli[16];
#pragma unroll
    for (int r = 0; r < 16; ++r) rli[r] = __builtin_amdgcn_rcpf(li_l[crow(r, hi)]);
    bf16* Ow = cur.O + (size_t)(wid * QBLK) * OP;
#pragma unroll
    for (int r = 0; r < 16; ++r) { const int orow = crow(r, hi);
#pragma unroll
        for (int d0 = 0; d0 < 2; ++d0) { const float v = o[d0][r] * rli[r];
            const float vn = __int_as_float(__builtin_amdgcn_mov_dpp(__float_as_int(v), 0xB1, 0xf, 0xf, true));
            if ((r32 & 1) == 0) *(unsigned*)(Ow + (size_t)orow * OP + d0 * 32 + r32) = cvtpk(v, vn); } }
    __syncthreads();
#undef RESC
#undef KBASE
#undef MASKT
#undef SEAM_K0
#undef HALF_STEP
}
#undef VMW
#undef VMWN
#undef SLOAD
#undef SWRITE_K
#undef SWRITE_V
#undef STG_DECL
#undef SBAR
}


template <int O> __device__ __forceinline__ float swz_xor(float v) { return __int_as_float(__builtin_amdgcn_ds_swizzle(__float_as_int(v), (O << 10) | 0x1f)); }
__device__ __forceinline__ float half_sum(float v) { auto rr = __builtin_amdgcn_permlane32_swap(__float_as_uint(v), __float_as_uint(v), false, false); return __uint_as_float(rr[0]) + __uint_as_float(rr[1]); }
__device__ __forceinline__ float wave_sum(float v) {
    v += swz_xor<1>(v); v += swz_xor<2>(v); v += swz_xor<4>(v); v += swz_xor<8>(v); v += swz_xor<16>(v);
    return half_sum(v);
}
__device__ __forceinline__ float bf2f(bf16 h) { return __uint_as_float((unsigned)h << 16); }
__device__ __forceinline__ float gelu_tanh(float x) { const float z = 1.5957691216057308f * (x + 0.044715f * x * x * x); return x * __builtin_amdgcn_rcpf(1.0f + __builtin_amdgcn_exp2f(-1.4426950408889634f * z)); }
__device__ __forceinline__ float sigm(float x) { return __builtin_amdgcn_rcpf(1.0f + __builtin_amdgcn_exp2f(-1.4426950408889634f * x)); }
__device__ __forceinline__ void unpack8(const v4u w, float* f) { f[0] = __uint_as_float(w.x << 16); f[1] = __uint_as_float(w.x & 0xffff0000u); f[2] = __uint_as_float(w.y << 16); f[3] = __uint_as_float(w.y & 0xffff0000u);
    f[4] = __uint_as_float(w.z << 16); f[5] = __uint_as_float(w.z & 0xffff0000u); f[6] = __uint_as_float(w.w << 16); f[7] = __uint_as_float(w.w & 0xffff0000u); }
__device__ __forceinline__ v4u pack8f(const float* f) { v4u o; o.x = pk2(f[0], f[1]); o.y = pk2(f[2], f[3]); o.z = pk2(f[4], f[5]); o.w = pk2(f[6], f[7]); return o; }

__device__ __forceinline__ int il2(int i, int half) { return i < half ? 2 * i : 2 * (i - half) + 1; }
__device__ __forceinline__ int dstrow(int kind, int s) {
    if (kind == 0) return s;
    if (kind == 1) {
        if (s < 1024) return s;
        if (s < 2048) { const int base = s < 1536 ? 1024 : 1536, w = s - base; return base + (w & ~63) + il2(w & 63, 32); }
        if (s < 3712) return s;
        if (s < 3744) return 3712 + il2(s - 3712, 16);
        return 3840 + (s - 3744);
    }
    if (kind == 3) { const int hd = s / 96, w = s - hd * 96; return w < 64 ? s : hd * 96 + 64 + il2(w - 64, 16); }
    { const int t = s < 2816 ? s : s - 2816; return (t >> 7) * 256 + (t & 127) + (s < 2816 ? 0 : 128); }
}
__device__ __forceinline__ void conv_item(const float* W, int K, int Nsrc, bf16* WT, int kind, const float* ksc, LAS float* scr, int item, int nblk, int lane) {
    const int kb = item / nblk, nb = item - kb * nblk, k0 = 64 * kb, s0 = 32 * nb;
    const int j4 = (lane & 7) * 4, kr = lane >> 3;
#pragma unroll
    for (int i = 0; i < 8; ++i) { const int kk = 8 * i + kr; f32x4 v = *(const f32x4*)(W + (size_t)(k0 + kk) * Nsrc + s0 + j4); if (ksc) v = v * ksc[k0 + kk];
        scr[kk * 33 + j4] = v.x; scr[kk * 33 + j4 + 1] = v.y; scr[kk * 33 + j4 + 2] = v.z; scr[kk * 33 + j4 + 3] = v.w; }
    LDS_WAIT(); asm volatile("" ::: "memory");
    const int c = lane & 7;
#pragma unroll
    for (int j = 0; j < 4; ++j) { const int n = (lane >> 3) + 8 * j; const LAS float* s = scr + (8 * c) * 33 + n;
        v4u o; o.x = pk2(s[0 * 33], s[1 * 33]); o.y = pk2(s[2 * 33], s[3 * 33]); o.z = pk2(s[4 * 33], s[5 * 33]); o.w = pk2(s[6 * 33], s[7 * 33]);
        *(GAS v4u*)(WT + (size_t)dstrow(kind, s0 + n) * K + k0 + 8 * c) = o; }
    LDS_WAIT(); asm volatile("" ::: "memory");
}
__device__ __forceinline__ int conv_matrix(const Ctx& X, LAS unsigned char* lds, int base, const float* W, int K, int Nsrc, bf16* WT, int kind, const float* ksc) {
    LAS float* scr = (LAS float*)(lds + X.wave * 16384);
    const int gw = X.vcu * NWAVES + X.wave, NGW = X.G * NWAVES, nblk = Nsrc / 32, nitems = (K / 64) * nblk;
    int first = (gw - base) % NGW; if (first < 0) first += NGW;
    for (int it = first; it < nitems; it += NGW) conv_item(W, K, Nsrc, WT, kind, ksc, scr, it, nblk, X.lane);
    return base + nitems;
}
__device__ __forceinline__ void convert_mixer(const Ctx& X, LAS unsigned char* lds, const Args& a, int l) {
    bf16* Wb = (bf16*)(wsptr(a) + WS_W); int base = 0;
    base = conv_matrix(X, lds, base, (const float*)inptr(a, I_WIN) + (size_t)l * 1024 * NIN, 1024, NIN, (bf16*)((char*)Wb + WO_IN), 1, nullptr);
    base = conv_matrix(X, lds, base, (const float*)inptr(a, I_WOUT) + (size_t)l * 1024 * 1024, 1024, 1024, (bf16*)((char*)Wb + WO_OUT), 0, nullptr);
    base = conv_matrix(X, lds, base, (const float*)inptr(a, I_LWO) + (size_t)l * 512 * 1024, 512, 1024, (bf16*)((char*)Wb + WO_O3), 0, nullptr);
    base = conv_matrix(X, lds, base, (const float*)inptr(a, I_RWO) + (size_t)l * 512 * 1024, 512, 1024, (bf16*)((char*)Wb + WO_O3) + 1024 * 512, 0, nullptr);
    base = conv_matrix(X, lds, base, (const float*)inptr(a, I_MWO) + (size_t)l * 512 * 1024, 512, 1024, (bf16*)((char*)Wb + WO_O3) + 2 * 1024 * 512, 0, nullptr);
    base = conv_matrix(X, lds, base, (const float*)inptr(a, I_WUQ) + (size_t)l * 384 * 768, 384, 768, (bf16*)((char*)Wb + WO_UQ), 3, (const float*)inptr(a, I_QNG) + l * 384);
    base = conv_matrix(X, lds, base, (const float*)inptr(a, I_WUKV) + (size_t)l * 256 * 1024, 256, 1024, (bf16*)((char*)Wb + WO_UKV), 0, (const float*)inptr(a, I_KVNG) + l * 256);
#pragma unroll 1
    for (int blk = 0; blk < 8; ++blk) {
        base = conv_matrix(X, lds, base, (const float*)inptr(a, I_LWA) + (size_t)(l * 8 + blk) * 4096, 64, 64, (bf16*)((char*)Wb + WO_AT) + blk * 4096, 0, nullptr);
        base = conv_matrix(X, lds, base, (const float*)inptr(a, I_LWX) + (size_t)(l * 8 + blk) * 4096, 64, 64, (bf16*)((char*)Wb + WO_XT) + blk * 4096, 0, nullptr);
    }
    { const int gt = X.vcu * 512 + X.tid, nth = X.G * 512; const unsigned zz = (unsigned)opaque_u(0); v4u z; z.x = zz; z.y = zz; z.z = zz; z.w = zz;
      for (int i = gt; i < 96 * 128; i += nth) *(GAS v4u*)((bf16*)((char*)Wb + WO_IN) + (size_t)3744 * 1024 + (size_t)i * 8) = z; }
}
__device__ __forceinline__ void convert_ffn(const Ctx& X, LAS unsigned char* lds, const Args& a, int l) {
    bf16* Wb = (bf16*)(wsptr(a) + WS_W); int base = 0;
    base = conv_matrix(X, lds, base, (const float*)inptr(a, I_WUP) + (size_t)l * 1024 * 5632, 1024, 5632, (bf16*)((char*)Wb + WO_UP), 4, nullptr);
    base = conv_matrix(X, lds, base, (const float*)inptr(a, I_WDOWN) + (size_t)l * 2816 * 1024, 2816, 1024, (bf16*)((char*)Wb + WO_DOWN), 0, nullptr);
}

__device__ __forceinline__ void p_mods(const Ctx& X, LAS unsigned char* lds, const Args& a) {
    LAS float* cact = (LAS float*)lds; LAS float* red = (LAS float*)(lds + 8192);
    const float* c = (const float*)inptr(a, I_C);
    for (int i = X.tid; i < NB * 1024; i += 512) { const float v = c[i]; cact[i] = v * sigm(v); }
    __syncthreads();
    float* MOD = (float*)(wsptr(a) + WS_MOD);
    const float* adaw = (const float*)inptr(a, I_ADAW); const float* adab = (const float*)inptr(a, I_ADAB);
    for (int it = X.vcu; it < DEPTH * 96; it += X.G) {
        const int l = it / 96, j0 = (it - l * 96) * 64, cl = X.tid & 63, ks = X.tid >> 6;
        const float* w = adaw + (size_t)l * 1024 * 6144 + j0 + cl;
        float a0 = 0.f, a1 = 0.f;
#pragma unroll 8
        for (int k = ks * 128; k < ks * 128 + 128; ++k) { const float wv = w[(size_t)k * 6144]; a0 += cact[k] * wv; a1 += cact[1024 + k] * wv; }
        red[(ks * 64 + cl) * 2] = a0; red[(ks * 64 + cl) * 2 + 1] = a1;
        __syncthreads();
        if (X.tid < 128) { const int cc = X.tid & 63, b = X.tid >> 6; float s = 0.f;
#pragma unroll
            for (int q = 0; q < 8; ++q) s += red[(q * 64 + cc) * 2 + b];
            MOD[(size_t)(l * NB + b) * 6144 + j0 + cc] = s + adab[l * 6144 + j0 + cc]; }
        __syncthreads();
    }
}
__device__ __forceinline__ void p_rope(const Ctx& X, const Args& a) {
    float* cr = (float*)(wsptr(a) + WS_ROPE); float* sr = cr + (size_t)M * 32; float* cm = sr + (size_t)M * 32; float* sm = cm + (size_t)M * 16;
    const int* pos = (const int*)inptr(a, I_POS);
    const int nth = X.G * 512;
    for (int idx = X.vcu * 512 + X.tid; idx < M * 32; idx += nth) {
        const int row = idx >> 5, i = idx & 31;
        const double ang = (double)pos[row] * INVR[i];
        const double k = __builtin_rint(ang * 0.15915494309189535);
        double r = __builtin_fma(-k, 6.283185307179586, ang); r = __builtin_fma(-k, 2.4492935982947064e-16, r);
        const float rf = (float)r; const float sn = sinf(rf), cs = cosf(rf);
        cr[idx] = cs; sr[idx] = sn;
        if ((i & 1) == 0) { cm[row * 16 + (i >> 1)] = cs; sm[row * 16 + (i >> 1)] = sn; }
    }
}

template <int MODE, bool HAS_NEXT>
__device__ __forceinline__ void row_pass(const Ctx& X, const float* xin, float* xout, const bf16* Y, const float* gpost, const float* gate  ,
                                         const float* gpre, const float* shift, const float* scale, bf16* XN) {
    const int gw = X.vcu * NWAVES + X.wave, NGW = X.G * NWAVES, lane = X.lane;
    for (int b = 0; b < NB; ++b) {
        f32x4 vgp[4], vgt[4], vpre[4], vsh[4], vsc[4];
#pragma unroll
        for (int j = 0; j < 4; ++j) { const int cidx = 4 * lane + 256 * j;
            if (MODE == 1) { vgp[j] = *(const f32x4*)(gpost + cidx); vgt[j] = *(const f32x4*)(gate + (size_t)b * 6144 + cidx); }
            if (MODE == 0 || HAS_NEXT) { vpre[j] = *(const f32x4*)(gpre + cidx); vsh[j] = *(const f32x4*)(shift + (size_t)b * 6144 + cidx); vsc[j] = *(const f32x4*)(scale + (size_t)b * 6144 + cidx) + 1.0f; } }
        for (int m = gw; m < SEQ; m += NGW) { const size_t row = (size_t)b * SEQ + m;
            f32x4 xv[4];
#pragma unroll
            for (int j = 0; j < 4; ++j) xv[j] = *(const f32x4*)(xin + row * 1024 + 4 * lane + 256 * j);
            if (MODE == 1) { f32x4 yv[4]; float s = 0.f;
#pragma unroll
                for (int j = 0; j < 4; ++j) { const u32x2 yw = *(const u32x2*)(Y + row * 1024 + 4 * lane + 256 * j); yv[j].x = __uint_as_float(yw.x << 16); yv[j].y = __uint_as_float(yw.x & 0xffff0000u); yv[j].z = __uint_as_float(yw.y << 16); yv[j].w = __uint_as_float(yw.y & 0xffff0000u); s += (yv[j].x * yv[j].x + yv[j].y * yv[j].y) + (yv[j].z * yv[j].z + yv[j].w * yv[j].w); }
                const float rs = __builtin_amdgcn_rsqf(wave_sum(s) * (1.0f / 1024.0f) + EPS);
#pragma unroll
                for (int j = 0; j < 4; ++j) { xv[j] = xv[j] + vgt[j] * (yv[j] * rs * vgp[j]); *(f32x4*)(xout + row * 1024 + 4 * lane + 256 * j) = xv[j]; } }
            if (MODE == 0 || HAS_NEXT) { float s = 0.f;
#pragma unroll
                for (int j = 0; j < 4; ++j) s += (xv[j].x * xv[j].x + xv[j].y * xv[j].y) + (xv[j].z * xv[j].z + xv[j].w * xv[j].w);
                const float rs = __builtin_amdgcn_rsqf(wave_sum(s) * (1.0f / 1024.0f) + EPS);
#pragma unroll
                for (int j = 0; j < 4; ++j) { const f32x4 h = (xv[j] * rs * vpre[j]) * vsc[j] + vsh[j];
                    u32x2 w; w.x = pk2(h.x, h.y); w.y = pk2(h.z, h.w); *(u32x2*)(XN + row * 1024 + 4 * lane + 256 * j) = w; } }
        }
    }
}

__device__ __forceinline__ void p_mla_rstd(const Ctx& X, const Args& a) {
    const bf16* TM = (const bf16*)(wsptr(a) + WS_TM); float* RSTD = (float*)(wsptr(a) + WS_RSTD);
    const int gw = X.vcu * NWAVES + X.wave, NGW = X.G * NWAVES, lane = X.lane;
    for (int m0 = gw * 4; m0 < M; m0 += NGW * 4) {
        u32x2 w[4][3];
#pragma unroll
        for (int r = 0; r < 4; ++r)
#pragma unroll
            for (int k = 0; k < 3; ++k) w[r][k] = *(const u32x2*)(TM + (size_t)(m0 + r) * 768 + k * 256 + lane * 4);
#pragma unroll
        for (int r = 0; r < 4; ++r) { float sq = 0.f, skv = 0.f;
#pragma unroll
            for (int k = 0; k < 3; ++k) { const float f0 = __uint_as_float(w[r][k].x << 16), f1 = __uint_as_float(w[r][k].x & 0xffff0000u), f2 = __uint_as_float(w[r][k].y << 16), f3 = __uint_as_float(w[r][k].y & 0xffff0000u);
                const float s = (f0 * f0 + f1 * f1) + (f2 * f2 + f3 * f3);
                if (k == 0) sq += s; else if (k == 1) { if (lane < 32) sq += s; else skv += s; } else { if (lane < 32) skv += s; } }
            sq = wave_sum(sq); skv = wave_sum(skv);
            if (lane == 0) { RSTD[m0 + r] = __builtin_amdgcn_rsqf(sq * (1.0f / 384.0f) + EPS); RSTD[M + m0 + r] = __builtin_amdgcn_rsqf(skv * (1.0f / 256.0f) + EPS); } }
    }
}
__device__ __forceinline__ void p_krope(const Ctx& X, const Args& a) {
    const bf16* TM = (const bf16*)(wsptr(a) + WS_TM); bf16* Kp = (bf16*)(wsptr(a) + WS_K);
    const float* cm = (const float*)(wsptr(a) + WS_ROPE) + (size_t)M * 64; const float* sm = cm + (size_t)M * 16;
    const int nth = X.G * 512;
    for (int idx = X.vcu * 512 + X.tid; idx < M * 4; idx += nth) { const int row = idx >> 2, cc = idx & 3;
        const v4u w = *(const v4u*)(TM + (size_t)row * 768 + 640 + cc * 8); float f[8]; unpack8(w, f);
        const f32x4 cs = *(const f32x4*)(cm + (size_t)row * 16 + cc * 4), sn = *(const f32x4*)(sm + (size_t)row * 16 + cc * 4);
        float o[8];
#pragma unroll
        for (int p = 0; p < 4; ++p) { o[2 * p] = f[2 * p] * cs[p] - f[2 * p + 1] * sn[p]; o[2 * p + 1] = f[2 * p] * sn[p] + f[2 * p + 1] * cs[p]; }
        const v4u ow = pack8f(o);
#pragma unroll
        for (int h = 0; h < 8; ++h) *(v4u*)(Kp + (size_t)row * 768 + h * 96 + 64 + cc * 8) = ow; }
}

__device__ __forceinline__ float log1p_small(float e) { return e < 0.03f ? e * (1.0f + e * (-0.5f + e * (0.33333334f + e * (-0.25f + e * 0.2f)))) : 0.6931471805599453f * __builtin_amdgcn_logf(1.0f + e); }
__device__ __forceinline__ float softplus_neg(float x) { const float z = -x, e = __builtin_amdgcn_exp2f(-1.4426950408889634f * __builtin_fabsf(z)); return __builtin_fmaxf(z, 0.0f) + log1p_small(e); }
__device__ __forceinline__ float neg_expm1(float y) { return y > -0.1f ? -y * (1.0f + y * (0.5f + y * (0.16666667f + y * (0.041666668f + y * 0.008333334f)))) : 1.0f - __builtin_amdgcn_exp2f(1.4426950408889634f * y); }
constexpr int LRU_XS = 0, LRU_XC = 33792, LRU_XCB = LRU_XC + 32768, LRU_SEG = LRU_XCB + 18432, LRU_GS = LRU_SEG + 4096, LRU_END = LRU_GS + 16384;
static_assert(LRU_END <= 131072, "lru lds");
template <int PASS>
__device__ __forceinline__ void lru_phase(const Ctx& X, unsigned char* ldsg, const Args& a, int l) {
    float* XS = (float*)(ldsg + LRU_XS); float* XC = (float*)(ldsg + LRU_XC); bf16* XCB = (bf16*)(ldsg + LRU_XCB); float* AA = (float*)(ldsg + LRU_XS); float* SEG = (float*)(ldsg + LRU_SEG); bf16* GS = (bf16*)(ldsg + LRU_GS);
    const bf16* TL = (const bf16*)(wsptr(a) + WS_TL); bf16* YB = (bf16*)(wsptr(a) + WS_YB);
    const bf16* WaT = (const bf16*)(wsptr(a) + WS_W + WO_AT); const bf16* WxT = (const bf16*)(wsptr(a) + WS_W + WO_XT);
    float* LSA = (float*)(wsptr(a) + WS_LSA); float* LSH = (float*)(wsptr(a) + WS_LSH); const float* LC = (const float*)(wsptr(a) + WS_LC);
    const float* cw = (const float*)inptr(a, I_LCW) + l * 4 * 512; const float* cbv = (const float*)inptr(a, I_LCB) + l * 512;
    const float* ba = (const float*)inptr(a, I_LBA) + l * 512; const float* bx = (const float*)inptr(a, I_LBX) + l * 512; const float* lam = (const float*)inptr(a, I_LLAM) + l * 512;
    const int tid = X.tid, lane = X.lane, wave = X.wave, r32 = lane & 31, hi = lane >> 5;
    constexpr int NU = NB * 64 * 8;
    v4u px0, px1, px2, pg0, pg1;
#define LRU_ISSUE(u_) do { const int blk_ = (u_) & 7, n_ = ((u_) >> 3) & 63, b_ = (u_) >> 9; const v4u z_ = {0u, 0u, 0u, 0u}; \
        { const int c_ = tid, r_ = c_ >> 3, cc_ = (c_ & 7) * 8, s_ = n_ * 128 + r_ - 3; px0 = z_; if (s_ >= 0) px0 = *(const v4u*)(TL + ((size_t)b_ * SEQ + s_) * 1024 + blk_ * 64 + cc_); } \
        { const int c_ = tid + 512, r_ = c_ >> 3, cc_ = (c_ & 7) * 8, s_ = n_ * 128 + r_ - 3; px1 = z_; if (s_ >= 0) px1 = *(const v4u*)(TL + ((size_t)b_ * SEQ + s_) * 1024 + blk_ * 64 + cc_); } \
        { const int c_ = tid + 1024, r_ = c_ >> 3, cc_ = (c_ & 7) * 8, s_ = n_ * 128 + r_ - 3; px2 = z_; if (c_ < 131 * 8 && s_ >= 0) px2 = *(const v4u*)(TL + ((size_t)b_ * SEQ + s_) * 1024 + blk_ * 64 + cc_); } \
        if (PASS == 2) { const size_t row0_ = (size_t)b_ * SEQ + n_ * 128; \
          pg0 = *(const v4u*)(TL + (row0_ + (tid >> 3)) * 1024 + 512 + blk_ * 64 + (tid & 7) * 8); pg1 = *(const v4u*)(TL + (row0_ + 64 + (tid >> 3)) * 1024 + 512 + blk_ * 64 + (tid & 7) * 8); } } while (0)
    int u = X.vcu;
    if (u < NU) LRU_ISSUE(u);
    for (; u < NU; u += X.G) {
        const int blk = u & 7, n = (u >> 3) & 63, b = u >> 9, ch0 = blk * 64; const size_t row0 = (size_t)b * SEQ + n * 128;
        { float f[8]; unpack8(px0, f); { const int c = tid, r = c >> 3, cc = (c & 7) * 8;
#pragma unroll
            for (int e = 0; e < 8; ++e) XS[r * 64 + cc + e] = f[e]; }
          unpack8(px1, f); { const int c = tid + 512, r = c >> 3, cc = (c & 7) * 8;
#pragma unroll
            for (int e = 0; e < 8; ++e) XS[r * 64 + cc + e] = f[e]; }
          if (tid + 1024 < 131 * 8) { unpack8(px2, f); const int c = tid + 1024, r = c >> 3, cc = (c & 7) * 8;
#pragma unroll
            for (int e = 0; e < 8; ++e) XS[r * 64 + cc + e] = f[e]; }
          if (PASS == 2) { *(v4u*)(GS + (tid >> 3) * 64 + (tid & 7) * 8) = pg0; *(v4u*)(GS + (64 + (tid >> 3)) * 64 + (tid & 7) * 8) = pg1; } }
        __syncthreads();
        { const int c = tid & 63, rg = tid >> 6; const float w0 = cw[ch0 + c], w1 = cw[512 + ch0 + c], w2 = cw[1024 + ch0 + c], w3 = cw[1536 + ch0 + c], bb = cbv[ch0 + c];
#pragma unroll 4
            for (int r = 0; r < 16; ++r) { const int t = rg * 16 + r; const float v = bb + w0 * XS[t * 64 + c] + w1 * XS[(t + 1) * 64 + c] + w2 * XS[(t + 2) * 64 + c] + w3 * XS[(t + 3) * 64 + c];
                XC[t * 64 + c] = v; XCB[t * 72 + c] = (bf16)f2bf(v); } }
        __syncthreads();
        if (u + X.G < NU) LRU_ISSUE(u + X.G);
        { const int tb = wave >> 1, cb = wave & 1; f32x16 R = {}, I = {};
#pragma unroll
            for (int ks = 0; ks < 4; ++ks) { const bf16x8 A = *(const bf16x8*)(XCB + (32 * tb + r32) * 72 + 16 * ks + 8 * hi);
                const bf16x8 Ba = *(const bf16x8*)(WaT + (size_t)(blk * 64 + 32 * cb + r32) * 64 + 16 * ks + 8 * hi), Bx = *(const bf16x8*)(WxT + (size_t)(blk * 64 + 32 * cb + r32) * 64 + 16 * ks + 8 * hi);
                R = __builtin_amdgcn_mfma_f32_32x32x16_bf16(A, Ba, R, 0, 0, 0); I = __builtin_amdgcn_mfma_f32_32x32x16_bf16(A, Bx, I, 0, 0, 0); }
            const int c = 32 * cb + r32; const float bav = ba[ch0 + c], bxv = bx[ch0 + c], sp = softplus_neg(lam[ch0 + c]);
#pragma unroll
            for (int r = 0; r < 16; ++r) { const int t = 32 * tb + (r & 3) + 8 * (r >> 2) + 4 * hi;
                const float rr = sigm(R[r] + bav), ii = sigm(I[r] + bxv), la = -8.0f * rr * sp, av = __builtin_amdgcn_exp2f(1.4426950408889634f * la), mult = __builtin_amdgcn_sqrtf(neg_expm1(2.0f * la));
                AA[t * 64 + c] = av; XC[t * 64 + c] = mult * ii * XC[t * 64 + c]; } }
        __syncthreads();
        { const int c = tid & 63, sg = tid >> 6; float Ap = 1.f, Hp = 0.f;
#pragma unroll 4
            for (int i = 0; i < 16; ++i) { const int t = sg * 16 + i; const float av = AA[t * 64 + c]; Hp = av * Hp + XC[t * 64 + c]; Ap *= av; }
            SEG[sg * 64 + c] = Ap; SEG[512 + sg * 64 + c] = Hp;
            __syncthreads();
            if (PASS == 1) { if (tid < 64) { float A2 = 1.f, H2 = 0.f;
#pragma unroll
                    for (int s = 0; s < 8; ++s) { const float sa = SEG[s * 64 + c]; H2 = sa * H2 + SEG[512 + s * 64 + c]; A2 *= sa; }
                    LSA[(size_t)(b * 64 + n) * 512 + ch0 + c] = A2; LSH[(size_t)(b * 64 + n) * 512 + ch0 + c] = H2; } }
            else { float hin = LC[(size_t)(b * 64 + n) * 512 + ch0 + c];
                for (int s = 0; s < sg; ++s) hin = SEG[s * 64 + c] * hin + SEG[512 + s * 64 + c];
#pragma unroll 4
                for (int i = 0; i < 16; ++i) { const int t = sg * 16 + i; hin = AA[t * 64 + c] * hin + XC[t * 64 + c];
                    const float g = bf2f(GS[t * 64 + c]);
                    YB[(row0 + t) * 1536 + ch0 + c] = (bf16)f2bf(hin * gelu_tanh(g)); } }
        }
        __syncthreads();
    }
#undef LRU_ISSUE
}
__device__ __forceinline__ void lru_prefix(const Ctx& X, const Args& a) {
    const float* LSA = (const float*)(wsptr(a) + WS_LSA); const float* LSH = (const float*)(wsptr(a) + WS_LSH); float* LC = (float*)(wsptr(a) + WS_LC);
    const int idx = X.vcu * 512 + X.tid;
    if (idx < NB * 512) { const int b = idx >> 9, ch = idx & 511; float h = 0.f;
        for (int n0 = 0; n0 < 64; n0 += 8) { float av[8], hv[8];
#pragma unroll
            for (int j = 0; j < 8; ++j) { av[j] = LSA[(size_t)(b * 64 + n0 + j) * 512 + ch]; hv[j] = LSH[(size_t)(b * 64 + n0 + j) * 512 + ch]; }
#pragma unroll
            for (int j = 0; j < 8; ++j) { LC[(size_t)(b * 64 + n0 + j) * 512 + ch] = h; h = av[j] * h + hv[j]; } } }
}

constexpr int RT_Q = 0, RT_K = 18432, RT_V = 36864, RT_S = 55296, RT_HALF = 64512, RT_P = 72;
template <int PASS>
__device__ __forceinline__ void ret_phase(const Ctx& X, unsigned char* ldsg, const Args& a) {
    const bf16* TR = (const bf16*)(wsptr(a) + WS_TR); bf16* YB = (bf16*)(wsptr(a) + WS_YB); float* RS = (float*)(wsptr(a) + WS_RS);
    const float* cr = (const float*)(wsptr(a) + WS_ROPE); const float* sr = cr + (size_t)M * 32;
    const int tid = X.tid, lane = X.lane, wave = X.wave, r32 = lane & 31, hi = lane >> 5, half = wave >> 2, w4 = wave & 3, t2 = tid & 255;
    bf16* Qs = (bf16*)(ldsg + half * RT_HALF + RT_Q); bf16* Ks = (bf16*)(ldsg + half * RT_HALF + RT_K); bf16* Vs = (bf16*)(ldsg + half * RT_HALF + RT_V); bf16* Ss = (bf16*)(ldsg + half * RT_HALF + RT_S);
    for (int u = X.vcu; u < NB * 64 * 4; u += X.G) {
        const int hp = u & 3, n = (u >> 2) & 63, b = u >> 8, h = 2 * hp + half; const size_t row0 = (size_t)b * SEQ + n * 128; const float lg = LG2G[h];
        for (int c = t2; c < 1024; c += 256) { const int r = c >> 3, cc = (c & 7) * 8; const size_t grow = row0 + r;
            const f32x4 cs = *(const f32x4*)(cr + grow * 32 + (cc >> 1)), sn = *(const f32x4*)(sr + grow * 32 + (cc >> 1));
            { const v4u w = *(const v4u*)(TR + grow * 2048 + 512 + h * 64 + cc); float f[8], o[8]; unpack8(w, f);
              const float kd = (PASS == 1) ? 0.125f * __builtin_amdgcn_exp2f((float)(127 - r) * lg) : 0.125f;
#pragma unroll
              for (int p = 0; p < 4; ++p) { o[2 * p] = (f[2 * p] * cs[p] - f[2 * p + 1] * sn[p]) * kd; o[2 * p + 1] = (f[2 * p] * sn[p] + f[2 * p + 1] * cs[p]) * kd; }
              *(v4u*)(Ks + r * RT_P + cc) = pack8f(o); }
            *(v4u*)(Vs + r * RT_P + cc) = *(const v4u*)(TR + grow * 2048 + 1024 + h * 64 + cc);
            if (PASS == 2) { const v4u w = *(const v4u*)(TR + grow * 2048 + h * 64 + cc); float f[8], o[8]; unpack8(w, f);
#pragma unroll
              for (int p = 0; p < 4; ++p) { o[2 * p] = f[2 * p] * cs[p] - f[2 * p + 1] * sn[p]; o[2 * p + 1] = f[2 * p] * sn[p] + f[2 * p + 1] * cs[p]; }
              *(v4u*)(Qs + r * RT_P + cc) = pack8f(o); } }
        if (PASS == 2) { const float* sp = RS + ((size_t)(b * 8 + h) * 64 + n) * 4096;
            for (int c = t2; c < 1024; c += 256) { const int d = c >> 4, e0 = (c & 15) * 4; const f32x4 v = *(const f32x4*)(sp + d * 64 + e0);
                Ss[(e0 + 0) * RT_P + d] = (bf16)f2bf(v.x); Ss[(e0 + 1) * RT_P + d] = (bf16)f2bf(v.y); Ss[(e0 + 2) * RT_P + d] = (bf16)f2bf(v.z); Ss[(e0 + 3) * RT_P + d] = (bf16)f2bf(v.w); } }
        __syncthreads();
        if (PASS == 1) {
            const int db = w4 >> 1, eb = w4 & 1; f32x16 acc = {};
#pragma unroll
            for (int ks = 0; ks < 8; ++ks) { bf16x8 A, B;
#pragma unroll
                for (int j = 0; j < 8; ++j) { A[j] = (short)Ks[(16 * ks + 8 * hi + j) * RT_P + 32 * db + r32]; B[j] = (short)Vs[(16 * ks + 8 * hi + j) * RT_P + 32 * eb + r32]; }
                acc = __builtin_amdgcn_mfma_f32_32x32x16_bf16(A, B, acc, 0, 0, 0); }
            float* dst = RS + ((size_t)(b * 8 + h) * 64 + n) * 4096;
#pragma unroll
            for (int r = 0; r < 16; ++r) dst[(32 * db + (r & 3) + 8 * (r >> 2) + 4 * hi) * 64 + 32 * eb + r32] = acc[r];
        } else {
            const int cb = w4; bf16x8 qf[4];
#pragma unroll
            for (int ks = 0; ks < 4; ++ks) qf[ks] = *(const bf16x8*)(Qs + (32 * cb + r32) * RT_P + 16 * ks + 8 * hi);
            f32x16 yin[2] = {}, ycr[2] = {};
            for (int sb = 0; sb <= cb; ++sb) { f32x16 st = {};
#pragma unroll
                for (int ks = 0; ks < 4; ++ks) { const bf16x8 A = *(const bf16x8*)(Ks + (32 * sb + r32) * RT_P + 16 * ks + 8 * hi); st = __builtin_amdgcn_mfma_f32_32x32x16_bf16(A, qf[ks], st, 0, 0, 0); }
#pragma unroll
                for (int r = 0; r < 16; ++r) { const int d = (32 * cb + r32) - (32 * sb + (r & 3) + 8 * (r >> 2) + 4 * hi); st[r] = d >= 0 ? st[r] * __builtin_amdgcn_exp2f((float)d * lg) : 0.f; }
#pragma unroll
                for (int t = 0; t < 2; ++t) { v4u pw; pw.x = pk2(st[8 * t], st[8 * t + 1]); pw.y = pk2(st[8 * t + 2], st[8 * t + 3]); pw.z = pk2(st[8 * t + 4], st[8 * t + 5]); pw.w = pk2(st[8 * t + 6], st[8 * t + 7]);
                    const bf16x8 Bf = __builtin_bit_cast(bf16x8, pw);
#pragma unroll
                    for (int eb = 0; eb < 2; ++eb) { bf16x8 A;
#pragma unroll
                        for (int j = 0; j < 8; ++j) A[j] = (short)Vs[(32 * sb + 16 * t + 8 * (j >> 2) + 4 * hi + (j & 3)) * RT_P + 32 * eb + r32];
                        yin[eb] = __builtin_amdgcn_mfma_f32_32x32x16_bf16(A, Bf, yin[eb], 0, 0, 0); } } }
#pragma unroll
            for (int eb = 0; eb < 2; ++eb)
#pragma unroll
                for (int ks = 0; ks < 4; ++ks) { const bf16x8 A = *(const bf16x8*)(Ss + (32 * eb + r32) * RT_P + 16 * ks + 8 * hi); ycr[eb] = __builtin_amdgcn_mfma_f32_32x32x16_bf16(A, qf[ks], ycr[eb], 0, 0, 0); }
            const float qd = __builtin_amdgcn_exp2f((float)(32 * cb + r32 + 1) * lg);
            float s = 0.f;
#pragma unroll
            for (int eb = 0; eb < 2; ++eb)
#pragma unroll
                for (int r = 0; r < 16; ++r) { yin[eb][r] += qd * ycr[eb][r]; s += yin[eb][r]; }
            s = half_sum(s); const float mu = s * (1.0f / 64.0f); float q = 0.f;
#pragma unroll
            for (int eb = 0; eb < 2; ++eb)
#pragma unroll
                for (int r = 0; r < 16; ++r) { const float dlt = yin[eb][r] - mu; yin[eb][r] = dlt; q += dlt * dlt; }
            q = half_sum(q); const float rstd = __builtin_amdgcn_rsqf(q * (1.0f / 64.0f) + EPS);
            const size_t grow = row0 + 32 * cb + r32;
#pragma unroll
            for (int eb = 0; eb < 2; ++eb)
#pragma unroll
                for (int qd4 = 0; qd4 < 4; ++qd4) { const int e0 = 32 * eb + 8 * qd4 + 4 * hi;
                    const u32x2 gw = *(const u32x2*)(TR + grow * 2048 + 1536 + h * 64 + e0);
                    const float g0 = __uint_as_float(gw.x << 16), g1 = __uint_as_float(gw.x & 0xffff0000u), g2 = __uint_as_float(gw.y << 16), g3 = __uint_as_float(gw.y & 0xffff0000u);
                    u32x2 ow; ow.x = pk2(g0 * sigm(g0) * yin[eb][4 * qd4] * rstd, g1 * sigm(g1) * yin[eb][4 * qd4 + 1] * rstd); ow.y = pk2(g2 * sigm(g2) * yin[eb][4 * qd4 + 2] * rstd, g3 * sigm(g3) * yin[eb][4 * qd4 + 3] * rstd);
                    *(u32x2*)(YB + grow * 1536 + 512 + h * 64 + e0) = ow; }
        }
        __syncthreads();
    }
}
__device__ __forceinline__ void ret_prefix(const Ctx& X, const Args& a) {
    float* RS = (float*)(wsptr(a) + WS_RS);
    const int nth = X.G * 512;
    for (int idx = X.vcu * 512 + X.tid; idx < NB * 8 * 4096; idx += nth) { const int bh = idx >> 12, off = idx & 4095, h = bh & 7;
        const float cd = __builtin_amdgcn_exp2f(128.0f * LG2G[h]); float* base = RS + (size_t)bh * 64 * 4096 + off; float st = 0.f;
        for (int n0 = 0; n0 < 64; n0 += 8) { float t[8];
#pragma unroll
            for (int j = 0; j < 8; ++j) t[j] = base[(size_t)(n0 + j) * 4096];
#pragma unroll
            for (int j = 0; j < 8; ++j) { base[(size_t)(n0 + j) * 4096] = st; st = st * cd + t[j]; } } }
}

__device__ __forceinline__ void act_pass(const Ctx& X, const Args& a, int l, int hb) {
    const bf16* UP = (const bf16*)(wsptr(a) + WS_UPH); bf16* ACT = (bf16*)(wsptr(a) + WS_ACT) + (size_t)hb * SEQ * DFF;
    const float* cw = (const float*)inptr(a, I_FCW) + (size_t)l * 3 * 5632; const float* cb = (const float*)inptr(a, I_FCB) + (size_t)l * 5632;
    const int nth = X.G * 512; constexpr int SEGR = 32, NSEG = SEQ / SEGR, NCH = DFF / 8;
    for (int idx = X.vcu * 512 + X.tid; idx < NSEG * NCH; idx += nth) { const int jc = idx % NCH, sg = idx / NCH, j0 = jc * 8, ucol = (j0 >> 7) * 256 + (j0 & 127), gcol = ucol + 128;
        float wu[3][8], wg[3][8], bu[8], bg[8];
#pragma unroll
        for (int k = 0; k < 3; ++k)
#pragma unroll
            for (int e = 0; e < 8; ++e) { wu[k][e] = cw[k * 5632 + j0 + e]; wg[k][e] = cw[k * 5632 + 2816 + j0 + e]; }
#pragma unroll
        for (int e = 0; e < 8; ++e) { bu[e] = cb[j0 + e]; bg[e] = cb[2816 + j0 + e]; }
        float u1[8], u2[8], g1[8], g2[8];
        const int s0 = sg * SEGR;
#pragma unroll
        for (int e = 0; e < 8; ++e) { u1[e] = 0.f; u2[e] = 0.f; g1[e] = 0.f; g2[e] = 0.f; }
        if (s0 >= 2) { unpack8(*(const v4u*)(UP + (size_t)(s0 - 1) * 5632 + ucol), u1); unpack8(*(const v4u*)(UP + (size_t)(s0 - 2) * 5632 + ucol), u2);
                       unpack8(*(const v4u*)(UP + (size_t)(s0 - 1) * 5632 + gcol), g1); unpack8(*(const v4u*)(UP + (size_t)(s0 - 2) * 5632 + gcol), g2); }
#pragma unroll 4
        for (int s = s0; s < s0 + SEGR; ++s) { float u0[8], g0[8], o[8];
            unpack8(*(const v4u*)(UP + (size_t)s * 5632 + ucol), u0); unpack8(*(const v4u*)(UP + (size_t)s * 5632 + gcol), g0);
#pragma unroll
            for (int e = 0; e < 8; ++e) { const float cu = bu[e] + wu[2][e] * u0[e] + wu[1][e] * u1[e] + wu[0][e] * u2[e], cg = bg[e] + wg[2][e] * g0[e] + wg[1][e] * g1[e] + wg[0][e] * g2[e];
                o[e] = gelu_tanh(cg) * cu; u2[e] = u1[e]; u1[e] = u0[e]; g2[e] = g1[e]; g1[e] = g0[e]; }
            *(v4u*)(ACT + (size_t)s * DFF + j0) = pack8f(o); } }
}

constexpr int PH_PER_LAYER = 15, NPH = 2 + PH_PER_LAYER * DEPTH;
constexpr int BIGT = 1 << 30;

__global__ void __launch_bounds__(NWAVES * 64, 2) mk_fwd(Args args) {
    unsigned char* lds = g_lds;
    LAS unsigned char* L3 = (LAS unsigned char*)lds;
    const int wave0 = __builtin_amdgcn_readfirstlane((int)threadIdx.x >> 6);
    const int lo = args.ph_lo, hi = args.ph_hi;
    for (int u = threadIdx.x; u < (LDS_BYTES - 131072) / 4; u += NWAVES * 64) ((LAS unsigned*)(L3 + 131072))[u] = 0u;
    __syncthreads();
    if (threadIdx.x < 31) ((LAS unsigned long long*)(L3 + ARGS_LDS_OFF))[threadIdx.x] = ((const unsigned long long*)&args)[threadIdx.x];
    __syncthreads();
    if (hi - lo > 1) (void)xcd_barrier_post((unsigned*)(wsptr(args) + WS_CTL) + 1024, (volatile LAS unsigned*)(L3 + MISC_OFF) + 8);
#ifndef PHMASK
#define PHMASK 0xFFFFFFFFu
#endif
#define PHON(j) ((PHMASK >> (2 + (j))) & 1u)
#define CTX Ctx X; int bx; LAS unsigned char* L3p; unsigned char* ldsp; \
        { int ln_; asm volatile("v_mbcnt_lo_u32_b32 %0, -1, 0\n\tv_mbcnt_hi_u32_b32 %0, -1, %0" : "=v"(ln_)); \
          const int w_ = opaque_u(wave0), g_ = opaque_u((int)gridDim.x), b_ = opaque_u((int)blockIdx.x), lz_ = opaque_u(0); \
          X.tid = w_ * 64 + ln_; X.lane = ln_; X.wave = w_; X.G = g_; bx = b_; X.vcu = (g_ % 8 == 0) ? (b_ % 8) * (g_ / 8) + b_ / 8 : b_; L3p = L3 + lz_; ldsp = lds + lz_; } \
        unsigned char* ws = wsptr(args); (void)bx; (void)L3p; (void)ldsp; (void)ws;
#define WPTR(off) ((const bf16*)(ws + WS_W + (off)))
#pragma unroll 1
    for (int ph = lo, rep = 0; ph < hi; ++ph) {
        const int l = ph < 2 ? 0 : (ph - 2) / PH_PER_LAYER, j = ph < 2 ? ph - 2 : (ph - 2) - l * PH_PER_LAYER;
#ifdef AMP_MASK
        const unsigned long long amp_t0 = __builtin_amdgcn_s_memrealtime();
#endif

#ifndef REPMASK
#define REPMASK 0u
#endif
        if (j == -2 && PHON(-2)) { CTX p_mods(X, L3p, args); __syncthreads(); p_rope(X, args); convert_mixer(X, L3p, args, 0); }
        else if (j == -1 && PHON(-1)) { CTX const float* MOD = (const float*)(ws + WS_MOD);
            row_pass<0, true>(X, (const float*)inptr(args, I_X), nullptr, nullptr, nullptr, nullptr, (const float*)inptr(args, I_MIXPRE), MOD, MOD + 1024, (bf16*)(ws + WS_XN)); }
        else if (j == 0 && PHON(0)) { CTX
            pg8::Gemm g{(const bf16*)(ws + WS_XN), WPTR(WO_IN), M, 3840, 1024, 1024}; pg8::StaticOrder S; S.init(M, 3840, X.G, bx);
            typedef pg8::EpiRoute<0, WS_TL, 1024, 4, WS_TR, 2048, 12, WS_TM, 768> E_t; E_t E{&args};
            pg8::gemm_phase<E_t, pg8::StaticOrder, true, true>(L3p, g, S, E, X.tid);
        }
        else if (j == 1 && PHON(1)) { CTX lru_phase<1>(X, ldsp, args, l); __syncthreads(); ret_phase<1>(X, ldsp, args); p_mla_rstd(X, args); }
        else if (j == 2 && PHON(2)) { CTX lru_prefix(X, args); ret_prefix(X, args); }
        else if (j == 3 && PHON(3)) { CTX lru_phase<2>(X, ldsp, args, l); __syncthreads(); ret_phase<2>(X, ldsp, args); }
        else if (j == 4 && PHON(4)) {
            { CTX p_krope(X, args); }
            { CTX pg8::Gemm g{(const bf16*)(ws + WS_TM), WPTR(WO_UQ), M, 768, 384, 768}; pg8::StaticOrder S; S.init(M, 768, X.G, bx);
              pg8::EpiQ E{&args}; pg8::gemm_phase<pg8::EpiQ, pg8::StaticOrder, true, true>(L3p, g, S, E, X.tid); }
            { CTX pg8::Gemm g{(const bf16*)(ws + WS_TM) + 384, WPTR(WO_UKV), M, 1024, 256, 768}; pg8::StaticOrder S; S.init(M, 1024, X.G, bx);
              pg8::EpiKV E{&args}; pg8::gemm_phase<pg8::EpiKV, pg8::StaticOrder, true, true>(L3p, g, S, E, X.tid); }
        }
        else if (j == 5 && PHON(5)) { CTX
            const bf16* Qb = (const bf16*)(ws + WS_Q); const bf16* Kb = (const bf16*)(ws + WS_K); const bf16* Vb = (const bf16*)(ws + WS_V); bf16* YB = (bf16*)(ws + WS_YB);
            att::Seam S;
            for (int L = X.vcu; L < 256; L += X.G) {
                const int bh = L >> 4, xq = L & 15, b = bh >> 3, h = bh & 7, qb0 = xq, qb1 = 31 - xq;
                const bf16* Kh = Kb + (size_t)b * SEQ * 768 + h * 96; const bf16* Vh = Vb + (size_t)b * SEQ * 512 + h * 64;
                att::BlockRef r0{Qb + ((size_t)b * SEQ + qb0 * 256) * 768 + h * 96, Kh, Vh, YB + ((size_t)b * SEQ + qb0 * 256) * 1536 + 1024 + h * 64, qb0 * 256};
                att::BlockRef r1{Qb + ((size_t)b * SEQ + qb1 * 256) * 768 + h * 96, Kh, Vh, YB + ((size_t)b * SEQ + qb1 * 256) * 1536 + 1024 + h * 64, qb1 * 256};
                att::attn_prime(r0, (char*)ldsp, S, X.tid);
                att::attn_block(r0, r1, (char*)ldsp, S, X.tid);
                att::attn_block(r1, r1, (char*)ldsp, S, X.tid);
                asm volatile("s_waitcnt vmcnt(0)" ::: "memory"); __syncthreads();
            }
        }
        else if (j == 6 && PHON(6)) {
            { CTX pg8::Gemm g{(const bf16*)(ws + WS_XN), WPTR(WO_G), M, 3072, 1024, 1024}; pg8::GateOrder S; S.init(M, X.G, bx);
              typedef pg8::EpiRoute<2, WS_G, 3072, BIGT, 0, 0, BIGT, 0, 0> E_t; E_t E{&args};
              pg8::gemm_phase<E_t, pg8::GateOrder, true, true>(L3p, g, S, E, X.tid);
              asm volatile("s_waitcnt vmcnt(0)" ::: "memory"); __syncthreads();
              __builtin_amdgcn_fence(__ATOMIC_ACQUIRE, "agent"); asm volatile("s_waitcnt vmcnt(0)" ::: "memory"); }
            { CTX pg8::Gemm g{(const bf16*)(ws + WS_YB), WPTR(WO_O3), M, 3072, 512, 1536}; pg8::MergeOrder S; S.init(M, X.G, bx);
              pg8::EpiMerge E{&args}; pg8::gemm_phase<pg8::EpiMerge, pg8::MergeOrder, true, true>(L3p, g, S, E, X.tid); }
        }
        else if (j == 7 && PHON(7)) { CTX
            pg8::Gemm g{(const bf16*)(ws + WS_XN), WPTR(WO_OUT), M, 1024, 1024, 1024}; pg8::StaticOrder S; S.init(M, 1024, X.G, bx);
            typedef pg8::EpiRoute<0, WS_Y, 1024, BIGT, 0, 0, BIGT, 0, 0> E_t; E_t E{&args}; pg8::gemm_phase<E_t, pg8::StaticOrder, true, true>(L3p, g, S, E, X.tid);
        }
        else if (j == 8 && PHON(8)) { CTX float* out = outptr(args); const float* MODl = (const float*)(ws + WS_MOD) + (size_t)l * NB * 6144;
            row_pass<1, true>(X, l == 0 ? (const float*)inptr(args, I_X) : (const float*)out, out, (const bf16*)(ws + WS_Y), (const float*)inptr(args, I_MIXPOST) + l * 1024, MODl + 2048,
                              (const float*)inptr(args, I_FPRE) + l * 1024, MODl + 3072, MODl + 4096, (bf16*)(ws + WS_XN));
            convert_ffn(X, L3p, args, l);
#ifdef REP_CONV
            convert_ffn(X, L3p, args, l);
#endif
        }
        else if ((j == 9 || j == 11) && PHON(9)) { CTX const int hb = (j - 9) >> 1;
            pg8::Gemm g{(const bf16*)(ws + WS_XN) + (size_t)hb * SEQ * 1024, WPTR(WO_UP), SEQ, 5632, 1024, 1024}; pg8::StaticOrder S; S.init(SEQ, 5632, X.G, bx);
            typedef pg8::EpiRoute<0, WS_UPH, 5632, BIGT, 0, 0, BIGT, 0, 0> E_t; E_t E{&args};
            pg8::gemm_phase<E_t, pg8::StaticOrder, true, true>(L3p, g, S, E, X.tid);
        }
        else if ((j == 10 || j == 12) && PHON(10)) { CTX act_pass(X, args, l, (j - 10) >> 1); }
        else if (j == 13 && PHON(13)) { CTX
            pg8::Gemm g{(const bf16*)(ws + WS_ACT), WPTR(WO_DOWN), M, 1024, 2816, 2816}; pg8::StaticOrder S; S.init(M, 1024, X.G, bx);
            typedef pg8::EpiRoute<0, WS_Y2, 1024, BIGT, 0, 0, BIGT, 0, 0> E_t; E_t E{&args}; pg8::gemm_phase<E_t, pg8::StaticOrder, true, true>(L3p, g, S, E, X.tid);
        }
        else if (j == 14 && PHON(14)) { CTX float* out = outptr(args); const float* MOD = (const float*)(ws + WS_MOD); const float* MODl = MOD + (size_t)l * NB * 6144;
            if (l + 1 < DEPTH) {
                const float* MODn = MOD + (size_t)(l + 1) * NB * 6144;
                row_pass<1, true>(X, (const float*)out, out, (const bf16*)(ws + WS_Y2), (const float*)inptr(args, I_FPOST) + l * 1024, MODl + 5120,
                                  (const float*)inptr(args, I_MIXPRE) + (l + 1) * 1024, MODn, MODn + 1024, (bf16*)(ws + WS_XN));
                convert_mixer(X, L3p, args, l + 1);
#ifdef REP_CONV
                convert_mixer(X, L3p, args, l + 1);
#endif
            } else {
                row_pass<1, false>(X, (const float*)out, out, (const bf16*)(ws + WS_Y2), (const float*)inptr(args, I_FPOST) + l * 1024, MODl + 5120, nullptr, nullptr, nullptr, nullptr);
            }
        }
        if (REPMASK != 0u) { const int nrep = ((REPMASK >> (j + 2)) & 1u) ? 2 : 1; if (++rep < nrep) { --ph; continue; } rep = 0; }
        if (ph + 1 < hi) {
            if (ph == lo) { cg::this_grid().sync(); }
            else { unsigned char* ws = wsptr(args); const int lz_ = opaque_u(0); XcdBarrier bar; bar.bar = (unsigned*)(ws + WS_CTL) + 1024; bar.x = xb_xcc_id(); bar.st = (volatile LAS unsigned*)(L3 + lz_ + MISC_OFF) + 8; xcd_barrier(bar);
#ifdef REP_BAR
                   xcd_barrier(bar);
#endif
            }
        }
#ifdef AMP_MASK
        if ((AMP_MASK >> (j + 2)) & 1u) {
            const unsigned long long t1 = __builtin_amdgcn_s_memrealtime(), target = t1 + (unsigned long long)(AMP_N - 1) * (t1 - amp_t0);
            while (__builtin_amdgcn_s_memrealtime() < target) __builtin_amdgcn_s_sleep(8);
        }
#endif
    }
#undef PHON
#undef WPTR
#undef CTX
}


#ifdef DBG_K
__global__ void dbg_dump(const unsigned char* ws, float* out) {
    const bf16* buf = (const bf16*)(ws + (size_t)DBG_OFF);
    for (size_t i = (size_t)blockIdx.x * blockDim.x + threadIdx.x; i < (size_t)M * 1024; i += (size_t)gridDim.x * blockDim.x) {
        const size_t r = i >> 10; const int c = (int)(i & 1023);
        out[i] = c < DBG_NC ? __uint_as_float((unsigned)buf[r * DBG_LD + DBG_COL0 + c] << 16) : 0.f; }
}
#endif
extern "C" void kernel_launch(void* const* d_in, const int* in_sizes, int n_in, void* d_out, int out_size, void* d_ws, size_t ws_size, hipStream_t stream) {
    static int grid = 0;
    if (grid == 0) {
        if (n_in != 29 || in_sizes[0] != M * DM || out_size != M * DM || ws_size < WS_END) { fprintf(stderr, "kernel_launch: unexpected shapes (n_in %d, in0 %d, out %d, ws %zu)\n", n_in, n_in > 0 ? in_sizes[0] : -1, out_size, ws_size); grid = -1; return; }
        int dev = 0, cus = 0, per_cu = 0;
        if (hipGetDevice(&dev) != hipSuccess || hipDeviceGetAttribute(&cus, hipDeviceAttributeMultiprocessorCount, dev) != hipSuccess) { grid = -1; return; }
        if (hipFuncSetAttribute((const void*)mk_fwd, hipFuncAttributeMaxDynamicSharedMemorySize, LDS_BYTES) != hipSuccess) { fprintf(stderr, "kernel_launch: hipFuncSetAttribute failed\n"); grid = -1; return; }
        if (hipOccupancyMaxActiveBlocksPerMultiprocessor(&per_cu, (const void*)mk_fwd, NWAVES * 64, LDS_BYTES) != hipSuccess || per_cu < 1) { fprintf(stderr, "kernel_launch: occupancy query says %d blocks per CU\n", per_cu); per_cu = 1; }
        (void)hipGetLastError();
        grid = cus;
    }
    if (grid < 0) return;
    (void)hipMemsetAsync((char*)d_ws + WS_CTL, 0, CTL_ZERO_BYTES, stream);
    Args a{};
    for (int i = 0; i < 29; ++i) a.in[i] = d_in[i];
    a.out = (float*)d_out; a.ws = (unsigned char*)d_ws;
#if MK_ONE_LAUNCH
    a.ph_lo = 0; a.ph_hi = NPH;
    void* params[] = {&a};
    hipError_t e = hipLaunchCooperativeKernel((const void*)mk_fwd, dim3(grid), dim3(NWAVES * 64), params, LDS_BYTES, stream);
    if (e != hipSuccess) fprintf(stderr, "kernel_launch: cooperative launch failed: %s (grid %d)\n", hipGetErrorString(e), grid);
#else
#ifdef DBG_K
    for (int k = 0; k < DBG_K; ++k) { a.ph_lo = k; a.ph_hi = k + 1; hipLaunchKernelGGL(mk_fwd, dim3(grid), dim3(NWAVES * 64), LDS_BYTES, stream, a); }
    hipLaunchKernelGGL(dbg_dump, dim3(2048), dim3(256), 0, stream, (const unsigned char*)d_ws, (float*)d_out);
#else
    for (int k = 0; k < NPH; ++k) { a.ph_lo = k; a.ph_hi = k + 1; hipLaunchKernelGGL(mk_fwd, dim3(grid), dim3(NWAVES * 64), LDS_BYTES, stream, a); }
#endif
#endif
}
```

```cpp
#include <hip/hip_runtime.h>
#include <hip/hip_bf16.h>
#include <hip/hip_cooperative_groups.h>
#include <cstdio>
#include <cstdint>
namespace cg = cooperative_groups;

#ifndef MK_ONE_LAUNCH
#define MK_ONE_LAUNCH 1
#endif

constexpr int DM = 1024, NB = 2, SEQ = 8192, M = NB * SEQ, DEPTH = 2;
constexpr int LRU_W = 512, RET_H = 8, MLA_H = 8, QRANK = 384, KVRANK = 256, DFF = 2816;
constexpr int NIN = 6816;
constexpr float EPS = 1e-6f;

constexpr size_t MiB = 1u << 20;
constexpr size_t WS_CTL = 0, CTL_ZERO_BYTES = 64 * 1024;
constexpr size_t WS_MOD = 1 * MiB;
constexpr size_t WS_RSTD = WS_MOD + 128 * 1024;
constexpr size_t WS_LSA = WS_RSTD + 128 * 1024;
constexpr size_t WS_LSH = WS_LSA + 256 * 1024;
constexpr size_t WS_LC = WS_LSH + 256 * 1024;
constexpr size_t WS_ROPE = 3 * MiB;
constexpr size_t WS_W = 10 * MiB;
constexpr size_t WS_XN = 30 * MiB;
constexpr size_t WS_YB = 62 * MiB;
constexpr size_t WS_RS = 110 * MiB;
constexpr size_t WS_BIG = 126 * MiB;
constexpr size_t WS_TL = WS_BIG, WS_TR = WS_BIG + 32 * MiB, WS_TM = WS_BIG + 96 * MiB;
constexpr size_t WS_Q = WS_BIG, WS_K = WS_BIG + 24 * MiB, WS_V = WS_BIG + 48 * MiB;
constexpr size_t WS_G = WS_BIG, WS_Y = WS_BIG;
constexpr size_t WS_XNH = WS_XN + 32 * MiB;
constexpr size_t WS_ACT = 150 * MiB, WS_Y2 = 64 * MiB;
constexpr size_t WS_END = 256 * MiB;
constexpr size_t WO_IN = 0, WO_G = WO_IN + (size_t)3840 * 1024 * 2, WO_OUT = WO_G + (size_t)3072 * 1024 * 2, WO_O3 = WO_OUT + (size_t)1024 * 1024 * 2,
                 WO_UQ = WO_O3 + (size_t)3 * 1024 * 512 * 2, WO_UKV = WO_UQ + (size_t)768 * 384 * 2, WO_AT = WO_UKV + (size_t)1024 * 256 * 2, WO_XT = WO_AT + 65536, WO_MIX_END = WO_XT + 65536;
constexpr size_t WO_UP = 0, WO_DOWN = (size_t)5632 * 1024 * 2, WO_FFN_END = WO_DOWN + (size_t)1024 * 2816 * 2;
static_assert(WO_MIX_END <= 20 * MiB && WO_FFN_END <= 20 * MiB, "weight region");
static_assert(WS_ACT + (size_t)M * DFF * 2 <= WS_END && WS_XNH + 2 * MiB <= WS_Y2 && WS_Y2 + 32 * MiB <= WS_ACT, "ffn map");

constexpr int LDS_BYTES = 147456;
constexpr int MISC_OFF = 131072 + 320;
constexpr int NWAVES = 8;

typedef float f32x16 __attribute__((ext_vector_type(16)));
typedef unsigned u32x2 __attribute__((ext_vector_type(2)));
typedef float f32x2 __attribute__((ext_vector_type(2)));

__device__ const double INVR[32] = {1.0, 0.7498942093324559, 0.5623413251903491, 0.4216965034285822, 0.31622776601683794, 0.23713737056616552, 0.1778279410038923, 0.1333521432163324, 0.1, 0.07498942093324558, 0.05623413251903491, 0.042169650342858224, 0.03162277660168379, 0.023713737056616554, 0.01778279410038923, 0.01333521432163324, 0.01, 0.007498942093324558, 0.005623413251903491, 0.004216965034285823, 0.0031622776601683794, 0.0023713737056616554, 0.0017782794100389228, 0.001333521432163324, 0.001, 0.0007498942093324559, 0.0005623413251903491, 0.00042169650342858224, 0.00031622776601683794, 0.00023713737056616554, 0.00017782794100389227, 0.0001333521432163324};
__device__ const float LG2G[8] = {-0.04580368961312479f, -0.02272007650008353f, -0.011315313227834146f, -0.005646563141142063f, -0.0028205190623786626f, -0.0014095702546713536f, -0.0007046129765893727f, -0.0003522634716290214f};

struct Ctx { int tid, lane, wave, G, vcu; };
struct Args { const void* in[29]; float* out; unsigned char* ws; int ph_lo, ph_hi; };
enum { I_X = 0, I_C, I_POS, I_ADAW, I_ADAB, I_MIXPRE, I_MIXPOST, I_WIN, I_LCW, I_LCB, I_LWA, I_LBA, I_LWX, I_LBX, I_LLAM, I_LWO, I_RWO, I_QNG, I_WUQ, I_KVNG, I_WUKV, I_MWO, I_WOUT,
       I_FPRE, I_FPOST, I_WUP, I_FCW, I_FCB, I_WDOWN };


#define GAS __attribute__((address_space(1)))
#define LAS __attribute__((address_space(3)))
extern __shared__ __attribute__((aligned(16))) unsigned char g_lds[];
constexpr int ARGS_LDS_OFF = 131072 + 1024;
__device__ __forceinline__ int opaque_u(int v) { int t; asm volatile("v_mov_b32 %0, %1" : "=v"(t) : "s"(v)); return __builtin_amdgcn_readfirstlane(t); }
__device__ __forceinline__ unsigned long long lds_arg(int idx) {
    const int z = opaque_u(0);
    volatile LAS unsigned* p = (volatile LAS unsigned*)((LAS unsigned char*)g_lds + z + ARGS_LDS_OFF) + 2 * idx;
    const unsigned lo = p[0], hi = p[1];
    return ((unsigned long long)(unsigned)__builtin_amdgcn_readfirstlane((int)hi) << 32) | (unsigned)__builtin_amdgcn_readfirstlane((int)lo);
}
__device__ __forceinline__ const void* inptr(const Args&, int i) { return (const void*)(GAS const void*)lds_arg(i); }
__device__ __forceinline__ unsigned char* wsptr(const Args&) { return (unsigned char*)(GAS unsigned char*)lds_arg(30); }
__device__ __forceinline__ float* outptr(const Args&) { return (float*)(GAS float*)lds_arg(29); }

namespace pg8 {
#define PG8_LAS __attribute__((address_space(3)))
typedef unsigned short bf16_t;
typedef short bf16x8 __attribute__((ext_vector_type(8)));
typedef float f32x4 __attribute__((ext_vector_type(4)));
typedef unsigned u32x4 __attribute__((ext_vector_type(4)));
typedef unsigned u32x2 __attribute__((ext_vector_type(2)));
constexpr int BM = 256, BK = 64, HALF = 128, HTB = HALF * BK * 2, STAGE_BYTES = 8 * HTB, NXCD = 8, WGM = 8;

__host__ __device__ __forceinline__ int lds_byte(int r, int c) { const int st = (r >> 4) * 2 + (c >> 5), rr = r & 15, cc = c & 31, ob = rr * 64 + cc * 2; return st * 1024 + (ob ^ (((ob >> 9) & 1) << 5)); }
__host__ __device__ __forceinline__ void stage_rc(int b, int& R, int& C) { const int st = b / 1024, sb = b % 1024, swz = sb ^ (((sb >> 9) & 1) << 5); R = (st >> 1) * 16 + swz / 64; C = (st & 1) * 32 + (swz % 64) / 2; }
__host__ __device__ __forceinline__ int perm32(int rho) { const int n = rho >> 4, i = rho & 15; return 8 * (i >> 2) + 4 * n + (i & 3); }

struct Unit { int pm, pn, ao; };
struct Gemm { const bf16_t* A; const bf16_t* Bt; int M, N, K, lda; };

struct StaticOrder {
    int nM, nN, nwg, G, c;
    __host__ __device__ void init(int M_, int N_, int G_, int c_) { nM = M_ / BM; nN = N_ / BM; nwg = nM * nN; G = G_; c = c_; }
    __host__ __device__ bool next(int i, Unit& u) const {
        const long L = (long)i * G + c; if (L >= nwg) return false;
        int wgid = (int)L; { const int q = nwg / NXCD, r = nwg % NXCD, xcd = wgid % NXCD, off = wgid / NXCD; wgid = (xcd < r ? xcd * (q + 1) : r * (q + 1) + (xcd - r) * q) + off; }
        const int nig = WGM * nN, gid = wgid / nig, fm = gid * WGM, gsz = (nM - fm) < WGM ? (nM - fm) : WGM;
        u.pm = fm + ((wgid % nig) % gsz); u.pn = (wgid % nig) / gsz; u.ao = 0; return true;
    }
    __device__ __forceinline__ void a_ready(const Unit&) const {}
    __device__ __forceinline__ void done(const Unit&) const {}
};


struct GateOrder {
    StaticOrder base;
    __host__ __device__ void init(int M_, int G_, int c_) { base.init(M_, 1024, G_, c_); }
    __host__ __device__ bool next(int i, Unit& u) const { if (i >= 3) return false; Unit t; if (!base.next(0, t)) return false; u.pm = t.pm; u.pn = t.pn + 4 * i; u.ao = 0; return true; }
    __device__ __forceinline__ void a_ready(const Unit&) const {}
    __device__ __forceinline__ void done(const Unit&) const {}
};
struct MergeOrder {
    StaticOrder base;
    __host__ __device__ void init(int M_, int G_, int c_) { base.init(M_, 1024, G_, c_); }
    __host__ __device__ bool next(int i, Unit& u) const { if (i >= 3) return false; Unit t; if (!base.next(0, t)) return false; u.pm = t.pm; u.pn = t.pn + 4 * i; u.ao = i * 1024; return true; }
    __device__ __forceinline__ void a_ready(const Unit&) const {}
    __device__ __forceinline__ void done(const Unit&) const {}
};
typedef float f32x2_t __attribute__((ext_vector_type(2))); typedef __bf16 bf16x2_t __attribute__((ext_vector_type(2)));
__device__ __forceinline__ unsigned cvt_pk_bf16(float lo, float hi) { f32x2_t v = {lo, hi}; bf16x2_t b = __builtin_convertvector(v, bf16x2_t); return __builtin_bit_cast(unsigned, b); }
__device__ __forceinline__ float bf_lo(unsigned w) { return __uint_as_float(w << 16); }
__device__ __forceinline__ float bf_hi(unsigned w) { return __uint_as_float(w & 0xffff0000u); }
__device__ __forceinline__ float sigmoidf_(float x) { return __builtin_amdgcn_rcpf(1.0f + __builtin_amdgcn_exp2f(-1.4426950408889634f * x)); }


template <int ACT, size_t O0, int LD0, int T1, size_t O1, int LD1, int T2, size_t O2, int LD2> struct EpiRoute {
    static constexpr bool PERM = true, AFTER_DRAIN = false;
    const Args* a;
    __device__ __forceinline__ void operator()(const f32x4 (&acc)[2][2][4][2], const Unit& u, int wr, int wc, int fr_, int fq_) const {
        (void)fr_; (void)fq_; int ln_; asm volatile("v_mbcnt_lo_u32_b32 %0, -1, 0\n\tv_mbcnt_hi_u32_b32 %0, -1, %0" : "=v"(ln_)); const int fr = ln_ & 15, fq = ln_ >> 4;
        unsigned char* ws = wsptr(*a);
        bf16_t* base; int ld, ct;
        if (u.pn < T1) { base = (bf16_t*)(ws + O0); ld = LD0; ct = u.pn; } else if (u.pn < T2) { base = (bf16_t*)(ws + O1); ld = LD1; ct = u.pn - T1; } else { base = (bf16_t*)(ws + O2); ld = LD2; ct = u.pn - T2; }
        int row0 = u.pm * BM + wr * 64 + fr, col0 = ct * BM + wc * 32 + 8 * fq; asm volatile("" : "+v"(row0), "+v"(col0));
#pragma unroll
        for (int ai = 0; ai < 2; ++ai)
#pragma unroll
            for (int m = 0; m < 4; ++m) { bf16_t* rowp = base + (size_t)(row0 + ai * HALF + m * 16) * ld + col0;
#pragma unroll
                for (int bj = 0; bj < 2; ++bj) { f32x4 v0 = acc[ai][bj][m][0], v1 = acc[ai][bj][m][1];
                    if (ACT == 2) {
#pragma unroll
                        for (int e = 0; e < 4; ++e) { v0[e] = sigmoidf_(v0[e]); v1[e] = sigmoidf_(v1[e]); } }
                    u32x4 w; w.x = cvt_pk_bf16(v0[0], v0[1]); w.y = cvt_pk_bf16(v0[2], v0[3]); w.z = cvt_pk_bf16(v1[0], v1[1]); w.w = cvt_pk_bf16(v1[2], v1[3]);
                    *(u32x4*)(rowp + bj * HALF) = w; } }
    }
};
struct EpiQ {
    static constexpr bool PERM = true, AFTER_DRAIN = false;
    const Args* a;
    __device__ __forceinline__ void operator()(const f32x4 (&acc)[2][2][4][2], const Unit& u, int wr, int wc, int fr_, int fq_) const {
        (void)fr_; (void)fq_; int ln_; asm volatile("v_mbcnt_lo_u32_b32 %0, -1, 0\n\tv_mbcnt_hi_u32_b32 %0, -1, %0" : "=v"(ln_)); const int fr = ln_ & 15, fq = ln_ >> 4;
        unsigned char* ws = wsptr(*a);
        const char* Qc = (const char*)(ws + WS_Q); const char* rstd = (const char*)(ws + WS_RSTD); const char* cosm = (const char*)(ws + WS_ROPE) + (size_t)M * 64 * 4; const char* sinm = cosm + (size_t)M * 16 * 4;
        int row0 = u.pm * BM + wr * 64 + fr, fq4 = fq; asm volatile("" : "+v"(row0), "+v"(fq4));
        const int g32 = u.pn * 8 + wc;
#pragma unroll
        for (int ai = 0; ai < 2; ++ai)
#pragma unroll
            for (int m = 0; m < 4; ++m) { const unsigned row = (unsigned)(row0 + ai * HALF + m * 16); const float rs = *(const float*)(rstd + row * 4u);
#pragma unroll
                for (int bj = 0; bj < 2; ++bj) { const int g = g32 + 4 * bj;
                    f32x4 v0 = acc[ai][bj][m][0] * rs, v1 = acc[ai][bj][m][1] * rs;
                    if ((g % 3) == 2) { const f32x4 cs = *(const f32x4*)(cosm + row * 64u + (unsigned)fq4 * 16u), sn = *(const f32x4*)(sinm + row * 64u + (unsigned)fq4 * 16u);
                        f32x4 p, b; p[0] = v0[0] * cs[0] - v0[1] * sn[0]; p[1] = v0[0] * sn[0] + v0[1] * cs[0]; p[2] = v0[2] * cs[1] - v0[3] * sn[1]; p[3] = v0[2] * sn[1] + v0[3] * cs[1];
                        b[0] = v1[0] * cs[2] - v1[1] * sn[2]; b[1] = v1[0] * sn[2] + v1[1] * cs[2]; b[2] = v1[2] * cs[3] - v1[3] * sn[3]; b[3] = v1[2] * sn[3] + v1[3] * cs[3]; v0 = p; v1 = b; }
                    u32x4 w; w.x = cvt_pk_bf16(v0[0], v0[1]); w.y = cvt_pk_bf16(v0[2], v0[3]); w.z = cvt_pk_bf16(v1[0], v1[1]); w.w = cvt_pk_bf16(v1[2], v1[3]);
                    *(u32x4*)(Qc + row * 1536u + (unsigned)(g * 64 + fq4 * 16)) = w; }
                asm volatile("" ::: "memory"); }
    }
};
struct EpiKV {
    static constexpr bool PERM = true, AFTER_DRAIN = false;
    const Args* a;
    __device__ __forceinline__ void operator()(const f32x4 (&acc)[2][2][4][2], const Unit& u, int wr, int wc, int fr_, int fq_) const {
        (void)fr_; (void)fq_; int ln_; asm volatile("v_mbcnt_lo_u32_b32 %0, -1, 0\n\tv_mbcnt_hi_u32_b32 %0, -1, %0" : "=v"(ln_)); const int fr = ln_ & 15, fq = ln_ >> 4;
        unsigned char* ws = wsptr(*a);
        bf16_t* Kp = (bf16_t*)(ws + WS_K); bf16_t* Vp = (bf16_t*)(ws + WS_V); const float* rstd = (const float*)(ws + WS_RSTD) + M;
        int row0 = u.pm * BM + wr * 64 + fr, col0 = u.pn * BM + wc * 32 + 8 * fq; asm volatile("" : "+v"(row0), "+v"(col0));
#pragma unroll
        for (int ai = 0; ai < 2; ++ai)
#pragma unroll
            for (int m = 0; m < 4; ++m) { const int row = row0 + ai * HALF + m * 16; const float rs = rstd[row];
#pragma unroll
                for (int bj = 0; bj < 2; ++bj) { const int c = col0 + bj * HALF, h = c >> 7, w = c & 127;
                    const f32x4 v0 = acc[ai][bj][m][0] * rs, v1 = acc[ai][bj][m][1] * rs;
                    u32x4 o; o.x = cvt_pk_bf16(v0[0], v0[1]); o.y = cvt_pk_bf16(v0[2], v0[3]); o.z = cvt_pk_bf16(v1[0], v1[1]); o.w = cvt_pk_bf16(v1[2], v1[3]);
                    bf16_t* dst = (w < 64) ? (Kp + (size_t)row * 768 + h * 96 + w) : (Vp + (size_t)row * 512 + h * 64 + (w - 64));
                    *(u32x4*)dst = o; }
                asm volatile("" ::: "memory"); }
    }
};
struct EpiMerge {
    static constexpr bool PERM = true, AFTER_DRAIN = false;
    const Args* a;
    __device__ __forceinline__ void operator()(const f32x4 (&acc)[2][2][4][2], const Unit& u, int wr, int wc, int fr_, int fq_) const {
        (void)fr_; (void)fq_; int ln_; asm volatile("v_mbcnt_lo_u32_b32 %0, -1, 0\n\tv_mbcnt_hi_u32_b32 %0, -1, %0" : "=v"(ln_)); const int fr = ln_ & 15, fq = ln_ >> 4;
        unsigned char* ws = wsptr(*a);
        const int b = u.pn >> 2, pn = u.pn & 3;
        bf16_t* O = (bf16_t*)(ws + WS_XN); const bf16_t* Gt = (const bf16_t*)(ws + WS_G) + 1024 * b; const bool accum = b > 0;
        int row0 = u.pm * BM + wr * 64 + fr, col0 = pn * BM + wc * 32 + 8 * fq; asm volatile("" : "+v"(row0), "+v"(col0));
#pragma unroll
        for (int ai = 0; ai < 2; ++ai)
#pragma unroll
            for (int m = 0; m < 4; ++m) { const int row = row0 + ai * HALF + m * 16;
#pragma unroll
                for (int bj = 0; bj < 2; ++bj) { const int c = col0 + bj * HALF;
                    const u32x4 gw = *(const u32x4*)(Gt + (size_t)row * 3072 + c);
                    f32x4 v0 = acc[ai][bj][m][0], v1 = acc[ai][bj][m][1];
                    v0[0] *= bf_lo(gw.x); v0[1] *= bf_hi(gw.x); v0[2] *= bf_lo(gw.y); v0[3] *= bf_hi(gw.y); v1[0] *= bf_lo(gw.z); v1[1] *= bf_hi(gw.z); v1[2] *= bf_lo(gw.w); v1[3] *= bf_hi(gw.w);
                    if (accum) { unsigned long long* op = (unsigned long long*)(O + (size_t)row * 1024 + c);
                        const unsigned long long o01 = __hip_atomic_load(op, __ATOMIC_RELAXED, __HIP_MEMORY_SCOPE_AGENT), o23 = __hip_atomic_load(op + 1, __ATOMIC_RELAXED, __HIP_MEMORY_SCOPE_AGENT);
                        const unsigned ox = (unsigned)o01, oy = (unsigned)(o01 >> 32), oz = (unsigned)o23, ow = (unsigned)(o23 >> 32);
                        v0[0] += bf_lo(ox); v0[1] += bf_hi(ox); v0[2] += bf_lo(oy); v0[3] += bf_hi(oy); v1[0] += bf_lo(oz); v1[1] += bf_hi(oz); v1[2] += bf_lo(ow); v1[3] += bf_hi(ow); }
                    u32x4 o; o.x = cvt_pk_bf16(v0[0], v0[1]); o.y = cvt_pk_bf16(v0[2], v0[3]); o.z = cvt_pk_bf16(v1[0], v1[1]); o.w = cvt_pk_bf16(v1[2], v1[3]);
                    *(u32x4*)(O + (size_t)row * 1024 + c) = o; }
                asm volatile("" ::: "memory"); }
    }
};
template <int CTRL> __device__ __forceinline__ float dppf(float x) { return __builtin_bit_cast(float, __builtin_amdgcn_mov_dpp(__builtin_bit_cast(int, x), CTRL, 0xf, 0xf, true)); }
__device__ __forceinline__ float gelu_tanh_(float x) { const float z = 1.5957691216057308f * (x + 0.044715f * x * x * x); return x * __builtin_amdgcn_rcpf(1.0f + __builtin_amdgcn_exp2f(-1.4426950408889634f * z)); }
struct EpiGlu {
    static constexpr bool PERM = true, AFTER_DRAIN = false;
    const Args* a; int l;
    __device__ __forceinline__ void operator()(const f32x4 (&acc)[2][2][4][2], const Unit& u, int wr, int wc, int fr_, int fq_) const {
        (void)fr_; (void)fq_; int ln_; asm volatile("v_mbcnt_lo_u32_b32 %0, -1, 0\n\tv_mbcnt_hi_u32_b32 %0, -1, %0" : "=v"(ln_)); const int fr = ln_ & 15, fq = ln_ >> 4;
        bf16_t* ACT = (bf16_t*)(wsptr(*a) + WS_ACT);
        const float* cw = (const float*)inptr(*a, 26) + (size_t)l * 3 * 5632; const float* cb = (const float*)inptr(*a, 27) + (size_t)l * 5632;
        int jcol = u.pn * 128 + wc * 32 + 8 * fq; asm volatile("" : "+v"(jcol));
        f32x4 wu[3][2], wg[3][2], bu[2], bg[2];
#pragma unroll
        for (int n = 0; n < 2; ++n) {
#pragma unroll
            for (int k = 0; k < 3; ++k) { wu[k][n] = *(const f32x4*)(cw + k * 5632 + jcol + 4 * n); wg[k][n] = *(const f32x4*)(cw + k * 5632 + 2816 + jcol + 4 * n); }
            bu[n] = *(const f32x4*)(cb + jcol + 4 * n); bg[n] = *(const f32x4*)(cb + 2816 + jcol + 4 * n); }
        const bool fix = u.pm >= 64; const int pmf = fix ? u.pm - 64 : u.pm;
#pragma unroll
        for (int ai = 0; ai < 2; ++ai)
#pragma unroll
            for (int m = 3; m >= 0; --m) { const int mp = m > 0 ? m - 1 : 0; float o[8];
#pragma unroll
                for (int n = 0; n < 2; ++n)
#pragma unroll
                    for (int e = 0; e < 4; ++e) {
                        const float xu = acc[ai][0][m][n][e], xg = acc[ai][1][m][n][e], yu = acc[ai][0][mp][n][e], yg = acc[ai][1][mp][n][e];
                        const float u1 = dppf<0x121>(fr == 15 ? yu : xu), u2 = dppf<0x122>(fr >= 14 ? yu : xu), g1 = dppf<0x121>(fr == 15 ? yg : xg), g2 = dppf<0x122>(fr >= 14 ? yg : xg);
                        const float cu = bu[n][e] + wu[2][n][e] * xu + wu[1][n][e] * u1 + wu[0][n][e] * u2, cg = bg[n][e] + wg[2][n][e] * xg + wg[1][n][e] * g1 + wg[0][n][e] * g2;
                        o[4 * n + e] = gelu_tanh_(cg) * cu; }
                const int R = pmf * BM + ai * HALF + wr * 64 + m * 16 + fr;
                const bool st = fix ? ((fr & 3) >= 2) : !(m == 0 && fr < 2);
                const int row = fix ? 64 * (R >> 2) + (fr & 3) - 2 : R;
                if (st) { u32x4 w; w.x = cvt_pk_bf16(o[0], o[1]); w.y = cvt_pk_bf16(o[2], o[3]); w.z = cvt_pk_bf16(o[4], o[5]); w.w = cvt_pk_bf16(o[6], o[7]);
                    *(u32x4*)(ACT + (size_t)row * 2816 + jcol) = w; } }
    }
};
template <size_t OFF> struct EpiF32 {
    static constexpr bool PERM = false, AFTER_DRAIN = false;
    const Args* a;
    __device__ __forceinline__ void operator()(const f32x4 (&acc)[2][2][4][2], const Unit& u, int wr, int wc, int fr_, int fq_) const {
        (void)fr_; (void)fq_; int ln_; asm volatile("v_mbcnt_lo_u32_b32 %0, -1, 0\n\tv_mbcnt_hi_u32_b32 %0, -1, %0" : "=v"(ln_)); const int fr = ln_ & 15, fq = ln_ >> 4;
        float* O = (float*)(wsptr(*a) + OFF);
        int row0 = u.pm * BM + wr * 64 + fr, col0 = u.pn * BM + wc * 32 + 4 * fq; asm volatile("" : "+v"(row0), "+v"(col0));
#pragma unroll
        for (int ai = 0; ai < 2; ++ai)
#pragma unroll
            for (int m = 0; m < 4; ++m) { float* rowp = O + (size_t)(row0 + ai * HALF + m * 16) * 1024 + col0;
#pragma unroll
                for (int bj = 0; bj < 2; ++bj)
#pragma unroll
                    for (int n = 0; n < 2; ++n) *(f32x4*)(rowp + bj * HALF + n * 16) = acc[ai][bj][m][n]; }
    }
};

template <class Epi, class Sched, bool ALIGN_EPI = false, bool SP2 = false>
__device__ __forceinline__ void gemm_phase(PG8_LAS unsigned char* lds, const Gemm g, const Sched& S, const Epi& E, int tid_in) {
    int tid_ = tid_in; asm volatile("" : "+v"(tid_));
    const int tid = tid_, wid = __builtin_amdgcn_readfirstlane(tid >> 6), lane = tid & 63, wr = wid >> 2, wc = wid & 3, fr = lane & 15, fq = lane >> 4;
    const int K = g.K, nt = K / BK;
    unsigned voffA[2], voffB[2];
#pragma unroll
    for (int i = 0; i < 2; ++i) { int R, C; stage_rc(tid * 16 + i * 8192, R, C); const int Rb = Epi::PERM ? ((R & ~31) + perm32(R & 31)) : R;
        voffA[i] = (unsigned)(R * g.lda + C) * 2u; voffB[i] = (unsigned)(Rb * K + C) * 2u; }
    const size_t kstep = (size_t)(BK * 2);
    const size_t hstepA = (size_t)HALF * g.lda * 2, hstepB = (size_t)HALF * K * 2;
    const size_t tstepA = 2 * hstepA, tstepB = 2 * hstepB;
    const unsigned ldsw = (unsigned)wid * 1024u;
    const int aoff = lds_byte(wr * 64 + fr, fq * 8), boff = lds_byte(wc * 32 + fr, fq * 8);
#define PG8_SA(b, h) (((b) * 2 + (h)) * HTB)
#define PG8_SB(b, h) ((4 + (b) * 2 + (h)) * HTB)
#define PG8_STAGE(bufoff, gbase, voff) do { _Pragma("unroll") for (int _i = 0; _i < 2; ++_i) \
        __builtin_amdgcn_global_load_lds((const unsigned*)((const char*)(gbase) + (voff)[_i]), (PG8_LAS unsigned*)(lds + (bufoff) + ldsw + _i * 8192), 16, 0, 0); } while (0)
#define PG8_LDA(dst, b, h) do { _Pragma("unroll") for (int m = 0; m < 4; ++m) _Pragma("unroll") for (int k = 0; k < 2; ++k) dst[m][k] = *(const PG8_LAS bf16x8*)(lds + PG8_SA(b, h) + aoff + m * 2048 + k * 1024); } while (0)
#define PG8_LDB(dst, b, h) do { _Pragma("unroll") for (int n = 0; n < 2; ++n) _Pragma("unroll") for (int k = 0; k < 2; ++k) dst[n][k] = *(const PG8_LAS bf16x8*)(lds + PG8_SB(b, h) + boff + n * 2048 + k * 1024); } while (0)
#define PG8_MMA(ai, bj, At, Bt) do { __builtin_amdgcn_s_setprio(1); _Pragma("unroll") for (int m = 0; m < 4; ++m) _Pragma("unroll") for (int n = 0; n < 2; ++n) _Pragma("unroll") for (int k = 0; k < 2; ++k) \
        acc[ai][bj][m][n] = __builtin_amdgcn_mfma_f32_16x16x32_bf16(Bt[n][k], At[m][k], acc[ai][bj][m][n], 0, 0, 0); __builtin_amdgcn_s_setprio(0); } while (0)
#define PG8_WAIT_V(n) asm volatile("s_waitcnt vmcnt(" #n ")" ::: "memory")
#define PG8_WAIT_L(n) asm volatile("s_waitcnt lgkmcnt(" #n ")" ::: "memory")
#define PG8_BAR __builtin_amdgcn_s_barrier()
#define PG8_SCHED __builtin_amdgcn_sched_barrier(0)
    Unit cur, nxt; int ui = 0;
    if (!S.next(0, cur)) return;
    f32x4 acc[2][2][4][2];
#pragma unroll
    for (int a = 0; a < 2; ++a)
#pragma unroll
        for (int b = 0; b < 2; ++b)
#pragma unroll
            for (int m = 0; m < 4; ++m)
#pragma unroll
                for (int n = 0; n < 2; ++n) acc[a][b][m][n] = (f32x4){0.f, 0.f, 0.f, 0.f};
    bf16x8 At[4][2], B0[2][2], B1[2][2];
    const char* cA = (const char*)g.A + (size_t)cur.pm * tstepA + cur.ao; const char* cB = (const char*)g.Bt + (size_t)cur.pn * tstepB;
    S.a_ready(cur);
    if constexpr (SP2) {
        PG8_STAGE(PG8_SB(0, 0), cB, voffB); PG8_STAGE(PG8_SB(0, 1), cB + hstepB, voffB); PG8_STAGE(PG8_SA(0, 0), cA, voffA); PG8_STAGE(PG8_SA(0, 1), cA + hstepA, voffA);
        if (wr == 1) PG8_BAR;
        PG8_WAIT_V(2); PG8_BAR;
        PG8_STAGE(PG8_SB(1, 0), cB + kstep, voffB); PG8_STAGE(PG8_SA(1, 0), cA + kstep, voffA); PG8_STAGE(PG8_SB(1, 1), cB + hstepB + kstep, voffB);
        PG8_WAIT_V(6); PG8_BAR;
    } else {
        PG8_STAGE(PG8_SB(0, 0), cB, voffB); PG8_STAGE(PG8_SA(0, 0), cA, voffA); PG8_STAGE(PG8_SB(0, 1), cB + hstepB, voffB); PG8_STAGE(PG8_SA(0, 1), cA + hstepA, voffA);
        if (wr == 1) PG8_BAR;
        PG8_WAIT_V(4); PG8_BAR;
        PG8_STAGE(PG8_SB(1, 0), cB + kstep, voffB); PG8_STAGE(PG8_SA(1, 0), cA + kstep, voffA); PG8_STAGE(PG8_SB(1, 1), cB + hstepB + kstep, voffB);
        PG8_WAIT_V(6); PG8_BAR;
    }
    for (;;) {
        const bool has_next = S.next(ui + 1, nxt);
        const char* nA = has_next ? (const char*)g.A + (size_t)nxt.pm * tstepA + nxt.ao : cA; const char* nB = has_next ? (const char*)g.Bt + (size_t)nxt.pn * tstepB : cB;
        for (int t = 0; t < nt; t += 2) {
            const bool last = (t == nt - 2);
            const char* a1 = cA + (size_t)(t + 1) * kstep;
            const char* a2 = last ? nA : cA + (size_t)(t + 2) * kstep; const char* b2 = last ? nB : cB + (size_t)(t + 2) * kstep;
            const char* a3 = a2 + kstep; const char* b3 = b2 + kstep;
            if (last && has_next) S.a_ready(nxt);
            if constexpr (SP2) {
            PG8_LDB(B0, 0, 0); PG8_LDB(B1, 0, 1); PG8_SCHED; PG8_LDA(At, 0, 0); PG8_STAGE(PG8_SA(1, 1), a1 + hstepA, voffA);
            PG8_WAIT_V(8); PG8_WAIT_L(0); PG8_BAR; PG8_MMA(0, 0, At, B0); PG8_MMA(0, 1, At, B1); PG8_BAR; PG8_SCHED;
            PG8_LDA(At, 0, 1); PG8_STAGE(PG8_SB(0, 0), b2, voffB); PG8_STAGE(PG8_SB(0, 1), b2 + hstepB, voffB); PG8_STAGE(PG8_SA(0, 0), a2, voffA);
            PG8_WAIT_V(8); PG8_WAIT_L(0); PG8_BAR; PG8_MMA(1, 0, At, B0); PG8_MMA(1, 1, At, B1); PG8_BAR; PG8_SCHED;
            PG8_LDB(B0, 1, 0); PG8_LDB(B1, 1, 1); PG8_SCHED; PG8_LDA(At, 1, 0); PG8_STAGE(PG8_SA(0, 1), a2 + hstepA, voffA);
            PG8_WAIT_V(8); PG8_WAIT_L(0); PG8_BAR; PG8_MMA(0, 0, At, B0); PG8_MMA(0, 1, At, B1); PG8_BAR; PG8_SCHED;
            PG8_LDA(At, 1, 1); PG8_STAGE(PG8_SB(1, 0), b3, voffB); PG8_STAGE(PG8_SB(1, 1), b3 + hstepB, voffB); PG8_STAGE(PG8_SA(1, 0), a3, voffA);
            PG8_WAIT_V(8); PG8_WAIT_L(0); PG8_BAR; PG8_MMA(1, 0, At, B0); PG8_MMA(1, 1, At, B1); PG8_BAR; PG8_SCHED;
            } else {
            PG8_LDB(B0, 0, 0); PG8_SCHED; PG8_LDA(At, 0, 0); PG8_STAGE(PG8_SA(1, 1), a1 + hstepA, voffA);
            PG8_WAIT_L(8); PG8_BAR; PG8_WAIT_L(0); PG8_MMA(0, 0, At, B0); PG8_BAR; PG8_SCHED;
            PG8_LDB(B1, 0, 1); PG8_STAGE(PG8_SB(0, 0), b2, voffB);
            PG8_BAR; PG8_WAIT_L(0); PG8_MMA(0, 1, At, B1); PG8_BAR;
            PG8_LDA(At, 0, 1); PG8_STAGE(PG8_SA(0, 0), a2, voffA);
            PG8_BAR; PG8_WAIT_L(0); PG8_MMA(1, 0, At, B0); PG8_BAR; PG8_SCHED;
            PG8_STAGE(PG8_SB(0, 1), b2 + hstepB, voffB);
            PG8_WAIT_V(6); PG8_BAR; PG8_MMA(1, 1, At, B1); PG8_BAR;
            PG8_LDB(B0, 1, 0); PG8_SCHED; PG8_LDA(At, 1, 0); PG8_STAGE(PG8_SA(0, 1), a2 + hstepA, voffA);
            PG8_WAIT_L(8); PG8_BAR; PG8_WAIT_L(0); PG8_MMA(0, 0, At, B0); PG8_BAR; PG8_SCHED;
            PG8_LDB(B1, 1, 1); PG8_STAGE(PG8_SB(1, 0), b3, voffB);
            PG8_BAR; PG8_WAIT_L(0); PG8_MMA(0, 1, At, B1); PG8_BAR;
            PG8_LDA(At, 1, 1); PG8_STAGE(PG8_SA(1, 0), a3, voffA);
            PG8_BAR; PG8_WAIT_L(0); PG8_MMA(1, 0, At, B0); PG8_BAR; PG8_SCHED;
            PG8_STAGE(PG8_SB(1, 1), b3 + hstepB, voffB);
            PG8_WAIT_V(6); PG8_BAR; PG8_MMA(1, 1, At, B1); PG8_BAR;
            }
        }
        if constexpr (ALIGN_EPI) { if (wr == 0) PG8_BAR; }
        if constexpr (!Epi::AFTER_DRAIN) { E(acc, cur, wr, wc, fr, fq); S.done(cur); }
        if (!has_next) break;
#pragma unroll
        for (int a = 0; a < 2; ++a)
#pragma unroll
            for (int b = 0; b < 2; ++b)
#pragma unroll
                for (int m = 0; m < 4; ++m)
#pragma unroll
                    for (int n = 0; n < 2; ++n) acc[a][b][m][n] = (f32x4){0.f, 0.f, 0.f, 0.f};
        cur = nxt; cA = nA; cB = nB; ++ui;
        if constexpr (ALIGN_EPI) { if (wr == 1) PG8_BAR; }
    }
    PG8_WAIT_V(0);
    if constexpr (!ALIGN_EPI) { if (wr == 0) PG8_BAR; }
    PG8_BAR;
    if constexpr (Epi::AFTER_DRAIN) { E.fused(acc, cur, wr, wc, fr, fq, lds, wid, lane); S.done(cur); }
#undef PG8_SA
#undef PG8_SB
#undef PG8_STAGE
#undef PG8_LDA
#undef PG8_LDB
#undef PG8_MMA
#undef PG8_WAIT_V
#undef PG8_WAIT_L
#undef PG8_BAR
#undef PG8_SCHED
}
}

#define GAS __attribute__((address_space(1)))
#define LAS __attribute__((address_space(3)))
typedef unsigned short bf16;
typedef unsigned v4u __attribute__((ext_vector_type(4)));
typedef float f32x4 __attribute__((ext_vector_type(4)));
typedef short bf16x8 __attribute__((ext_vector_type(8)));
typedef GAS unsigned gu32;
typedef GAS unsigned long long gu64;
#define RLX_AGENT __ATOMIC_RELAXED, __HIP_MEMORY_SCOPE_AGENT
#define LDS_WAIT() asm volatile("s_waitcnt lgkmcnt(0)" ::: "memory")
#define VM_WAIT() asm volatile("s_waitcnt vmcnt(0)" ::: "memory")
__device__ __forceinline__ unsigned long long rt() { return __builtin_amdgcn_s_memrealtime(); }
__device__ __forceinline__ unsigned f2bf(float f) { unsigned u = __builtin_bit_cast(unsigned, f); return (u + 0x7fffu + ((u >> 16) & 1u)) >> 16; }
__device__ __forceinline__ unsigned pk2(float lo, float hi) { return f2bf(lo) | (f2bf(hi) << 16); }

#define XB_TMO      128
#define XB_XCNT(j)  (256  + 64 * (j))
#define XB_XSUB(j)  (1280 + 64 * (j))
#define XB_XGEN(j)  (2304 + 64 * (j))
#define XB_TOP      3328
#define XB_TOPGEN   3392
#define XCD_BAR_WORDS 3456
#define XB_SPIN_CAP (1u << 18)

__device__ __forceinline__ unsigned xb_ld(unsigned* p)              { return __hip_atomic_load(p, __ATOMIC_RELAXED, __HIP_MEMORY_SCOPE_AGENT); }
__device__ __forceinline__ unsigned xb_add(unsigned* p, unsigned v) { return __hip_atomic_fetch_add(p, v, __ATOMIC_RELAXED, __HIP_MEMORY_SCOPE_AGENT); }
__device__ __forceinline__ unsigned xb_xcc_id() { return (unsigned)__builtin_amdgcn_s_getreg((3 << 11) | 20) & 0xFu; }
#define XB_SPIN(cond, bar) do { unsigned _sp = 0; while (cond) { __builtin_amdgcn_s_sleep(1); \
    if ((++_sp & 255u) == 0u) { if (xb_ld(&(bar)[XB_TMO])) break; if (_sp > XB_SPIN_CAP) { atomicAdd(&(bar)[XB_TMO], 1u); break; } } } } while (0)

struct XcdBarrier {
    unsigned* bar; unsigned x;
    volatile LAS unsigned* st;
};

__device__ __forceinline__ XcdBarrier xcd_barrier_post(unsigned* bar, volatile LAS unsigned* st) {
    XcdBarrier b; b.bar = bar; b.x = xb_xcc_id(); b.st = st;
    if (threadIdx.x == 0) (void)xb_add(&bar[XB_XCNT(b.x)], 1u);
    return b;
}
__device__ __forceinline__ void xcd_barrier_complete(unsigned* bar, unsigned x, unsigned& nloc, unsigned& nx) {
    const unsigned G = gridDim.x * gridDim.y * gridDim.z;
    unsigned sum, cnt, mine, sp = 0u;
    for (;;) {
        sum = 0u; cnt = 0u; mine = 0u;
#pragma unroll
        for (unsigned j = 0; j < 16; ++j) { const unsigned c = xb_ld(&bar[XB_XCNT(j)]); sum += c; cnt += (c > 0u) ? 1u : 0u; mine = (j == x) ? c : mine; }
        if (sum == G) break;
        __builtin_amdgcn_s_sleep(1);
        if ((++sp & 255u) == 0u) { if (xb_ld(&bar[XB_TMO])) break; if (sp > XB_SPIN_CAP) { atomicAdd(&bar[XB_TMO], 1u); break; } }
    }
    nloc = mine > 0u ? mine : 1u; nx = cnt > 0u ? cnt : 1u;
}

__device__ __forceinline__ void xcd_barrier(const XcdBarrier& b) {
    asm volatile("s_waitcnt vmcnt(0)" ::: "memory");
    __syncthreads();
    if (threadIdx.x == 0) {
        unsigned* bar = b.bar;
        __builtin_amdgcn_s_waitcnt(0);
        unsigned nloc = b.st[0], nx = b.st[1];
        if (nloc == 0u) { xcd_barrier_complete(bar, b.x, nloc, nx); b.st[0] = nloc; b.st[1] = nx; }
        const unsigned old = xb_add(&bar[XB_XSUB(b.x)], 1u);
        const unsigned gen = old / nloc;
        if (old + 1u == (gen + 1u) * nloc) {
            __builtin_amdgcn_fence(__ATOMIC_RELEASE, "agent");
            asm volatile("s_waitcnt vmcnt(0)" ::: "memory");
            const unsigned og = xb_add(&bar[XB_TOP], 1u);
            const unsigned tg = og / nx;
            if (og + 1u == (tg + 1u) * nx) xb_add(&bar[XB_TOPGEN], 1u);
            else XB_SPIN(xb_ld(&bar[XB_TOPGEN]) == tg, bar);
            __builtin_amdgcn_fence(__ATOMIC_ACQUIRE, "agent");
            xb_add(&bar[XB_XGEN(b.x)], 1u);
            asm volatile("s_waitcnt vmcnt(0)" ::: "memory");
        } else {
            XB_SPIN(xb_ld(&bar[XB_XGEN(b.x)]) == gen, bar);
            __builtin_amdgcn_fence(__ATOMIC_ACQUIRE, "agent");
            asm volatile("s_waitcnt vmcnt(0)" ::: "memory");
        }
    }
    __syncthreads();
}

namespace att {
using bf16 = unsigned short;
typedef short bf16x8 __attribute__((ext_vector_type(8)));
typedef short s16x4 __attribute__((ext_vector_type(4)));
typedef float f32x16 __attribute__((ext_vector_type(16)));
typedef float f32x4 __attribute__((ext_vector_type(4)));
typedef unsigned u32x4 __attribute__((ext_vector_type(4)));
constexpr int DQK = 96, DV = 64, NW = 8, QBLK = 32, KVBLK = 64, QB = NW * QBLK;
constexpr int QP = 768, KP = 768, VP = 512, OP = 1536;
constexpr int SHM_V = KVBLK * DV * 2  , SHM_K = KVBLK * 256  ;
constexpr int LDS_BYTES = 2 * SHM_V + 2 * SHM_K + NW * 64 * 4;
constexpr float SCALE = 0.10206207261596575f;
constexpr float THR = 8.f;
#define KSWZ(row, colB) ((row) * 256 + ((colB) ^ (((row) & 7) << 4)))
#define SBAR() __builtin_amdgcn_sched_barrier(0)
__device__ __forceinline__ int v_st(int k, int c) { const int kk = (k & ~0xC) | ((k & 4) << 1) | ((k & 8) >> 1); return ((kk >> 3) * 2 + (c >> 5)) * 512 + ((kk & 7) * 32 + (c & 31)) * 2; }
__device__ __forceinline__ int v_rd_base(int lane) { return ((lane & 3) << 3) | (((lane >> 2) & 3) << 6) | (((lane >> 4) & 1) << 5) | (((lane >> 5) & 1) << 8); }
__device__ __forceinline__ int crow(int r, int hi) { return (r & 3) + 8 * (r >> 2) + 4 * hi; }
typedef float f32x2_t __attribute__((ext_vector_type(2))); typedef __bf16 bf16x2_t __attribute__((ext_vector_type(2)));
__device__ __forceinline__ unsigned cvtpk(float lo, float hi) { f32x2_t v = {lo, hi}; bf16x2_t b = __builtin_convertvector(v, bf16x2_t); return __builtin_bit_cast(unsigned, b); }
__device__ __forceinline__ void mask_tile(f32x16& p0, f32x16& p1, int dq) {
    const float NEG = -__builtin_inff();
#pragma unroll
    for (int r = 0; r < 16; ++r) { const int c = (r & 3) + 8 * (r >> 2); if (dq - c < 0) p0[r] = NEG; if (dq - c - 32 < 0) p1[r] = NEG; }
}
__device__ __forceinline__ void partialSM(f32x16& p0, f32x16& p1, float& m_reg, float& mn, float& alpha) {
    float pmax = p0[0];
#pragma unroll
    for (int r = 1; r < 16; ++r) pmax = fmaxf(pmax, p0[r]);
#pragma unroll
    for (int r = 0; r < 16; ++r) pmax = fmaxf(pmax, p1[r]);
    { auto rr = __builtin_amdgcn_permlane32_swap(__float_as_uint(pmax), __float_as_uint(pmax), false, false);
      pmax = fmaxf(__uint_as_float(rr[0]), __uint_as_float(rr[1])); }
    constexpr float C2 = 1.4426950408889634f * SCALE;
    if (__builtin_expect(__all((pmax - m_reg) * SCALE <= THR), 1)) { mn = m_reg; alpha = 1.f; }
    else { mn = fmaxf(m_reg, pmax); alpha = __builtin_amdgcn_exp2f((m_reg - mn) * C2); m_reg = mn; }
    const float mnL = -mn * C2;
#pragma unroll
    for (int r = 0; r < 16; ++r) p0[r] = fmaf(p0[r], C2, mnL);
#pragma unroll
    for (int r = 0; r < 16; ++r) p1[r] = fmaf(p1[r], C2, mnL);
#pragma unroll
    for (int r = 0; r < 16; ++r) p0[r] = __builtin_amdgcn_exp2f(p0[r]);
}
__device__ __forceinline__ void finishSM(f32x16& p0, f32x16& p1, float alpha, float& l_reg, bf16x8& pa0, bf16x8& pa1, bf16x8& pa2, bf16x8& pa3) {
#pragma unroll
    for (int r = 0; r < 16; ++r) p1[r] = __builtin_amdgcn_exp2f(p1[r]);
    float ps = 0;
#pragma unroll
    for (int r = 0; r < 16; ++r) ps += p0[r];
#pragma unroll
    for (int r = 0; r < 16; ++r) ps += p1[r];
    { auto rr = __builtin_amdgcn_permlane32_swap(__float_as_uint(ps), __float_as_uint(ps), false, false);
      ps = __uint_as_float(rr[0]) + __uint_as_float(rr[1]); }
    l_reg = l_reg * alpha + ps;
#define PK4(P, B_, OUT) do { unsigned a0 = cvtpk(P[B_+0], P[B_+1]), a1 = cvtpk(P[B_+2], P[B_+3]);                          \
        unsigned b0 = cvtpk(P[B_+4], P[B_+5]), b1 = cvtpk(P[B_+6], P[B_+7]);                                             \
        auto r0 = __builtin_amdgcn_permlane32_swap(a0, b0, false, false); auto r1 = __builtin_amdgcn_permlane32_swap(a1, b1, false, false); \
        u32x4 w = {r0[0], r1[0], r0[1], r1[1]}; OUT = *reinterpret_cast<bf16x8*>(&w); } while (0)
    PK4(p0, 0, pa0); PK4(p0, 8, pa1); PK4(p1, 0, pa2); PK4(p1, 8, pa3);
#undef PK4
}
template <int KB>
__device__ __forceinline__ void qkt(f32x16& p0, f32x16& p1, const char* K_lds, int r32, int hi, const bf16x8* qr) {
    p0 = f32x16{}; p1 = f32x16{};
    const char* kb[4];
#pragma unroll
    for (int dd = 0; dd < 4; ++dd) kb[dd] = K_lds + KB * SHM_K + KSWZ(r32, (dd * 16 + hi * 8) * 2);
#pragma unroll
    for (int d0 = 0; d0 < 6; ++d0) { const char* a = kb[d0 & 3] + (d0 >> 2) * 128;
        bf16x8 b0 = *reinterpret_cast<const bf16x8*>(a);
        bf16x8 b1 = *reinterpret_cast<const bf16x8*>(a + 32 * 256);
        p0 = __builtin_amdgcn_mfma_f32_32x32x16_bf16(b0, qr[d0], p0, 0, 0, 0);
        p1 = __builtin_amdgcn_mfma_f32_32x32x16_bf16(b1, qr[d0], p1, 0, 0, 0); }
}
template <int VB>
__device__ __forceinline__ void pv_tile(f32x16* o, int vb0, bf16x8 pa0, bf16x8 pa1, bf16x8 pa2, bf16x8 pa3) {
#define TRRD(dst, off) asm volatile("ds_read_b64_tr_b16 %0, %1 offset:%2" : "=&v"(dst) : "v"(vb0), "i"(off) : "memory")
#define PV_D0(d0) do { s16x4 l0, l1, l2, l3, h0, h1, h2, h3; constexpr int b_ = VB * SHM_V + (d0) * 512;   \
        TRRD(l0, b_); TRRD(h0, b_ + 1024); TRRD(l1, b_ + 2048); TRRD(h1, b_ + 3072); TRRD(l2, b_ + 4096); TRRD(h2, b_ + 5120); TRRD(l3, b_ + 6144); TRRD(h3, b_ + 7168); \
        asm volatile("s_waitcnt lgkmcnt(0)" ::: "memory"); SBAR();   \
        o[d0] = __builtin_amdgcn_mfma_f32_32x32x16_bf16(pa0, (bf16x8){l0[0], l0[1], l0[2], l0[3], h0[0], h0[1], h0[2], h0[3]}, o[d0], 0, 0, 0);   \
        o[d0] = __builtin_amdgcn_mfma_f32_32x32x16_bf16(pa1, (bf16x8){l1[0], l1[1], l1[2], l1[3], h1[0], h1[1], h1[2], h1[3]}, o[d0], 0, 0, 0);   \
        o[d0] = __builtin_amdgcn_mfma_f32_32x32x16_bf16(pa2, (bf16x8){l2[0], l2[1], l2[2], l2[3], h2[0], h2[1], h2[2], h2[3]}, o[d0], 0, 0, 0);   \
        o[d0] = __builtin_amdgcn_mfma_f32_32x32x16_bf16(pa3, (bf16x8){l3[0], l3[1], l3[2], l3[3], h3[0], h3[1], h3[2], h3[3]}, o[d0], 0, 0, 0); } while (0)
    PV_D0(0); PV_D0(1);
#undef PV_D0
#undef TRRD
}
struct BlockRef { const bf16* Q; const bf16* K; const bf16* V; bf16* O; int P0; };
struct Seam { bf16x8 qr[6]; bf16x8 st_v, st_k0, st_k1; };
#define VMW() asm volatile("s_waitcnt vmcnt(0)" ::: "memory")
#define VMWN(n) asm volatile("s_waitcnt vmcnt(%0)" :: "i"(n) : "memory")
#define SLOAD(Kp_, Vp_, k0) do { S.st_v = *(const bf16x8*)((Vp_) + (size_t)((k0) + vr) * VP + vc);                                   \
        if (kact) { S.st_k0 = *(const bf16x8*)((Kp_) + (size_t)((k0) + sr) * KP + kc); S.st_k1 = *(const bf16x8*)((Kp_) + (size_t)((k0) + 32 + sr) * KP + kc); } } while (0)
#define SWRITE_K(bf) do { if (kact) { *(bf16x8*)(K_lds + (bf) * SHM_K + kws) = S.st_k0; *(bf16x8*)(K_lds + (bf) * SHM_K + kws + 32 * 256) = S.st_k1; } } while (0)
#define SWRITE_V(bf) do { *(bf16x8*)(V_lds + (bf) * SHM_V + vst) = S.st_v; } while (0)
#define STG_DECL const int sr = tid >> 4, kc = ((tid & 15) < 12 ? (tid & 15) : 11) * 8; const bool kact = true; const int kws = KSWZ(sr, kc * 2); \
        const int vr = tid >> 3, vc = (tid & 7) * 8, vst = v_st(vr, vc);
__device__ __forceinline__ void attn_prime(const BlockRef& cur, char* lds, Seam& S, int tid_in) {
    int tid_ = tid_in; asm volatile("" : "+v"(tid_)); const int tid = tid_, wid = __builtin_amdgcn_readfirstlane(tid >> 6), lane = tid & 63, r32 = lane & 31, hi = lane >> 5;
    STG_DECL; (void)vst; char* K_lds = lds + 2 * SHM_V;
#pragma unroll
    for (int d0 = 0; d0 < 6; ++d0) S.qr[d0] = *(const bf16x8*)(cur.Q + (size_t)(wid * QBLK + r32) * QP + d0 * 16 + hi * 8);
    SLOAD(cur.K, cur.V, 0); VMW(); SWRITE_K(0);
    __syncthreads();
}
__device__ __forceinline__ void attn_block(const BlockRef& cur, const BlockRef& nxt, char* lds, Seam& S, int tid_in) {
    int tid_ = tid_in; asm volatile("" : "+v"(tid_)); const int tid = tid_, wid = __builtin_amdgcn_readfirstlane(tid >> 6), lane = tid & 63, r32 = lane & 31, hi = lane >> 5;
    const int NT = (cur.P0 + QB) / KVBLK;
    const int qlo = cur.P0 + wid * QBLK, qm = qlo + r32 - 4 * hi;
    char* V_lds = lds; char* K_lds = lds + 2 * SHM_V;
    float* ws = (float*)(lds + 2 * SHM_V + 2 * SHM_K) + wid * 64; float* li_l = ws, * al_l = ws + 32;
    float m_reg = -1e30f, l_reg = 0; f32x16 o[2] = {};
    STG_DECL;
    const int vb0 = (int)(uintptr_t)V_lds + v_rd_base(lane);
    const bf16* Kh = cur.K; const bf16* Vh = cur.V;
#define RESC(a) do { if (__any((a) < 1.f)) { if (hi == 0) al_l[r32] = (a); asm volatile("s_waitcnt lgkmcnt(0)" ::: "memory");              \
                     _Pragma("unroll") for (int d_ = 0; d_ < 2; ++d_) _Pragma("unroll") for (int r = 0; r < 16; ++r) o[d_][r] *= al_l[crow(r, hi)]; } } while (0)
#define KBASE(t) ((t) * KVBLK)
#define MASKT(P0_, P1_, t) do { const int kb_ = KBASE(t); if (kb_ + KVBLK - 1 > qlo) mask_tile(P0_, P1_, qm - kb_); } while (0)
    constexpr int NQL = 6;
#define SEAM_K0() do { VMWN(NQL); SWRITE_K(0); SBAR(); } while (0)
    f32x16 pA0, pA1, pB0, pB1; float mnA, mnB, alA, alB; bf16x8 pa0, pa1, pa2, pa3;
    SWRITE_V(0); SBAR();
    if (NT > 1) { SLOAD(Kh, Vh, KBASE(1)); }
    SBAR(); qkt<0>(pA0, pA1, K_lds, r32, hi, S.qr);
    MASKT(pA0, pA1, 0); partialSM(pA0, pA1, m_reg, mnA, alA);
    if (NT > 1) { VMW(); SWRITE_V(1); SWRITE_K(1); }
    __syncthreads();
#define HALF_STEP(PX0, PX1, mnX, alX, PY0, PY1, alY, t, KB, VB, SB) do {                                                      \
        SBAR(); qkt<KB>(PX0, PX1, K_lds, r32, hi, S.qr);                                                                      \
        finishSM(PY0, PY1, alY, l_reg, pa0, pa1, pa2, pa3); SBAR();                                                           \
        if ((t) + 1 < NT) { SLOAD(Kh, Vh, KBASE((t) + 1)); SBAR(); }                                                          \
        pv_tile<VB>(o, vb0, pa0, pa1, pa2, pa3); MASKT(PX0, PX1, (t)); partialSM(PX0, PX1, m_reg, mnX, alX);                  \
        __syncthreads();                                                                                                      \
        if ((t) + 1 < NT) { VMW(); SWRITE_V(SB); SWRITE_K(SB); }                                                              \
        RESC(alX); __syncthreads(); } while (0)
    for (int t = 1; t + 1 < NT; t += 2) {
        HALF_STEP(pB0, pB1, mnB, alB, pA0, pA1, alA, t, 1, 0, 0);
        HALF_STEP(pA0, pA1, mnA, alA, pB0, pB1, alB, t + 1, 0, 1, 1);
    }
    SBAR(); qkt<1>(pB0, pB1, K_lds, r32, hi, S.qr); SBAR();
    SLOAD(nxt.K, nxt.V, 0); SBAR();
#pragma unroll
    for (int d0 = 0; d0 < 6; ++d0) S.qr[d0] = *(const bf16x8*)(nxt.Q + (size_t)(wid * QBLK + r32) * QP + d0 * 16 + hi * 8);
    SBAR();
    finishSM(pA0, pA1, alA, l_reg, pa0, pa1, pa2, pa3); SBAR();
    pv_tile<0>(o, vb0, pa0, pa1, pa2, pa3);
    MASKT(pB0, pB1, NT - 1); partialSM(pB0, pB1, m_reg, mnB, alB); __syncthreads(); RESC(alB);
    finishSM(pB0, pB1, alB, l_reg, pa0, pa1, pa2, pa3); SBAR(); pv_tile<1>(o, vb0, pa0, pa1, pa2, pa3);
    SBAR(); SEAM_K0();
    if (hi == 0) li_l[r32] = l_reg; asm volatile("s_waitcnt lgkmcnt(0)" ::: "memory");
    float rli[16];
#pragma unroll
    for (int r = 0; r < 16; ++r) rli[r] = __builtin_amdgcn_rcpf(li_l[crow(r, hi)]);
    bf16* Ow = cur.O + (size_t)(wid * QBLK) * OP;
#pragma unroll
    for (int r = 0; r < 16; ++r) { const int orow = crow(r, hi);
#pragma unroll
        for (int d0 = 0; d0 < 2; ++d0) { const float v = o[d0][r] * rli[r];
            const float vn = __int_as_float(__builtin_amdgcn_mov_dpp(__float_as_int(v), 0xB1, 0xf, 0xf, true));
            if ((r32 & 1) == 0) *(unsigned*)(Ow + (size_t)orow * OP + d0 * 32 + r32) = cvtpk(v, vn); } }
    __syncthreads();
#undef RESC
#undef KBASE
#undef MASKT
#undef SEAM_K0
#undef HALF_STEP
}
#undef VMW
#undef VMWN
#undef SLOAD
#undef SWRITE_K
#undef SWRITE_V
#undef STG_DECL
#undef SBAR
}


template <int O> __device__ __forceinline__ float swz_xor(float v) { return __int_as_float(__builtin_amdgcn_ds_swizzle(__float_as_int(v), (O << 10) | 0x1f)); }
__device__ __forceinline__ float half_sum(float v) { auto rr = __builtin_amdgcn_permlane32_swap(__float_as_uint(v), __float_as_uint(v), false, false); return __uint_as_float(rr[0]) + __uint_as_float(rr[1]); }
__device__ __forceinline__ float wave_sum(float v) {
    v += swz_xor<1>(v); v += swz_xor<2>(v); v += swz_xor<4>(v); v += swz_xor<8>(v); v += swz_xor<16>(v);
    return half_sum(v);
}
__device__ __forceinline__ float bf2f(bf16 h) { return __uint_as_float((unsigned)h << 16); }
__device__ __forceinline__ float gelu_tanh(float x) { const float z = 1.5957691216057308f * (x + 0.044715f * x * x * x); return x * __builtin_amdgcn_rcpf(1.0f + __builtin_amdgcn_exp2f(-1.4426950408889634f * z)); }
__device__ __forceinline__ float sigm(float x) { return __builtin_amdgcn_rcpf(1.0f + __builtin_amdgcn_exp2f(-1.4426950408889634f * x)); }
__device__ __forceinline__ void unpack8(const v4u w, float* f) { f[0] = __uint_as_float(w.x << 16); f[1] = __uint_as_float(w.x & 0xffff0000u); f[2] = __uint_as_float(w.y << 16); f[3] = __uint_as_float(w.y & 0xffff0000u);
    f[4] = __uint_as_float(w.z << 16); f[5] = __uint_as_float(w.z & 0xffff0000u); f[6] = __uint_as_float(w.w << 16); f[7] = __uint_as_float(w.w & 0xffff0000u); }
__device__ __forceinline__ v4u pack8f(const float* f) { v4u o; o.x = pk2(f[0], f[1]); o.y = pk2(f[2], f[3]); o.z = pk2(f[4], f[5]); o.w = pk2(f[6], f[7]); return o; }

__device__ __forceinline__ int il2(int i, int half) { return i < half ? 2 * i : 2 * (i - half) + 1; }
__device__ __forceinline__ int dstrow(int kind, int s) {
    if (kind == 0) return s;
    if (kind == 1) {
        if (s < 1024) return s;
        if (s < 2048) { const int base = s < 1536 ? 1024 : 1536, w = s - base; return base + (w & ~63) + il2(w & 63, 32); }
        if (s < 3712) return s;
        if (s < 3744) return 3712 + il2(s - 3712, 16);
        return 3840 + (s - 3744);
    }
    if (kind == 3) { const int hd = s / 96, w = s - hd * 96; return w < 64 ? s : hd * 96 + 64 + il2(w - 64, 16); }
    { const int t = s < 2816 ? s : s - 2816; return (t >> 7) * 256 + (t & 127) + (s < 2816 ? 0 : 128); }
}
__device__ __forceinline__ void conv_item(const float* W, int K, int Nsrc, bf16* WT, int kind, const float* ksc, LAS float* scr, int item, int nblk, int lane) {
    const int kb = item / nblk, nb = item - kb * nblk, k0 = 64 * kb, s0 = 32 * nb;
    const int j4 = (lane & 7) * 4, kr = lane >> 3;
#pragma unroll
    for (int i = 0; i < 8; ++i) { const int kk = 8 * i + kr; f32x4 v = *(const f32x4*)(W + (size_t)(k0 + kk) * Nsrc + s0 + j4); if (ksc) v = v * ksc[k0 + kk];
        scr[kk * 33 + j4] = v.x; scr[kk * 33 + j4 + 1] = v.y; scr[kk * 33 + j4 + 2] = v.z; scr[kk * 33 + j4 + 3] = v.w; }
    LDS_WAIT(); asm volatile("" ::: "memory");
    const int c = lane & 7;
#pragma unroll
    for (int j = 0; j < 4; ++j) { const int n = (lane >> 3) + 8 * j; const LAS float* s = scr + (8 * c) * 33 + n;
        v4u o; o.x = pk2(s[0 * 33], s[1 * 33]); o.y = pk2(s[2 * 33], s[3 * 33]); o.z = pk2(s[4 * 33], s[5 * 33]); o.w = pk2(s[6 * 33], s[7 * 33]);
        *(GAS v4u*)(WT + (size_t)dstrow(kind, s0 + n) * K + k0 + 8 * c) = o; }
    LDS_WAIT(); asm volatile("" ::: "memory");
}
__device__ __forceinline__ int conv_matrix(const Ctx& X, LAS unsigned char* lds, int base, const float* W, int K, int Nsrc, bf16* WT, int kind, const float* ksc) {
    LAS float* scr = (LAS float*)(lds + X.wave * 16384);
    const int gw = X.vcu * NWAVES + X.wave, NGW = X.G * NWAVES, nblk = Nsrc / 32, nitems = (K / 64) * nblk;
    int first = (gw - base) % NGW; if (first < 0) first += NGW;
    for (int it = first; it < nitems; it += NGW) conv_item(W, K, Nsrc, WT, kind, ksc, scr, it, nblk, X.lane);
    return base + nitems;
}
__device__ __forceinline__ void convert_mixer(const Ctx& X, LAS unsigned char* lds, const Args& a, int l) {
    bf16* Wb = (bf16*)(wsptr(a) + WS_W); int base = 0;
    base = conv_matrix(X, lds, base, (const float*)inptr(a, I_WIN) + (size_t)l * 1024 * NIN, 1024, NIN, (bf16*)((char*)Wb + WO_IN), 1, nullptr);
    base = conv_matrix(X, lds, base, (const float*)inptr(a, I_WOUT) + (size_t)l * 1024 * 1024, 1024, 1024, (bf16*)((char*)Wb + WO_OUT), 0, nullptr);
    base = conv_matrix(X, lds, base, (const float*)inptr(a, I_LWO) + (size_t)l * 512 * 1024, 512, 1024, (bf16*)((char*)Wb + WO_O3), 0, nullptr);
    base = conv_matrix(X, lds, base, (const float*)inptr(a, I_RWO) + (size_t)l * 512 * 1024, 512, 1024, (bf16*)((char*)Wb + WO_O3) + 1024 * 512, 0, nullptr);
    base = conv_matrix(X, lds, base, (const float*)inptr(a, I_MWO) + (size_t)l * 512 * 1024, 512, 1024, (bf16*)((char*)Wb + WO_O3) + 2 * 1024 * 512, 0, nullptr);
    base = conv_matrix(X, lds, base, (const float*)inptr(a, I_WUQ) + (size_t)l * 384 * 768, 384, 768, (bf16*)((char*)Wb + WO_UQ), 3, (const float*)inptr(a, I_QNG) + l * 384);
    base = conv_matrix(X, lds, base, (const float*)inptr(a, I_WUKV) + (size_t)l * 256 * 1024, 256, 1024, (bf16*)((char*)Wb + WO_UKV), 0, (const float*)inptr(a, I_KVNG) + l * 256);
#pragma unroll 1
    for (int blk = 0; blk < 8; ++blk) {
        base = conv_matrix(X, lds, base, (const float*)inptr(a, I_LWA) + (size_t)(l * 8 + blk) * 4096, 64, 64, (bf16*)((char*)Wb + WO_AT) + blk * 4096, 0, nullptr);
        base = conv_matrix(X, lds, base, (const float*)inptr(a, I_LWX) + (size_t)(l * 8 + blk) * 4096, 64, 64, (bf16*)((char*)Wb + WO_XT) + blk * 4096, 0, nullptr);
    }
    { const int gt = X.vcu * 512 + X.tid, nth = X.G * 512; const unsigned zz = (unsigned)opaque_u(0); v4u z; z.x = zz; z.y = zz; z.z = zz; z.w = zz;
      for (int i = gt; i < 96 * 128; i += nth) *(GAS v4u*)((bf16*)((char*)Wb + WO_IN) + (size_t)3744 * 1024 + (size_t)i * 8) = z; }
}
__device__ __forceinline__ void convert_ffn(const Ctx& X, LAS unsigned char* lds, const Args& a, int l) {
    bf16* Wb = (bf16*)(wsptr(a) + WS_W); int base = 0;
    base = conv_matrix(X, lds, base, (const float*)inptr(a, I_WUP) + (size_t)l * 1024 * 5632, 1024, 5632, (bf16*)((char*)Wb + WO_UP), 4, nullptr);
    base = conv_matrix(X, lds, base, (const float*)inptr(a, I_WDOWN) + (size_t)l * 2816 * 1024, 2816, 1024, (bf16*)((char*)Wb + WO_DOWN), 0, nullptr);
}

__device__ __forceinline__ void p_mods(const Ctx& X, LAS unsigned char* lds, const Args& a) {
    LAS float* cact = (LAS float*)lds; LAS float* red = (LAS float*)(lds + 8192);
    const float* c = (const float*)inptr(a, I_C);
    for (int i = X.tid; i < NB * 1024; i += 512) { const float v = c[i]; cact[i] = v * sigm(v); }
    __syncthreads();
    float* MOD = (float*)(wsptr(a) + WS_MOD);
    const float* adaw = (const float*)inptr(a, I_ADAW); const float* adab = (const float*)inptr(a, I_ADAB);
    for (int it = X.vcu; it < DEPTH * 96; it += X.G) {
        const int l = it / 96, j0 = (it - l * 96) * 64, cl = X.tid & 63, ks = X.tid >> 6;
        const float* w = adaw + (size_t)l * 1024 * 6144 + j0 + cl;
        float a0 = 0.f, a1 = 0.f;
#pragma unroll 8
        for (int k = ks * 128; k < ks * 128 + 128; ++k) { const float wv = w[(size_t)k * 6144]; a0 += cact[k] * wv; a1 += cact[1024 + k] * wv; }
        red[(ks * 64 + cl) * 2] = a0; red[(ks * 64 + cl) * 2 + 1] = a1;
        __syncthreads();
        if (X.tid < 128) { const int cc = X.tid & 63, b = X.tid >> 6; float s = 0.f;
#pragma unroll
            for (int q = 0; q < 8; ++q) s += red[(q * 64 + cc) * 2 + b];
            MOD[(size_t)(l * NB + b) * 6144 + j0 + cc] = s + adab[l * 6144 + j0 + cc]; }
        __syncthreads();
    }
}
__device__ __forceinline__ void p_rope(const Ctx& X, const Args& a) {
    float* cr = (float*)(wsptr(a) + WS_ROPE); float* sr = cr + (size_t)M * 32; float* cm = sr + (size_t)M * 32; float* sm = cm + (size_t)M * 16;
    const int* pos = (const int*)inptr(a, I_POS);
    const int nth = X.G * 512;
    for (int idx = X.vcu * 512 + X.tid; idx < M * 32; idx += nth) {
        const int row = idx >> 5, i = idx & 31;
        const double ang = (double)pos[row] * INVR[i];
        const double k = __builtin_rint(ang * 0.15915494309189535);
        double r = __builtin_fma(-k, 6.283185307179586, ang); r = __builtin_fma(-k, 2.4492935982947064e-16, r);
        const float rf = (float)r; const float sn = sinf(rf), cs = cosf(rf);
        cr[idx] = cs; sr[idx] = sn;
        if ((i & 1) == 0) { cm[row * 16 + (i >> 1)] = cs; sm[row * 16 + (i >> 1)] = sn; }
    }
}

template <int MODE, bool HAS_NEXT, bool HALO = false>
__device__ __forceinline__ void row_pass(const Ctx& X, const float* xin, float* xout, const bf16* Y, const float* gpost, const float* gate  ,
                                         const float* gpre, const float* shift, const float* scale, bf16* XN) {
    const int gw = X.vcu * NWAVES + X.wave, NGW = X.G * NWAVES, lane = X.lane;
    for (int b = 0; b < NB; ++b) {
        f32x4 vgp[4], vgt[4], vpre[4], vsh[4], vsc[4];
#pragma unroll
        for (int j = 0; j < 4; ++j) { const int cidx = 4 * lane + 256 * j;
            if (MODE == 1) { vgp[j] = *(const f32x4*)(gpost + cidx); vgt[j] = *(const f32x4*)(gate + (size_t)b * 6144 + cidx); }
            if (MODE == 0 || HAS_NEXT) { vpre[j] = *(const f32x4*)(gpre + cidx); vsh[j] = *(const f32x4*)(shift + (size_t)b * 6144 + cidx); vsc[j] = *(const f32x4*)(scale + (size_t)b * 6144 + cidx) + 1.0f; } }
        for (int m = gw; m < SEQ; m += NGW) { const size_t row = (size_t)b * SEQ + m;
            f32x4 xv[4];
#pragma unroll
            for (int j = 0; j < 4; ++j) xv[j] = *(const f32x4*)(xin + row * 1024 + 4 * lane + 256 * j);
            if (MODE == 1) { f32x4 yv[4]; float s = 0.f;
#pragma unroll
                for (int j = 0; j < 4; ++j) { const u32x2 yw = *(const u32x2*)(Y + row * 1024 + 4 * lane + 256 * j); yv[j].x = __uint_as_float(yw.x << 16); yv[j].y = __uint_as_float(yw.x & 0xffff0000u); yv[j].z = __uint_as_float(yw.y << 16); yv[j].w = __uint_as_float(yw.y & 0xffff0000u); s += (yv[j].x * yv[j].x + yv[j].y * yv[j].y) + (yv[j].z * yv[j].z + yv[j].w * yv[j].w); }
                const float rs = __builtin_amdgcn_rsqf(wave_sum(s) * (1.0f / 1024.0f) + EPS);
#pragma unroll
                for (int j = 0; j < 4; ++j) { xv[j] = xv[j] + vgt[j] * (yv[j] * rs * vgp[j]); *(f32x4*)(xout + row * 1024 + 4 * lane + 256 * j) = xv[j]; } }
            if (MODE == 0 || HAS_NEXT) { float s = 0.f;
#pragma unroll
                for (int j = 0; j < 4; ++j) s += (xv[j].x * xv[j].x + xv[j].y * xv[j].y) + (xv[j].z * xv[j].z + xv[j].w * xv[j].w);
                const float rs = __builtin_amdgcn_rsqf(wave_sum(s) * (1.0f / 1024.0f) + EPS);
#pragma unroll
                for (int j = 0; j < 4; ++j) { const f32x4 h = (xv[j] * rs * vpre[j]) * vsc[j] + vsh[j];
                    u32x2 w; w.x = pk2(h.x, h.y); w.y = pk2(h.z, h.w); *(u32x2*)(XN + row * 1024 + 4 * lane + 256 * j) = w;
                    if (HALO) { bf16* XNH = XN + (size_t)M * 1024; const int r64 = m & 63, q = (int)(row >> 6);
                        if (r64 >= 62) { const int qn = q + 1; if ((qn & 127) != 0) *(u32x2*)(XNH + (size_t)(4 * qn + r64 - 62) * 1024 + 4 * lane + 256 * j) = w; }
                        if (r64 <= 1) *(u32x2*)(XNH + (size_t)(4 * q + 2 + r64) * 1024 + 4 * lane + 256 * j) = w;
                        if (m == 0) { u32x2 z; z.x = 0u; z.y = 0u; *(u32x2*)(XNH + (size_t)(4 * q) * 1024 + 4 * lane + 256 * j) = z; *(u32x2*)(XNH + (size_t)(4 * q + 1) * 1024 + 4 * lane + 256 * j) = z; } } } }
        }
    }
}

__device__ __forceinline__ void p_mla_rstd(const Ctx& X, const Args& a) {
    const bf16* TM = (const bf16*)(wsptr(a) + WS_TM); float* RSTD = (float*)(wsptr(a) + WS_RSTD);
    const int gw = X.vcu * NWAVES + X.wave, NGW = X.G * NWAVES, lane = X.lane;
    for (int m0 = gw * 4; m0 < M; m0 += NGW * 4) {
        u32x2 w[4][3];
#pragma unroll
        for (int r = 0; r < 4; ++r)
#pragma unroll
            for (int k = 0; k < 3; ++k) w[r][k] = *(const u32x2*)(TM + (size_t)(m0 + r) * 768 + k * 256 + lane * 4);
#pragma unroll
        for (int r = 0; r < 4; ++r) { float sq = 0.f, skv = 0.f;
#pragma unroll
            for (int k = 0; k < 3; ++k) { const float f0 = __uint_as_float(w[r][k].x << 16), f1 = __uint_as_float(w[r][k].x & 0xffff0000u), f2 = __uint_as_float(w[r][k].y << 16), f3 = __uint_as_float(w[r][k].y & 0xffff0000u);
                const float s = (f0 * f0 + f1 * f1) + (f2 * f2 + f3 * f3);
                if (k == 0) sq += s; else if (k == 1) { if (lane < 32) sq += s; else skv += s; } else { if (lane < 32) skv += s; } }
            sq = wave_sum(sq); skv = wave_sum(skv);
            if (lane == 0) { RSTD[m0 + r] = __builtin_amdgcn_rsqf(sq * (1.0f / 384.0f) + EPS); RSTD[M + m0 + r] = __builtin_amdgcn_rsqf(skv * (1.0f / 256.0f) + EPS); } }
    }
}
__device__ __forceinline__ void p_krope(const Ctx& X, const Args& a) {
    const bf16* TM = (const bf16*)(wsptr(a) + WS_TM); bf16* Kp = (bf16*)(wsptr(a) + WS_K);
    const float* cm = (const float*)(wsptr(a) + WS_ROPE) + (size_t)M * 64; const float* sm = cm + (size_t)M * 16;
    const int nth = X.G * 512;
    for (int idx = X.vcu * 512 + X.tid; idx < M * 4; idx += nth) { const int row = idx >> 2, cc = idx & 3;
        const v4u w = *(const v4u*)(TM + (size_t)row * 768 + 640 + cc * 8); float f[8]; unpack8(w, f);
        const f32x4 cs = *(const f32x4*)(cm + (size_t)row * 16 + cc * 4), sn = *(const f32x4*)(sm + (size_t)row * 16 + cc * 4);
        float o[8];
#pragma unroll
        for (int p = 0; p < 4; ++p) { o[2 * p] = f[2 * p] * cs[p] - f[2 * p + 1] * sn[p]; o[2 * p + 1] = f[2 * p] * sn[p] + f[2 * p + 1] * cs[p]; }
        const v4u ow = pack8f(o);
#pragma unroll
        for (int h = 0; h < 8; ++h) *(v4u*)(Kp + (size_t)row * 768 + h * 96 + 64 + cc * 8) = ow; }
}

__device__ __forceinline__ float log1p_small(float e) { return e < 0.03f ? e * (1.0f + e * (-0.5f + e * (0.33333334f + e * (-0.25f + e * 0.2f)))) : 0.6931471805599453f * __builtin_amdgcn_logf(1.0f + e); }
__device__ __forceinline__ float softplus_neg(float x) { const float z = -x, e = __builtin_amdgcn_exp2f(-1.4426950408889634f * __builtin_fabsf(z)); return __builtin_fmaxf(z, 0.0f) + log1p_small(e); }
__device__ __forceinline__ float neg_expm1(float y) { return y > -0.1f ? -y * (1.0f + y * (0.5f + y * (0.16666667f + y * (0.041666668f + y * 0.008333334f)))) : 1.0f - __builtin_amdgcn_exp2f(1.4426950408889634f * y); }
constexpr int LRU_XS = 0, LRU_XC = 33792, LRU_XCB = LRU_XC + 32768, LRU_SEG = LRU_XCB + 18432, LRU_GS = LRU_SEG + 4096, LRU_END = LRU_GS + 16384;
static_assert(LRU_END <= 131072, "lru lds");
template <int PASS>
__device__ __forceinline__ void lru_phase(const Ctx& X, unsigned char* ldsg, const Args& a, int l) {
    float* XS = (float*)(ldsg + LRU_XS); float* XC = (float*)(ldsg + LRU_XC); bf16* XCB = (bf16*)(ldsg + LRU_XCB); float* AA = (float*)(ldsg + LRU_XS); float* SEG = (float*)(ldsg + LRU_SEG); bf16* GS = (bf16*)(ldsg + LRU_GS);
    const bf16* TL = (const bf16*)(wsptr(a) + WS_TL); bf16* YB = (bf16*)(wsptr(a) + WS_YB);
    const bf16* WaT = (const bf16*)(wsptr(a) + WS_W + WO_AT); const bf16* WxT = (const bf16*)(wsptr(a) + WS_W + WO_XT);
    float* LSA = (float*)(wsptr(a) + WS_LSA); float* LSH = (float*)(wsptr(a) + WS_LSH); const float* LC = (const float*)(wsptr(a) + WS_LC);
    const float* cw = (const float*)inptr(a, I_LCW) + l * 4 * 512; const float* cbv = (const float*)inptr(a, I_LCB) + l * 512;
    const float* ba = (const float*)inptr(a, I_LBA) + l * 512; const float* bx = (const float*)inptr(a, I_LBX) + l * 512; const float* lam = (const float*)inptr(a, I_LLAM) + l * 512;
    const int tid = X.tid, lane = X.lane, wave = X.wave, r32 = lane & 31, hi = lane >> 5;
    constexpr int NU = NB * 64 * 8;
    v4u px0, px1, px2, pg0, pg1;
#define LRU_ISSUE(u_) do { const int blk_ = (u_) & 7, n_ = ((u_) >> 3) & 63, b_ = (u_) >> 9; const v4u z_ = {0u, 0u, 0u, 0u}; \
        { const int c_ = tid, r_ = c_ >> 3, cc_ = (c_ & 7) * 8, s_ = n_ * 128 + r_ - 3; px0 = z_; if (s_ >= 0) px0 = *(const v4u*)(TL + ((size_t)b_ * SEQ + s_) * 1024 + blk_ * 64 + cc_); } \
        { const int c_ = tid + 512, r_ = c_ >> 3, cc_ = (c_ & 7) * 8, s_ = n_ * 128 + r_ - 3; px1 = z_; if (s_ >= 0) px1 = *(const v4u*)(TL + ((size_t)b_ * SEQ + s_) * 1024 + blk_ * 64 + cc_); } \
        { const int c_ = tid + 1024, r_ = c_ >> 3, cc_ = (c_ & 7) * 8, s_ = n_ * 128 + r_ - 3; px2 = z_; if (c_ < 131 * 8 && s_ >= 0) px2 = *(const v4u*)(TL + ((size_t)b_ * SEQ + s_) * 1024 + blk_ * 64 + cc_); } \
        if (PASS == 2) { const size_t row0_ = (size_t)b_ * SEQ + n_ * 128; \
          pg0 = *(const v4u*)(TL + (row0_ + (tid >> 3)) * 1024 + 512 + blk_ * 64 + (tid & 7) * 8); pg1 = *(const v4u*)(TL + (row0_ + 64 + (tid >> 3)) * 1024 + 512 + blk_ * 64 + (tid & 7) * 8); } } while (0)
    int u = X.vcu;
    if (u < NU) LRU_ISSUE(u);
    for (; u < NU; u += X.G) {
        const int blk = u & 7, n = (u >> 3) & 63, b = u >> 9, ch0 = blk * 64; const size_t row0 = (size_t)b * SEQ + n * 128;
        { float f[8]; unpack8(px0, f); { const int c = tid, r = c >> 3, cc = (c & 7) * 8;
#pragma unroll
            for (int e = 0; e < 8; ++e) XS[r * 64 + cc + e] = f[e]; }
          unpack8(px1, f); { const int c = tid + 512, r = c >> 3, cc = (c & 7) * 8;
#pragma unroll
            for (int e = 0; e < 8; ++e) XS[r * 64 + cc + e] = f[e]; }
          if (tid + 1024 < 131 * 8) { unpack8(px2, f); const int c = tid + 1024, r = c >> 3, cc = (c & 7) * 8;
#pragma unroll
            for (int e = 0; e < 8; ++e) XS[r * 64 + cc + e] = f[e]; }
          if (PASS == 2) { *(v4u*)(GS + (tid >> 3) * 64 + (tid & 7) * 8) = pg0; *(v4u*)(GS + (64 + (tid >> 3)) * 64 + (tid & 7) * 8) = pg1; } }
        __syncthreads();
        { const int c = tid & 63, rg = tid >> 6; const float w0 = cw[ch0 + c], w1 = cw[512 + ch0 + c], w2 = cw[1024 + ch0 + c], w3 = cw[1536 + ch0 + c], bb = cbv[ch0 + c];
#pragma unroll 4
            for (int r = 0; r < 16; ++r) { const int t = rg * 16 + r; const float v = bb + w0 * XS[t * 64 + c] + w1 * XS[(t + 1) * 64 + c] + w2 * XS[(t + 2) * 64 + c] + w3 * XS[(t + 3) * 64 + c];
                XC[t * 64 + c] = v; XCB[t * 72 + c] = (bf16)f2bf(v); } }
        __syncthreads();
        if (u + X.G < NU) LRU_ISSUE(u + X.G);
        { const int tb = wave >> 1, cb = wave & 1; f32x16 R = {}, I = {};
#pragma unroll
            for (int ks = 0; ks < 4; ++ks) { const bf16x8 A = *(const bf16x8*)(XCB + (32 * tb + r32) * 72 + 16 * ks + 8 * hi);
                const bf16x8 Ba = *(const bf16x8*)(WaT + (size_t)(blk * 64 + 32 * cb + r32) * 64 + 16 * ks + 8 * hi), Bx = *(const bf16x8*)(WxT + (size_t)(blk * 64 + 32 * cb + r32) * 64 + 16 * ks + 8 * hi);
                R = __builtin_amdgcn_mfma_f32_32x32x16_bf16(A, Ba, R, 0, 0, 0); I = __builtin_amdgcn_mfma_f32_32x32x16_bf16(A, Bx, I, 0, 0, 0); }
            const int c = 32 * cb + r32; const float bav = ba[ch0 + c], bxv = bx[ch0 + c], sp = softplus_neg(lam[ch0 + c]);
#pragma unroll
            for (int r = 0; r < 16; ++r) { const int t = 32 * tb + (r & 3) + 8 * (r >> 2) + 4 * hi;
                const float rr = sigm(R[r] + bav), ii = sigm(I[r] + bxv), la = -8.0f * rr * sp, av = __builtin_amdgcn_exp2f(1.4426950408889634f * la), mult = __builtin_amdgcn_sqrtf(neg_expm1(2.0f * la));
                AA[t * 64 + c] = av; XC[t * 64 + c] = mult * ii * XC[t * 64 + c]; } }
        __syncthreads();
        { const int c = tid & 63, sg = tid >> 6; float Ap = 1.f, Hp = 0.f;
#pragma unroll 4
            for (int i = 0; i < 16; ++i) { const int t = sg * 16 + i; const float av = AA[t * 64 + c]; Hp = av * Hp + XC[t * 64 + c]; Ap *= av; }
            SEG[sg * 64 + c] = Ap; SEG[512 + sg * 64 + c] = Hp;
            __syncthreads();
            if (PASS == 1) { if (tid < 64) { float A2 = 1.f, H2 = 0.f;
#pragma unroll
                    for (int s = 0; s < 8; ++s) { const float sa = SEG[s * 64 + c]; H2 = sa * H2 + SEG[512 + s * 64 + c]; A2 *= sa; }
                    LSA[(size_t)(b * 64 + n) * 512 + ch0 + c] = A2; LSH[(size_t)(b * 64 + n) * 512 + ch0 + c] = H2; } }
            else { float hin = LC[(size_t)(b * 64 + n) * 512 + ch0 + c];
                for (int s = 0; s < sg; ++s) hin = SEG[s * 64 + c] * hin + SEG[512 + s * 64 + c];
#pragma unroll 4
                for (int i = 0; i < 16; ++i) { const int t = sg * 16 + i; hin = AA[t * 64 + c] * hin + XC[t * 64 + c];
                    const float g = bf2f(GS[t * 64 + c]);
                    YB[(row0 + t) * 1536 + ch0 + c] = (bf16)f2bf(hin * gelu_tanh(g)); } }
        }
        __syncthreads();
    }
#undef LRU_ISSUE
}
__device__ __forceinline__ void lru_prefix(const Ctx& X, const Args& a) {
    const float* LSA = (const float*)(wsptr(a) + WS_LSA); const float* LSH = (const float*)(wsptr(a) + WS_LSH); float* LC = (float*)(wsptr(a) + WS_LC);
    const int idx = X.vcu * 512 + X.tid;
    if (idx < NB * 512) { const int b = idx >> 9, ch = idx & 511; float h = 0.f;
        for (int n0 = 0; n0 < 64; n0 += 8) { float av[8], hv[8];
#pragma unroll
            for (int j = 0; j < 8; ++j) { av[j] = LSA[(size_t)(b * 64 + n0 + j) * 512 + ch]; hv[j] = LSH[(size_t)(b * 64 + n0 + j) * 512 + ch]; }
#pragma unroll
            for (int j = 0; j < 8; ++j) { LC[(size_t)(b * 64 + n0 + j) * 512 + ch] = h; h = av[j] * h + hv[j]; } } }
}

constexpr int RT_Q = 0, RT_K = 18432, RT_V = 36864, RT_S = 55296, RT_HALF = 64512, RT_P = 72;
template <int PASS>
__device__ __forceinline__ void ret_phase(const Ctx& X, unsigned char* ldsg, const Args& a) {
    const bf16* TR = (const bf16*)(wsptr(a) + WS_TR); bf16* YB = (bf16*)(wsptr(a) + WS_YB); float* RS = (float*)(wsptr(a) + WS_RS);
    const float* cr = (const float*)(wsptr(a) + WS_ROPE); const float* sr = cr + (size_t)M * 32;
    const int tid = X.tid, lane = X.lane, wave = X.wave, r32 = lane & 31, hi = lane >> 5, half = wave >> 2, w4 = wave & 3, t2 = tid & 255;
    bf16* Qs = (bf16*)(ldsg + half * RT_HALF + RT_Q); bf16* Ks = (bf16*)(ldsg + half * RT_HALF + RT_K); bf16* Vs = (bf16*)(ldsg + half * RT_HALF + RT_V); bf16* Ss = (bf16*)(ldsg + half * RT_HALF + RT_S);
    for (int u = X.vcu; u < NB * 64 * 4; u += X.G) {
        const int hp = u & 3, n = (u >> 2) & 63, b = u >> 8, h = 2 * hp + half; const size_t row0 = (size_t)b * SEQ + n * 128; const float lg = LG2G[h];
        for (int c = t2; c < 1024; c += 256) { const int r = c >> 3, cc = (c & 7) * 8; const size_t grow = row0 + r;
            const f32x4 cs = *(const f32x4*)(cr + grow * 32 + (cc >> 1)), sn = *(const f32x4*)(sr + grow * 32 + (cc >> 1));
            { const v4u w = *(const v4u*)(TR + grow * 2048 + 512 + h * 64 + cc); float f[8], o[8]; unpack8(w, f);
              const float kd = (PASS == 1) ? 0.125f * __builtin_amdgcn_exp2f((float)(127 - r) * lg) : 0.125f;
#pragma unroll
              for (int p = 0; p < 4; ++p) { o[2 * p] = (f[2 * p] * cs[p] - f[2 * p + 1] * sn[p]) * kd; o[2 * p + 1] = (f[2 * p] * sn[p] + f[2 * p + 1] * cs[p]) * kd; }
              *(v4u*)(Ks + r * RT_P + cc) = pack8f(o); }
            *(v4u*)(Vs + r * RT_P + cc) = *(const v4u*)(TR + grow * 2048 + 1024 + h * 64 + cc);
            if (PASS == 2) { const v4u w = *(const v4u*)(TR + grow * 2048 + h * 64 + cc); float f[8], o[8]; unpack8(w, f);
#pragma unroll
              for (int p = 0; p < 4; ++p) { o[2 * p] = f[2 * p] * cs[p] - f[2 * p + 1] * sn[p]; o[2 * p + 1] = f[2 * p] * sn[p] + f[2 * p + 1] * cs[p]; }
              *(v4u*)(Qs + r * RT_P + cc) = pack8f(o); } }
        if (PASS == 2) { const float* sp = RS + ((size_t)(b * 8 + h) * 64 + n) * 4096;
            for (int c = t2; c < 1024; c += 256) { const int d = c >> 4, e0 = (c & 15) * 4; const f32x4 v = *(const f32x4*)(sp + d * 64 + e0);
                Ss[(e0 + 0) * RT_P + d] = (bf16)f2bf(v.x); Ss[(e0 + 1) * RT_P + d] = (bf16)f2bf(v.y); Ss[(e0 + 2) * RT_P + d] = (bf16)f2bf(v.z); Ss[(e0 + 3) * RT_P + d] = (bf16)f2bf(v.w); } }
        __syncthreads();
        if (PASS == 1) {
            const int db = w4 >> 1, eb = w4 & 1; f32x16 acc = {};
#pragma unroll
            for (int ks = 0; ks < 8; ++ks) { bf16x8 A, B;
#pragma unroll
                for (int j = 0; j < 8; ++j) { A[j] = (short)Ks[(16 * ks + 8 * hi + j) * RT_P + 32 * db + r32]; B[j] = (short)Vs[(16 * ks + 8 * hi + j) * RT_P + 32 * eb + r32]; }
                acc = __builtin_amdgcn_mfma_f32_32x32x16_bf16(A, B, acc, 0, 0, 0); }
            float* dst = RS + ((size_t)(b * 8 + h) * 64 + n) * 4096;
#pragma unroll
            for (int r = 0; r < 16; ++r) dst[(32 * db + (r & 3) + 8 * (r >> 2) + 4 * hi) * 64 + 32 * eb + r32] = acc[r];
        } else {
            const int cb = w4; bf16x8 qf[4];
#pragma unroll
            for (int ks = 0; ks < 4; ++ks) qf[ks] = *(const bf16x8*)(Qs + (32 * cb + r32) * RT_P + 16 * ks + 8 * hi);
            f32x16 yin[2] = {}, ycr[2] = {};
            for (int sb = 0; sb <= cb; ++sb) { f32x16 st = {};
#pragma unroll
                for (int ks = 0; ks < 4; ++ks) { const bf16x8 A = *(const bf16x8*)(Ks + (32 * sb + r32) * RT_P + 16 * ks + 8 * hi); st = __builtin_amdgcn_mfma_f32_32x32x16_bf16(A, qf[ks], st, 0, 0, 0); }
#pragma unroll
                for (int r = 0; r < 16; ++r) { const int d = (32 * cb + r32) - (32 * sb + (r & 3) + 8 * (r >> 2) + 4 * hi); st[r] = d >= 0 ? st[r] * __builtin_amdgcn_exp2f((float)d * lg) : 0.f; }
#pragma unroll
                for (int t = 0; t < 2; ++t) { v4u pw; pw.x = pk2(st[8 * t], st[8 * t + 1]); pw.y = pk2(st[8 * t + 2], st[8 * t + 3]); pw.z = pk2(st[8 * t + 4], st[8 * t + 5]); pw.w = pk2(st[8 * t + 6], st[8 * t + 7]);
                    const bf16x8 Bf = __builtin_bit_cast(bf16x8, pw);
#pragma unroll
                    for (int eb = 0; eb < 2; ++eb) { bf16x8 A;
#pragma unroll
                        for (int j = 0; j < 8; ++j) A[j] = (short)Vs[(32 * sb + 16 * t + 8 * (j >> 2) + 4 * hi + (j & 3)) * RT_P + 32 * eb + r32];
                        yin[eb] = __builtin_amdgcn_mfma_f32_32x32x16_bf16(A, Bf, yin[eb], 0, 0, 0); } } }
#pragma unroll
            for (int eb = 0; eb < 2; ++eb)
#pragma unroll
                for (int ks = 0; ks < 4; ++ks) { const bf16x8 A = *(const bf16x8*)(Ss + (32 * eb + r32) * RT_P + 16 * ks + 8 * hi); ycr[eb] = __builtin_amdgcn_mfma_f32_32x32x16_bf16(A, qf[ks], ycr[eb], 0, 0, 0); }
            const float qd = __builtin_amdgcn_exp2f((float)(32 * cb + r32 + 1) * lg);
            float s = 0.f;
#pragma unroll
            for (int eb = 0; eb < 2; ++eb)
#pragma unroll
                for (int r = 0; r < 16; ++r) { yin[eb][r] += qd * ycr[eb][r]; s += yin[eb][r]; }
            s = half_sum(s); const float mu = s * (1.0f / 64.0f); float q = 0.f;
#pragma unroll
            for (int eb = 0; eb < 2; ++eb)
#pragma unroll
                for (int r = 0; r < 16; ++r) { const float dlt = yin[eb][r] - mu; yin[eb][r] = dlt; q += dlt * dlt; }
            q = half_sum(q); const float rstd = __builtin_amdgcn_rsqf(q * (1.0f / 64.0f) + EPS);
            const size_t grow = row0 + 32 * cb + r32;
#pragma unroll
            for (int eb = 0; eb < 2; ++eb)
#pragma unroll
                for (int qd4 = 0; qd4 < 4; ++qd4) { const int e0 = 32 * eb + 8 * qd4 + 4 * hi;
                    const u32x2 gw = *(const u32x2*)(TR + grow * 2048 + 1536 + h * 64 + e0);
                    const float g0 = __uint_as_float(gw.x << 16), g1 = __uint_as_float(gw.x & 0xffff0000u), g2 = __uint_as_float(gw.y << 16), g3 = __uint_as_float(gw.y & 0xffff0000u);
                    u32x2 ow; ow.x = pk2(g0 * sigm(g0) * yin[eb][4 * qd4] * rstd, g1 * sigm(g1) * yin[eb][4 * qd4 + 1] * rstd); ow.y = pk2(g2 * sigm(g2) * yin[eb][4 * qd4 + 2] * rstd, g3 * sigm(g3) * yin[eb][4 * qd4 + 3] * rstd);
                    *(u32x2*)(YB + grow * 1536 + 512 + h * 64 + e0) = ow; }
        }
        __syncthreads();
    }
}
__device__ __forceinline__ void ret_prefix(const Ctx& X, const Args& a) {
    float* RS = (float*)(wsptr(a) + WS_RS);
    const int nth = X.G * 512;
    for (int idx = X.vcu * 512 + X.tid; idx < NB * 8 * 4096; idx += nth) { const int bh = idx >> 12, off = idx & 4095, h = bh & 7;
        const float cd = __builtin_amdgcn_exp2f(128.0f * LG2G[h]); float* base = RS + (size_t)bh * 64 * 4096 + off; float st = 0.f;
        for (int n0 = 0; n0 < 64; n0 += 8) { float t[8];
#pragma unroll
            for (int j = 0; j < 8; ++j) t[j] = base[(size_t)(n0 + j) * 4096];
#pragma unroll
            for (int j = 0; j < 8; ++j) { base[(size_t)(n0 + j) * 4096] = st; st = st * cd + t[j]; } } }
}


constexpr int PH_PER_LAYER = 12, NPH = 2 + PH_PER_LAYER * DEPTH;
constexpr int BIGT = 1 << 30;

__global__ void __launch_bounds__(NWAVES * 64, 2) mk_fwd(Args args) {
    unsigned char* lds = g_lds;
    LAS unsigned char* L3 = (LAS unsigned char*)lds;
    const int wave0 = __builtin_amdgcn_readfirstlane((int)threadIdx.x >> 6);
    const int lo = args.ph_lo, hi = args.ph_hi;
    for (int u = threadIdx.x; u < (LDS_BYTES - 131072) / 4; u += NWAVES * 64) ((LAS unsigned*)(L3 + 131072))[u] = 0u;
    __syncthreads();
    if (threadIdx.x < 31) ((LAS unsigned long long*)(L3 + ARGS_LDS_OFF))[threadIdx.x] = ((const unsigned long long*)&args)[threadIdx.x];
    __syncthreads();
    if (hi - lo > 1) (void)xcd_barrier_post((unsigned*)(wsptr(args) + WS_CTL) + 1024, (volatile LAS unsigned*)(L3 + MISC_OFF) + 8);
#ifndef PHMASK
#define PHMASK 0xFFFFFFFFu
#endif
#define PHON(j) ((PHMASK >> (2 + (j))) & 1u)
#define CTX Ctx X; int bx; LAS unsigned char* L3p; unsigned char* ldsp; \
        { int ln_; asm volatile("v_mbcnt_lo_u32_b32 %0, -1, 0\n\tv_mbcnt_hi_u32_b32 %0, -1, %0" : "=v"(ln_)); \
          const int w_ = opaque_u(wave0), g_ = opaque_u((int)gridDim.x), b_ = opaque_u((int)blockIdx.x), lz_ = opaque_u(0); \
          X.tid = w_ * 64 + ln_; X.lane = ln_; X.wave = w_; X.G = g_; bx = b_; X.vcu = (g_ % 8 == 0) ? (b_ % 8) * (g_ / 8) + b_ / 8 : b_; L3p = L3 + lz_; ldsp = lds + lz_; } \
        unsigned char* ws = wsptr(args); (void)bx; (void)L3p; (void)ldsp; (void)ws;
#define WPTR(off) ((const bf16*)(ws + WS_W + (off)))
#pragma unroll 1
    for (int ph = lo, rep = 0; ph < hi; ++ph) {
        const int l = ph < 2 ? 0 : (ph - 2) / PH_PER_LAYER, j = ph < 2 ? ph - 2 : (ph - 2) - l * PH_PER_LAYER;
#ifdef AMP_MASK
        const unsigned long long amp_t0 = __builtin_amdgcn_s_memrealtime();
#endif

#ifndef REPMASK
#define REPMASK 0u
#endif
        if (j == -2 && PHON(-2)) { CTX p_mods(X, L3p, args); __syncthreads(); p_rope(X, args); convert_mixer(X, L3p, args, 0); }
        else if (j == -1 && PHON(-1)) { CTX const float* MOD = (const float*)(ws + WS_MOD);
            row_pass<0, true>(X, (const float*)inptr(args, I_X), nullptr, nullptr, nullptr, nullptr, (const float*)inptr(args, I_MIXPRE), MOD, MOD + 1024, (bf16*)(ws + WS_XN)); }
        else if (j == 0 && PHON(0)) { CTX
            pg8::Gemm g{(const bf16*)(ws + WS_XN), WPTR(WO_IN), M, 3840, 1024, 1024}; pg8::StaticOrder S; S.init(M, 3840, X.G, bx);
            typedef pg8::EpiRoute<0, WS_TL, 1024, 4, WS_TR, 2048, 12, WS_TM, 768> E_t; E_t E{&args};
            pg8::gemm_phase<E_t, pg8::StaticOrder, true, true>(L3p, g, S, E, X.tid);
        }
        else if (j == 1 && PHON(1)) { CTX lru_phase<1>(X, ldsp, args, l); __syncthreads(); ret_phase<1>(X, ldsp, args); p_mla_rstd(X, args); }
        else if (j == 2 && PHON(2)) { CTX lru_prefix(X, args); ret_prefix(X, args); }
        else if (j == 3 && PHON(3)) { CTX lru_phase<2>(X, ldsp, args, l); __syncthreads(); ret_phase<2>(X, ldsp, args); }
        else if (j == 4 && PHON(4)) {
            { CTX p_krope(X, args); }
            { CTX pg8::Gemm g{(const bf16*)(ws + WS_TM), WPTR(WO_UQ), M, 768, 384, 768}; pg8::StaticOrder S; S.init(M, 768, X.G, bx);
              pg8::EpiQ E{&args}; pg8::gemm_phase<pg8::EpiQ, pg8::StaticOrder, true, true>(L3p, g, S, E, X.tid); }
            { CTX pg8::Gemm g{(const bf16*)(ws + WS_TM) + 384, WPTR(WO_UKV), M, 1024, 256, 768}; pg8::StaticOrder S; S.init(M, 1024, X.G, bx);
              pg8::EpiKV E{&args}; pg8::gemm_phase<pg8::EpiKV, pg8::StaticOrder, true, true>(L3p, g, S, E, X.tid); }
        }
        else if (j == 5 && PHON(5)) { CTX
            const bf16* Qb = (const bf16*)(ws + WS_Q); const bf16* Kb = (const bf16*)(ws + WS_K); const bf16* Vb = (const bf16*)(ws + WS_V); bf16* YB = (bf16*)(ws + WS_YB);
            att::Seam S;
            for (int L = X.vcu; L < 256; L += X.G) {
                const int bh = L >> 4, xq = L & 15, b = bh >> 3, h = bh & 7, qb0 = xq, qb1 = 31 - xq;
                const bf16* Kh = Kb + (size_t)b * SEQ * 768 + h * 96; const bf16* Vh = Vb + (size_t)b * SEQ * 512 + h * 64;
                att::BlockRef r0{Qb + ((size_t)b * SEQ + qb0 * 256) * 768 + h * 96, Kh, Vh, YB + ((size_t)b * SEQ + qb0 * 256) * 1536 + 1024 + h * 64, qb0 * 256};
                att::BlockRef r1{Qb + ((size_t)b * SEQ + qb1 * 256) * 768 + h * 96, Kh, Vh, YB + ((size_t)b * SEQ + qb1 * 256) * 1536 + 1024 + h * 64, qb1 * 256};
                att::attn_prime(r0, (char*)ldsp, S, X.tid);
                att::attn_block(r0, r1, (char*)ldsp, S, X.tid);
                att::attn_block(r1, r1, (char*)ldsp, S, X.tid);
                asm volatile("s_waitcnt vmcnt(0)" ::: "memory"); __syncthreads();
            }
        }
        else if (j == 6 && PHON(6)) {
            { CTX pg8::Gemm g{(const bf16*)(ws + WS_XN), WPTR(WO_G), M, 3072, 1024, 1024}; pg8::GateOrder S; S.init(M, X.G, bx);
              typedef pg8::EpiRoute<2, WS_G, 3072, BIGT, 0, 0, BIGT, 0, 0> E_t; E_t E{&args};
              pg8::gemm_phase<E_t, pg8::GateOrder, true, true>(L3p, g, S, E, X.tid);
              asm volatile("s_waitcnt vmcnt(0)" ::: "memory"); __syncthreads();
              __builtin_amdgcn_fence(__ATOMIC_ACQUIRE, "agent"); asm volatile("s_waitcnt vmcnt(0)" ::: "memory"); }
            { CTX pg8::Gemm g{(const bf16*)(ws + WS_YB), WPTR(WO_O3), M, 3072, 512, 1536}; pg8::MergeOrder S; S.init(M, X.G, bx);
              pg8::EpiMerge E{&args}; pg8::gemm_phase<pg8::EpiMerge, pg8::MergeOrder, true, true>(L3p, g, S, E, X.tid); }
        }
        else if (j == 7 && PHON(7)) { CTX
            pg8::Gemm g{(const bf16*)(ws + WS_XN), WPTR(WO_OUT), M, 1024, 1024, 1024}; pg8::StaticOrder S; S.init(M, 1024, X.G, bx);
            typedef pg8::EpiRoute<0, WS_Y, 1024, BIGT, 0, 0, BIGT, 0, 0> E_t; E_t E{&args}; pg8::gemm_phase<E_t, pg8::StaticOrder, true, true>(L3p, g, S, E, X.tid);
        }
        else if (j == 8 && PHON(8)) { CTX float* out = outptr(args); const float* MODl = (const float*)(ws + WS_MOD) + (size_t)l * NB * 6144;
            row_pass<1, true, true>(X, l == 0 ? (const float*)inptr(args, I_X) : (const float*)out, out, (const bf16*)(ws + WS_Y), (const float*)inptr(args, I_MIXPOST) + l * 1024, MODl + 2048,
                              (const float*)inptr(args, I_FPRE) + l * 1024, MODl + 3072, MODl + 4096, (bf16*)(ws + WS_XN));
            convert_ffn(X, L3p, args, l);
#ifdef REP_CONV
            convert_ffn(X, L3p, args, l);
#endif
        }
        else if (j == 9 && PHON(9)) { CTX
            pg8::Gemm g{(const bf16*)(ws + WS_XN), WPTR(WO_UP), M + 1024, 5632, 1024, 1024}; pg8::StaticOrder S; S.init(M + 1024, 5632, X.G, bx);
            pg8::EpiGlu E{&args, l}; pg8::gemm_phase<pg8::EpiGlu, pg8::StaticOrder, true, true>(L3p, g, S, E, X.tid);
        }
        else if (j == 10 && PHON(10)) { CTX
            pg8::Gemm g{(const bf16*)(ws + WS_ACT), WPTR(WO_DOWN), M, 1024, 2816, 2816}; pg8::StaticOrder S; S.init(M, 1024, X.G, bx);
            typedef pg8::EpiRoute<0, WS_Y2, 1024, BIGT, 0, 0, BIGT, 0, 0> E_t; E_t E{&args}; pg8::gemm_phase<E_t, pg8::StaticOrder, true, true>(L3p, g, S, E, X.tid);
        }
        else if (j == 11 && PHON(11)) { CTX float* out = outptr(args); const float* MOD = (const float*)(ws + WS_MOD); const float* MODl = MOD + (size_t)l * NB * 6144;
            if (l + 1 < DEPTH) {
                const float* MODn = MOD + (size_t)(l + 1) * NB * 6144;
                row_pass<1, true>(X, (const float*)out, out, (const bf16*)(ws + WS_Y2), (const float*)inptr(args, I_FPOST) + l * 1024, MODl + 5120,
                                  (const float*)inptr(args, I_MIXPRE) + (l + 1) * 1024, MODn, MODn + 1024, (bf16*)(ws + WS_XN));
                convert_mixer(X, L3p, args, l + 1);
#ifdef REP_CONV
                convert_mixer(X, L3p, args, l + 1);
#endif
            } else {
                row_pass<1, false>(X, (const float*)out, out, (const bf16*)(ws + WS_Y2), (const float*)inptr(args, I_FPOST) + l * 1024, MODl + 5120, nullptr, nullptr, nullptr, nullptr);
            }
        }
        if (REPMASK != 0u) { const int nrep = ((REPMASK >> (j + 2)) & 1u) ? 2 : 1; if (++rep < nrep) { --ph; continue; } rep = 0; }
        if (ph + 1 < hi) {
            if (ph == lo) { cg::this_grid().sync(); }
            else { unsigned char* ws = wsptr(args); const int lz_ = opaque_u(0); XcdBarrier bar; bar.bar = (unsigned*)(ws + WS_CTL) + 1024; bar.x = xb_xcc_id(); bar.st = (volatile LAS unsigned*)(L3 + lz_ + MISC_OFF) + 8; xcd_barrier(bar);
#ifdef REP_BAR
                   xcd_barrier(bar);
#endif
            }
        }
#ifdef AMP_MASK
        if ((AMP_MASK >> (j + 2)) & 1u) {
            const unsigned long long t1 = __builtin_amdgcn_s_memrealtime(), target = t1 + (unsigned long long)(AMP_N - 1) * (t1 - amp_t0);
            while (__builtin_amdgcn_s_memrealtime() < target) __builtin_amdgcn_s_sleep(8);
        }
#endif
    }
#undef PHON
#undef WPTR
#undef CTX
}


#ifdef DBG_K
__global__ void dbg_dump(const unsigned char* ws, float* out) {
    const bf16* buf = (const bf16*)(ws + (size_t)DBG_OFF);
    for (size_t i = (size_t)blockIdx.x * blockDim.x + threadIdx.x; i < (size_t)M * 1024; i += (size_t)gridDim.x * blockDim.x) {
        const size_t r = i >> 10; const int c = (int)(i & 1023);
        out[i] = c < DBG_NC ? __uint_as_float((unsigned)buf[r * DBG_LD + DBG_COL0 + c] << 16) : 0.f; }
}
#endif
extern "C" void kernel_launch(void* const* d_in, const int* in_sizes, int n_in, void* d_out, int out_size, void* d_ws, size_t ws_size, hipStream_t stream) {
    static int grid = 0;
    if (grid == 0) {
        if (n_in != 29 || in_sizes[0] != M * DM || out_size != M * DM || ws_size < WS_END) { fprintf(stderr, "kernel_launch: unexpected shapes (n_in %d, in0 %d, out %d, ws %zu)\n", n_in, n_in > 0 ? in_sizes[0] : -1, out_size, ws_size); grid = -1; return; }
        int dev = 0, cus = 0, per_cu = 0;
        if (hipGetDevice(&dev) != hipSuccess || hipDeviceGetAttribute(&cus, hipDeviceAttributeMultiprocessorCount, dev) != hipSuccess) { grid = -1; return; }
        if (hipFuncSetAttribute((const void*)mk_fwd, hipFuncAttributeMaxDynamicSharedMemorySize, LDS_BYTES) != hipSuccess) { fprintf(stderr, "kernel_launch: hipFuncSetAttribute failed\n"); grid = -1; return; }
        if (hipOccupancyMaxActiveBlocksPerMultiprocessor(&per_cu, (const void*)mk_fwd, NWAVES * 64, LDS_BYTES) != hipSuccess || per_cu < 1) { fprintf(stderr, "kernel_launch: occupancy query says %d blocks per CU\n", per_cu); per_cu = 1; }
        (void)hipGetLastError();
        grid = cus;
    }
    if (grid < 0) return;
    (void)hipMemsetAsync((char*)d_ws + WS_CTL, 0, CTL_ZERO_BYTES, stream);
    Args a{};
    for (int i = 0; i < 29; ++i) a.in[i] = d_in[i];
    a.out = (float*)d_out; a.ws = (unsigned char*)d_ws;
#if MK_ONE_LAUNCH
    a.ph_lo = 0; a.ph_hi = NPH;
    void* params[] = {&a};
    hipError_t e = hipLaunchCooperativeKernel((const void*)mk_fwd, dim3(grid), dim3(NWAVES * 64), params, LDS_BYTES, stream);
    if (e != hipSuccess) fprintf(stderr, "kernel_launch: cooperative launch failed: %s (grid %d)\n", hipGetErrorString(e), grid);
#else
#ifdef DBG_K
    for (int k = 0; k < DBG_K; ++k) { a.ph_lo = k; a.ph_hi = k + 1; hipLaunchKernelGGL(mk_fwd, dim3(grid), dim3(NWAVES * 64), LDS_BYTES, stream, a); }
    hipLaunchKernelGGL(dbg_dump, dim3(2048), dim3(256), 0, stream, (const unsigned char*)d_ws, (float*)d_out);
#else
    for (int k = 0; k < NPH; ++k) { a.ph_lo = k; a.ph_hi = k + 1; hipLaunchKernelGGL(mk_fwd, dim3(grid), dim3(NWAVES * 64), LDS_BYTES, stream, a); }
#endif
#endif
}
```

```cpp
#include <hip/hip_runtime.h>
#include <hip/hip_bf16.h>
#include <hip/hip_cooperative_groups.h>
#include <cstdio>
#include <cstdint>
namespace cg = cooperative_groups;

#ifndef MK_ONE_LAUNCH
#define MK_ONE_LAUNCH 1
#endif

constexpr int DM = 1024, NB = 2, SEQ = 8192, M = NB * SEQ, DEPTH = 2;
constexpr int LRU_W = 512, RET_H = 8, MLA_H = 8, QRANK = 384, KVRANK = 256, DFF = 2816;
constexpr int NIN = 6816;
constexpr float EPS = 1e-6f;

constexpr size_t MiB = 1u << 20;
constexpr size_t WS_CTL = 0, CTL_ZERO_BYTES = 64 * 1024;
constexpr size_t WS_MOD = 1 * MiB;
constexpr size_t WS_RSTD = WS_MOD + 128 * 1024;
constexpr size_t WS_LSA = WS_RSTD + 128 * 1024;
constexpr size_t WS_LSH = WS_LSA + 256 * 1024;
constexpr size_t WS_LC = WS_LSH + 256 * 1024;
constexpr size_t WS_ROPE = 3 * MiB;
constexpr size_t WS_W = 10 * MiB;
constexpr size_t WS_XN = 30 * MiB;
constexpr size_t WS_YB = 62 * MiB;
constexpr size_t WS_RS = 110 * MiB;
constexpr size_t WS_BIG = 126 * MiB;
constexpr size_t WS_TL = WS_BIG, WS_TR = WS_BIG + 32 * MiB, WS_TM = WS_BIG + 96 * MiB;
constexpr size_t WS_Q = WS_BIG, WS_K = WS_BIG + 24 * MiB, WS_V = WS_BIG + 48 * MiB;
constexpr size_t WS_G = WS_BIG, WS_Y = WS_BIG;
constexpr size_t WS_XNH = WS_XN + 32 * MiB;
constexpr size_t WS_ACT = 150 * MiB, WS_Y2 = 64 * MiB;
constexpr size_t WS_END = 256 * MiB;
constexpr size_t WO_IN = 0, WO_G = WO_IN + (size_t)3840 * 1024 * 2, WO_OUT = WO_G + (size_t)3072 * 1024 * 2, WO_O3 = WO_OUT + (size_t)1024 * 1024 * 2,
                 WO_UQ = WO_O3 + (size_t)3 * 1024 * 512 * 2, WO_UKV = WO_UQ + (size_t)768 * 384 * 2, WO_AT = WO_UKV + (size_t)1024 * 256 * 2, WO_XT = WO_AT + 65536, WO_MIX_END = WO_XT + 65536;
constexpr size_t WO_UP = 0, WO_DOWN = (size_t)5632 * 1024 * 2, WO_FFN_END = WO_DOWN + (size_t)1024 * 2816 * 2;
static_assert(WO_MIX_END <= 20 * MiB && WO_FFN_END <= 20 * MiB, "weight region");
static_assert(WS_ACT + (size_t)M * DFF * 2 <= WS_END && WS_XNH + 2 * MiB <= WS_Y2 && WS_Y2 + 32 * MiB <= WS_ACT, "ffn map");

constexpr int LDS_BYTES = 147456;
constexpr int MISC_OFF = 131072 + 320;
constexpr int NWAVES = 8;

typedef float f32x16 __attribute__((ext_vector_type(16)));
typedef unsigned u32x2 __attribute__((ext_vector_type(2)));
typedef float f32x2 __attribute__((ext_vector_type(2)));

__device__ const double INVR[32] = {1.0, 0.7498942093324559, 0.5623413251903491, 0.4216965034285822, 0.31622776601683794, 0.23713737056616552, 0.1778279410038923, 0.1333521432163324, 0.1, 0.07498942093324558, 0.05623413251903491, 0.042169650342858224, 0.03162277660168379, 0.023713737056616554, 0.01778279410038923, 0.01333521432163324, 0.01, 0.007498942093324558, 0.005623413251903491, 0.004216965034285823, 0.0031622776601683794, 0.0023713737056616554, 0.0017782794100389228, 0.001333521432163324, 0.001, 0.0007498942093324559, 0.0005623413251903491, 0.00042169650342858224, 0.00031622776601683794, 0.00023713737056616554, 0.00017782794100389227, 0.0001333521432163324};
__device__ const float LG2G[8] = {-0.04580368961312479f, -0.02272007650008353f, -0.011315313227834146f, -0.005646563141142063f, -0.0028205190623786626f, -0.0014095702546713536f, -0.0007046129765893727f, -0.0003522634716290214f};

struct Ctx { int tid, lane, wave, G, vcu; };
struct Args { const void* in[29]; float* out; unsigned char* ws; int ph_lo, ph_hi; };
enum { I_X = 0, I_C, I_POS, I_ADAW, I_ADAB, I_MIXPRE, I_MIXPOST, I_WIN, I_LCW, I_LCB, I_LWA, I_LBA, I_LWX, I_LBX, I_LLAM, I_LWO, I_RWO, I_QNG, I_WUQ, I_KVNG, I_WUKV, I_MWO, I_WOUT,
       I_FPRE, I_FPOST, I_WUP, I_FCW, I_FCB, I_WDOWN };


#define GAS __attribute__((address_space(1)))
#define LAS __attribute__((address_space(3)))
extern __shared__ __attribute__((aligned(16))) unsigned char g_lds[];
constexpr int ARGS_LDS_OFF = 131072 + 1024;
__device__ __forceinline__ int opaque_u(int v) { int t; asm volatile("v_mov_b32 %0, %1" : "=v"(t) : "s"(v)); return __builtin_amdgcn_readfirstlane(t); }
__device__ __forceinline__ unsigned long long lds_arg(int idx) {
    const int z = opaque_u(0);
    volatile LAS unsigned* p = (volatile LAS unsigned*)((LAS unsigned char*)g_lds + z + ARGS_LDS_OFF) + 2 * idx;
    const unsigned lo = p[0], hi = p[1];
    return ((unsigned long long)(unsigned)__builtin_amdgcn_readfirstlane((int)hi) << 32) | (unsigned)__builtin_amdgcn_readfirstlane((int)lo);
}
__device__ __forceinline__ const void* inptr(const Args&, int i) { return (const void*)(GAS const void*)lds_arg(i); }
__device__ __forceinline__ unsigned char* wsptr(const Args&) { return (unsigned char*)(GAS unsigned char*)lds_arg(30); }
__device__ __forceinline__ float* outptr(const Args&) { return (float*)(GAS float*)lds_arg(29); }

namespace pg8 {
#define PG8_LAS __attribute__((address_space(3)))
typedef unsigned short bf16_t;
typedef short bf16x8 __attribute__((ext_vector_type(8)));
typedef float f32x4 __attribute__((ext_vector_type(4)));
typedef unsigned u32x4 __attribute__((ext_vector_type(4)));
typedef unsigned u32x2 __attribute__((ext_vector_type(2)));
constexpr int BM = 256, BK = 64, HALF = 128, HTB = HALF * BK * 2, STAGE_BYTES = 8 * HTB, NXCD = 8, WGM = 8;

__host__ __device__ __forceinline__ int lds_byte(int r, int c) { const int st = (r >> 4) * 2 + (c >> 5), rr = r & 15, cc = c & 31, ob = rr * 64 + cc * 2; return st * 1024 + (ob ^ (((ob >> 9) & 1) << 5)); }
__host__ __device__ __forceinline__ void stage_rc(int b, int& R, int& C) { const int st = b / 1024, sb = b % 1024, swz = sb ^ (((sb >> 9) & 1) << 5); R = (st >> 1) * 16 + swz / 64; C = (st & 1) * 32 + (swz % 64) / 2; }
__host__ __device__ __forceinline__ int perm32(int rho) { const int n = rho >> 4, i = rho & 15; return 8 * (i >> 2) + 4 * n + (i & 3); }

struct Unit { int pm, pn, ao; };
struct Gemm { const bf16_t* A; const bf16_t* Bt; int M, N, K, lda; };

struct StaticOrder {
    int nM, nN, nwg, G, c;
    __host__ __device__ void init(int M_, int N_, int G_, int c_) { nM = M_ / BM; nN = N_ / BM; nwg = nM * nN; G = G_; c = c_; }
    __host__ __device__ bool next(int i, Unit& u) const {
        const long L = (long)i * G + c; if (L >= nwg) return false;
        int wgid = (int)L; { const int q = nwg / NXCD, r = nwg % NXCD, xcd = wgid % NXCD, off = wgid / NXCD; wgid = (xcd < r ? xcd * (q + 1) : r * (q + 1) + (xcd - r) * q) + off; }
        const int nig = WGM * nN, gid = wgid / nig, fm = gid * WGM, gsz = (nM - fm) < WGM ? (nM - fm) : WGM;
        u.pm = fm + ((wgid % nig) % gsz); u.pn = (wgid % nig) / gsz; u.ao = 0; return true;
    }
    __device__ __forceinline__ void a_ready(const Unit&) const {}
    __device__ __forceinline__ void done(const Unit&) const {}
};


struct GateOrder {
    StaticOrder base;
    __host__ __device__ void init(int M_, int G_, int c_) { base.init(M_, 1024, G_, c_); }
    __host__ __device__ bool next(int i, Unit& u) const { if (i >= 3) return false; Unit t; if (!base.next(0, t)) return false; u.pm = t.pm; u.pn = t.pn + 4 * i; u.ao = 0; return true; }
    __device__ __forceinline__ void a_ready(const Unit&) const {}
    __device__ __forceinline__ void done(const Unit&) const {}
};
struct MergeOrder {
    StaticOrder base;
    __host__ __device__ void init(int M_, int G_, int c_) { base.init(M_, 1024, G_, c_); }
    __host__ __device__ bool next(int i, Unit& u) const { if (i >= 3) return false; Unit t; if (!base.next(0, t)) return false; u.pm = t.pm; u.pn = t.pn + 4 * i; u.ao = i * 1024; return true; }
    __device__ __forceinline__ void a_ready(const Unit&) const {}
    __device__ __forceinline__ void done(const Unit&) const {}
};
typedef float f32x2_t __attribute__((ext_vector_type(2))); typedef __bf16 bf16x2_t __attribute__((ext_vector_type(2)));
__device__ __forceinline__ unsigned cvt_pk_bf16(float lo, float hi) { f32x2_t v = {lo, hi}; bf16x2_t b = __builtin_convertvector(v, bf16x2_t); return __builtin_bit_cast(unsigned, b); }
__device__ __forceinline__ float bf_lo(unsigned w) { return __uint_as_float(w << 16); }
__device__ __forceinline__ float bf_hi(unsigned w) { return __uint_as_float(w & 0xffff0000u); }
__device__ __forceinline__ float sigmoidf_(float x) { return __builtin_amdgcn_rcpf(1.0f + __builtin_amdgcn_exp2f(-1.4426950408889634f * x)); }


template <int ACT, size_t O0, int LD0, int T1, size_t O1, int LD1, int T2, size_t O2, int LD2> struct EpiRoute {
    static constexpr bool PERM = true, AFTER_DRAIN = false;
    const Args* a;
    __device__ __forceinline__ void operator()(const f32x4 (&acc)[2][2][4][2], const Unit& u, int wr, int wc, int fr_, int fq_) const {
        (void)fr_; (void)fq_; int ln_; asm volatile("v_mbcnt_lo_u32_b32 %0, -1, 0\n\tv_mbcnt_hi_u32_b32 %0, -1, %0" : "=v"(ln_)); const int fr = ln_ & 15, fq = ln_ >> 4;
        unsigned char* ws = wsptr(*a);
        bf16_t* base; int ld, ct;
        if (u.pn < T1) { base = (bf16_t*)(ws + O0); ld = LD0; ct = u.pn; } else if (u.pn < T2) { base = (bf16_t*)(ws + O1); ld = LD1; ct = u.pn - T1; } else { base = (bf16_t*)(ws + O2); ld = LD2; ct = u.pn - T2; }
        int row0 = u.pm * BM + wr * 64 + fr, col0 = ct * BM + wc * 32 + 8 * fq; asm volatile("" : "+v"(row0), "+v"(col0));
#pragma unroll
        for (int ai = 0; ai < 2; ++ai)
#pragma unroll
            for (int m = 0; m < 4; ++m) { bf16_t* rowp = base + (size_t)(row0 + ai * HALF + m * 16) * ld + col0;
#pragma unroll
                for (int bj = 0; bj < 2; ++bj) { f32x4 v0 = acc[ai][bj][m][0], v1 = acc[ai][bj][m][1];
                    if (ACT == 2) {
#pragma unroll
                        for (int e = 0; e < 4; ++e) { v0[e] = sigmoidf_(v0[e]); v1[e] = sigmoidf_(v1[e]); } }
                    u32x4 w; w.x = cvt_pk_bf16(v0[0], v0[1]); w.y = cvt_pk_bf16(v0[2], v0[3]); w.z = cvt_pk_bf16(v1[0], v1[1]); w.w = cvt_pk_bf16(v1[2], v1[3]);
                    *(u32x4*)(rowp + bj * HALF) = w; } }
    }
};
struct EpiQ {
    static constexpr bool PERM = true, AFTER_DRAIN = false;
    const Args* a;
    __device__ __forceinline__ void operator()(const f32x4 (&acc)[2][2][4][2], const Unit& u, int wr, int wc, int fr_, int fq_) const {
        (void)fr_; (void)fq_; int ln_; asm volatile("v_mbcnt_lo_u32_b32 %0, -1, 0\n\tv_mbcnt_hi_u32_b32 %0, -1, %0" : "=v"(ln_)); const int fr = ln_ & 15, fq = ln_ >> 4;
        unsigned char* ws = wsptr(*a);
        const char* Qc = (const char*)(ws + WS_Q); const char* rstd = (const char*)(ws + WS_RSTD); const char* cosm = (const char*)(ws + WS_ROPE) + (size_t)M * 64 * 4; const char* sinm = cosm + (size_t)M * 16 * 4;
        int row0 = u.pm * BM + wr * 64 + fr, fq4 = fq; asm volatile("" : "+v"(row0), "+v"(fq4));
        const int g32 = u.pn * 8 + wc;
#pragma unroll
        for (int ai = 0; ai < 2; ++ai)
#pragma unroll
            for (int m = 0; m < 4; ++m) { const unsigned row = (unsigned)(row0 + ai * HALF + m * 16); const float rs = *(const float*)(rstd + row * 4u);
#pragma unroll
                for (int bj = 0; bj < 2; ++bj) { const int g = g32 + 4 * bj;
                    f32x4 v0 = acc[ai][bj][m][0] * rs, v1 = acc[ai][bj][m][1] * rs;
                    if ((g % 3) == 2) { const f32x4 cs = *(const f32x4*)(cosm + row * 64u + (unsigned)fq4 * 16u), sn = *(const f32x4*)(sinm + row * 64u + (unsigned)fq4 * 16u);
                        f32x4 p, b; p[0] = v0[0] * cs[0] - v0[1] * sn[0]; p[1] = v0[0] * sn[0] + v0[1] * cs[0]; p[2] = v0[2] * cs[1] - v0[3] * sn[1]; p[3] = v0[2] * sn[1] + v0[3] * cs[1];
                        b[0] = v1[0] * cs[2] - v1[1] * sn[2]; b[1] = v1[0] * sn[2] + v1[1] * cs[2]; b[2] = v1[2] * cs[3] - v1[3] * sn[3]; b[3] = v1[2] * sn[3] + v1[3] * cs[3]; v0 = p; v1 = b; }
                    u32x4 w; w.x = cvt_pk_bf16(v0[0], v0[1]); w.y = cvt_pk_bf16(v0[2], v0[3]); w.z = cvt_pk_bf16(v1[0], v1[1]); w.w = cvt_pk_bf16(v1[2], v1[3]);
                    *(u32x4*)(Qc + row * 1536u + (unsigned)(g * 64 + fq4 * 16)) = w; }
                asm volatile("" ::: "memory"); }
    }
};
struct EpiKV {
    static constexpr bool PERM = true, AFTER_DRAIN = false;
    const Args* a;
    __device__ __forceinline__ void operator()(const f32x4 (&acc)[2][2][4][2], const Unit& u, int wr, int wc, int fr_, int fq_) const {
        (void)fr_; (void)fq_; int ln_; asm volatile("v_mbcnt_lo_u32_b32 %0, -1, 0\n\tv_mbcnt_hi_u32_b32 %0, -1, %0" : "=v"(ln_)); const int fr = ln_ & 15, fq = ln_ >> 4;
        unsigned char* ws = wsptr(*a);
        bf16_t* Kp = (bf16_t*)(ws + WS_K); bf16_t* Vp = (bf16_t*)(ws + WS_V); const float* rstd = (const float*)(ws + WS_RSTD) + M;
        int row0 = u.pm * BM + wr * 64 + fr, col0 = u.pn * BM + wc * 32 + 8 * fq; asm volatile("" : "+v"(row0), "+v"(col0));
#pragma unroll
        for (int ai = 0; ai < 2; ++ai)
#pragma unroll
            for (int m = 0; m < 4; ++m) { const int row = row0 + ai * HALF + m * 16; const float rs = rstd[row];
#pragma unroll
                for (int bj = 0; bj < 2; ++bj) { const int c = col0 + bj * HALF, h = c >> 7, w = c & 127;
                    const f32x4 v0 = acc[ai][bj][m][0] * rs, v1 = acc[ai][bj][m][1] * rs;
                    u32x4 o; o.x = cvt_pk_bf16(v0[0], v0[1]); o.y = cvt_pk_bf16(v0[2], v0[3]); o.z = cvt_pk_bf16(v1[0], v1[1]); o.w = cvt_pk_bf16(v1[2], v1[3]);
                    bf16_t* dst = (w < 64) ? (Kp + (size_t)row * 768 + h * 96 + w) : (Vp + (size_t)row * 512 + h * 64 + (w - 64));
                    *(u32x4*)dst = o; }
                asm volatile("" ::: "memory"); }
    }
};
struct EpiMerge {
    static constexpr bool PERM = true, AFTER_DRAIN = false;
    const Args* a;
    __device__ __forceinline__ void operator()(const f32x4 (&acc)[2][2][4][2], const Unit& u, int wr, int wc, int fr_, int fq_) const {
        (void)fr_; (void)fq_; int ln_; asm volatile("v_mbcnt_lo_u32_b32 %0, -1, 0\n\tv_mbcnt_hi_u32_b32 %0, -1, %0" : "=v"(ln_)); const int fr = ln_ & 15, fq = ln_ >> 4;
        unsigned char* ws = wsptr(*a);
        const int b = u.pn >> 2, pn = u.pn & 3;
        bf16_t* O = (bf16_t*)(ws + WS_XN); const bf16_t* Gt = (const bf16_t*)(ws + WS_G) + 1024 * b; const bool accum = b > 0;
        int row0 = u.pm * BM + wr * 64 + fr, col0 = pn * BM + wc * 32 + 8 * fq; asm volatile("" : "+v"(row0), "+v"(col0));
#pragma unroll
        for (int ai = 0; ai < 2; ++ai)
#pragma unroll
            for (int m = 0; m < 4; ++m) { const int row = row0 + ai * HALF + m * 16;
#pragma unroll
                for (int bj = 0; bj < 2; ++bj) { const int c = col0 + bj * HALF;
                    const u32x4 gw = *(const u32x4*)(Gt + (size_t)row * 3072 + c);
                    f32x4 v0 = acc[ai][bj][m][0], v1 = acc[ai][bj][m][1];
                    v0[0] *= bf_lo(gw.x); v0[1] *= bf_hi(gw.x); v0[2] *= bf_lo(gw.y); v0[3] *= bf_hi(gw.y); v1[0] *= bf_lo(gw.z); v1[1] *= bf_hi(gw.z); v1[2] *= bf_lo(gw.w); v1[3] *= bf_hi(gw.w);
                    if (accum) { unsigned long long* op = (unsigned long long*)(O + (size_t)row * 1024 + c);
                        const unsigned long long o01 = __hip_atomic_load(op, __ATOMIC_RELAXED, __HIP_MEMORY_SCOPE_AGENT), o23 = __hip_atomic_load(op + 1, __ATOMIC_RELAXED, __HIP_MEMORY_SCOPE_AGENT);
                        const unsigned ox = (unsigned)o01, oy = (unsigned)(o01 >> 32), oz = (unsigned)o23, ow = (unsigned)(o23 >> 32);
                        v0[0] += bf_lo(ox); v0[1] += bf_hi(ox); v0[2] += bf_lo(oy); v0[3] += bf_hi(oy); v1[0] += bf_lo(oz); v1[1] += bf_hi(oz); v1[2] += bf_lo(ow); v1[3] += bf_hi(ow); }
                    u32x4 o; o.x = cvt_pk_bf16(v0[0], v0[1]); o.y = cvt_pk_bf16(v0[2], v0[3]); o.z = cvt_pk_bf16(v1[0], v1[1]); o.w = cvt_pk_bf16(v1[2], v1[3]);
                    *(u32x4*)(O + (size_t)row * 1024 + c) = o; }
                asm volatile("" ::: "memory"); }
    }
};
template <int CTRL> __device__ __forceinline__ float dppf(float x) { return __builtin_bit_cast(float, __builtin_amdgcn_mov_dpp(__builtin_bit_cast(int, x), CTRL, 0xf, 0xf, true)); }
__device__ __forceinline__ float gelu_tanh_(float x) { const float z = 1.5957691216057308f * (x + 0.044715f * x * x * x); return x * __builtin_amdgcn_rcpf(1.0f + __builtin_amdgcn_exp2f(-1.4426950408889634f * z)); }
struct EpiGlu {
    static constexpr bool PERM = true, AFTER_DRAIN = false;
    const Args* a; int l;
    __device__ __forceinline__ void operator()(const f32x4 (&acc)[2][2][4][2], const Unit& u, int wr, int wc, int fr_, int fq_) const {
        (void)fr_; (void)fq_; int ln_; asm volatile("v_mbcnt_lo_u32_b32 %0, -1, 0\n\tv_mbcnt_hi_u32_b32 %0, -1, %0" : "=v"(ln_)); const int fr = ln_ & 15, fq = ln_ >> 4;
        bf16_t* ACT = (bf16_t*)(wsptr(*a) + WS_ACT);
        const float* cw = (const float*)inptr(*a, 26) + (size_t)l * 3 * 5632; const float* cb = (const float*)inptr(*a, 27) + (size_t)l * 5632;
        int jcol = u.pn * 128 + wc * 32 + 8 * fq; asm volatile("" : "+v"(jcol));
        f32x4 wu[3][2], wg[3][2], bu[2], bg[2];
#pragma unroll
        for (int n = 0; n < 2; ++n) {
#pragma unroll
            for (int k = 0; k < 3; ++k) { wu[k][n] = *(const f32x4*)(cw + k * 5632 + jcol + 4 * n); wg[k][n] = *(const f32x4*)(cw + k * 5632 + 2816 + jcol + 4 * n); }
            bu[n] = *(const f32x4*)(cb + jcol + 4 * n); bg[n] = *(const f32x4*)(cb + 2816 + jcol + 4 * n); }
        const bool fix = u.pm >= 64; const int pmf = fix ? u.pm - 64 : u.pm;
#pragma unroll
        for (int ai = 0; ai < 2; ++ai)
#pragma unroll
            for (int m = 3; m >= 0; --m) { const int mp = m > 0 ? m - 1 : 0; float o[8];
#pragma unroll
                for (int n = 0; n < 2; ++n)
#pragma unroll
                    for (int e = 0; e < 4; ++e) {
                        const float xu = acc[ai][0][m][n][e], xg = acc[ai][1][m][n][e], yu = acc[ai][0][mp][n][e], yg = acc[ai][1][mp][n][e];
                        const float u1 = dppf<0x121>(fr == 15 ? yu : xu), u2 = dppf<0x122>(fr >= 14 ? yu : xu), g1 = dppf<0x121>(fr == 15 ? yg : xg), g2 = dppf<0x122>(fr >= 14 ? yg : xg);
                        const float cu = bu[n][e] + wu[2][n][e] * xu + wu[1][n][e] * u1 + wu[0][n][e] * u2, cg = bg[n][e] + wg[2][n][e] * xg + wg[1][n][e] * g1 + wg[0][n][e] * g2;
                        o[4 * n + e] = gelu_tanh_(cg) * cu; }
                const int R = pmf * BM + ai * HALF + wr * 64 + m * 16 + fr;
                const bool st = fix ? ((fr & 3) >= 2) : !(m == 0 && fr < 2);
                const int row = fix ? 64 * (R >> 2) + (fr & 3) - 2 : R;
                if (st) { u32x4 w; w.x = cvt_pk_bf16(o[0], o[1]); w.y = cvt_pk_bf16(o[2], o[3]); w.z = cvt_pk_bf16(o[4], o[5]); w.w = cvt_pk_bf16(o[6], o[7]);
                    *(u32x4*)(ACT + (size_t)row * 2816 + jcol) = w; } }
    }
};
template <size_t OFF> struct EpiF32 {
    static constexpr bool PERM = false, AFTER_DRAIN = false;
    const Args* a;
    __device__ __forceinline__ void operator()(const f32x4 (&acc)[2][2][4][2], const Unit& u, int wr, int wc, int fr_, int fq_) const {
        (void)fr_; (void)fq_; int ln_; asm volatile("v_mbcnt_lo_u32_b32 %0, -1, 0\n\tv_mbcnt_hi_u32_b32 %0, -1, %0" : "=v"(ln_)); const int fr = ln_ & 15, fq = ln_ >> 4;
        float* O = (float*)(wsptr(*a) + OFF);
        int row0 = u.pm * BM + wr * 64 + fr, col0 = u.pn * BM + wc * 32 + 4 * fq; asm volatile("" : "+v"(row0), "+v"(col0));
#pragma unroll
        for (int ai = 0; ai < 2; ++ai)
#pragma unroll
            for (int m = 0; m < 4; ++m) { float* rowp = O + (size_t)(row0 + ai * HALF + m * 16) * 1024 + col0;
#pragma unroll
                for (int bj = 0; bj < 2; ++bj)
#pragma unroll
                    for (int n = 0; n < 2; ++n) *(f32x4*)(rowp + bj * HALF + n * 16) = acc[ai][bj][m][n]; }
    }
};

template <class Epi, class Sched, bool ALIGN_EPI = false, bool SP2 = false>
__device__ __forceinline__ void gemm_phase(PG8_LAS unsigned char* lds, const Gemm g, const Sched& S, const Epi& E, int tid_in) {
    int tid_ = tid_in; asm volatile("" : "+v"(tid_));
    const int tid = tid_, wid = __builtin_amdgcn_readfirstlane(tid >> 6), lane = tid & 63, wr = wid >> 2, wc = wid & 3, fr = lane & 15, fq = lane >> 4;
    const int K = g.K, nt = K / BK;
    unsigned voffA[2], voffB[2];
#pragma unroll
    for (int i = 0; i < 2; ++i) { int R, C; stage_rc(tid * 16 + i * 8192, R, C); const int Rb = Epi::PERM ? ((R & ~31) + perm32(R & 31)) : R;
        voffA[i] = (unsigned)(R * g.lda + C) * 2u; voffB[i] = (unsigned)(Rb * K + C) * 2u; }
    const size_t kstep = (size_t)(BK * 2);
    const size_t hstepA = (size_t)HALF * g.lda * 2, hstepB = (size_t)HALF * K * 2;
    const size_t tstepA = 2 * hstepA, tstepB = 2 * hstepB;
    const unsigned ldsw = (unsigned)wid * 1024u;
    const int aoff = lds_byte(wr * 64 + fr, fq * 8), boff = lds_byte(wc * 32 + fr, fq * 8);
#define PG8_SA(b, h) (((b) * 2 + (h)) * HTB)
#define PG8_SB(b, h) ((4 + (b) * 2 + (h)) * HTB)
#define PG8_STAGE(bufoff, gbase, voff) do { _Pragma("unroll") for (int _i = 0; _i < 2; ++_i) \
        __builtin_amdgcn_global_load_lds((const unsigned*)((const char*)(gbase) + (voff)[_i]), (PG8_LAS unsigned*)(lds + (bufoff) + ldsw + _i * 8192), 16, 0, 0); } while (0)
#define PG8_LDA(dst, b, h) do { _Pragma("unroll") for (int m = 0; m < 4; ++m) _Pragma("unroll") for (int k = 0; k < 2; ++k) dst[m][k] = *(const PG8_LAS bf16x8*)(lds + PG8_SA(b, h) + aoff + m * 2048 + k * 1024); } while (0)
#define PG8_LDB(dst, b, h) do { _Pragma("unroll") for (int n = 0; n < 2; ++n) _Pragma("unroll") for (int k = 0; k < 2; ++k) dst[n][k] = *(const PG8_LAS bf16x8*)(lds + PG8_SB(b, h) + boff + n * 2048 + k * 1024); } while (0)
#define PG8_MMA(ai, bj, At, Bt) do { __builtin_amdgcn_s_setprio(1); _Pragma("unroll") for (int m = 0; m < 4; ++m) _Pragma("unroll") for (int n = 0; n < 2; ++n) _Pragma("unroll") for (int k = 0; k < 2; ++k) \
        acc[ai][bj][m][n] = __builtin_amdgcn_mfma_f32_16x16x32_bf16(Bt[n][k], At[m][k], acc[ai][bj][m][n], 0, 0, 0); __builtin_amdgcn_s_setprio(0); } while (0)
#define PG8_WAIT_V(n) asm volatile("s_waitcnt vmcnt(" #n ")" ::: "memory")
#define PG8_WAIT_L(n) asm volatile("s_waitcnt lgkmcnt(" #n ")" ::: "memory")
#define PG8_BAR __builtin_amdgcn_s_barrier()
#define PG8_SCHED __builtin_amdgcn_sched_barrier(0)
    Unit cur, nxt; int ui = 0;
    if (!S.next(0, cur)) return;
    f32x4 acc[2][2][4][2];
#pragma unroll
    for (int a = 0; a < 2; ++a)
#pragma unroll
        for (int b = 0; b < 2; ++b)
#pragma unroll
            for (int m = 0; m < 4; ++m)
#pragma unroll
                for (int n = 0; n < 2; ++n) acc[a][b][m][n] = (f32x4){0.f, 0.f, 0.f, 0.f};
    bf16x8 At[4][2], B0[2][2], B1[2][2];
    const char* cA = (const char*)g.A + (size_t)cur.pm * tstepA + cur.ao; const char* cB = (const char*)g.Bt + (size_t)cur.pn * tstepB;
    S.a_ready(cur);
    if constexpr (SP2) {
        PG8_STAGE(PG8_SB(0, 0), cB, voffB); PG8_STAGE(PG8_SB(0, 1), cB + hstepB, voffB); PG8_STAGE(PG8_SA(0, 0), cA, voffA); PG8_STAGE(PG8_SA(0, 1), cA + hstepA, voffA);
        if (wr == 1) PG8_BAR;
        PG8_WAIT_V(2); PG8_BAR;
        PG8_STAGE(PG8_SB(1, 0), cB + kstep, voffB); PG8_STAGE(PG8_SA(1, 0), cA + kstep, voffA); PG8_STAGE(PG8_SB(1, 1), cB + hstepB + kstep, voffB);
        PG8_WAIT_V(6); PG8_BAR;
    } else {
        PG8_STAGE(PG8_SB(0, 0), cB, voffB); PG8_STAGE(PG8_SA(0, 0), cA, voffA); PG8_STAGE(PG8_SB(0, 1), cB + hstepB, voffB); PG8_STAGE(PG8_SA(0, 1), cA + hstepA, voffA);
        if (wr == 1) PG8_BAR;
        PG8_WAIT_V(4); PG8_BAR;
        PG8_STAGE(PG8_SB(1, 0), cB + kstep, voffB); PG8_STAGE(PG8_SA(1, 0), cA + kstep, voffA); PG8_STAGE(PG8_SB(1, 1), cB + hstepB + kstep, voffB);
        PG8_WAIT_V(6); PG8_BAR;
    }
    for (;;) {
        const bool has_next = S.next(ui + 1, nxt);
        const char* nA = has_next ? (const char*)g.A + (size_t)nxt.pm * tstepA + nxt.ao : cA; const char* nB = has_next ? (const char*)g.Bt + (size_t)nxt.pn * tstepB : cB;
        for (int t = 0; t < nt; t += 2) {
            const bool last = (t == nt - 2);
            const char* a1 = cA + (size_t)(t + 1) * kstep;
            const char* a2 = last ? nA : cA + (size_t)(t + 2) * kstep; const char* b2 = last ? nB : cB + (size_t)(t + 2) * kstep;
            const char* a3 = a2 + kstep; const char* b3 = b2 + kstep;
            if (last && has_next) S.a_ready(nxt);
            if constexpr (SP2) {
            PG8_LDB(B0, 0, 0); PG8_LDB(B1, 0, 1); PG8_SCHED; PG8_LDA(At, 0, 0); PG8_STAGE(PG8_SA(1, 1), a1 + hstepA, voffA);
            PG8_WAIT_V(8); PG8_WAIT_L(0); PG8_BAR; PG8_MMA(0, 0, At, B0); PG8_MMA(0, 1, At, B1); PG8_BAR; PG8_SCHED;
            PG8_LDA(At, 0, 1); PG8_STAGE(PG8_SB(0, 0), b2, voffB); PG8_STAGE(PG8_SB(0, 1), b2 + hstepB, voffB); PG8_STAGE(PG8_SA(0, 0), a2, voffA);
            PG8_WAIT_V(8); PG8_WAIT_L(0); PG8_BAR; PG8_MMA(1, 0, At, B0); PG8_MMA(1, 1, At, B1); PG8_BAR; PG8_SCHED;
            PG8_LDB(B0, 1, 0); PG8_LDB(B1, 1, 1); PG8_SCHED; PG8_LDA(At, 1, 0); PG8_STAGE(PG8_SA(0, 1), a2 + hstepA, voffA);
            PG8_WAIT_V(8); PG8_WAIT_L(0); PG8_BAR; PG8_MMA(0, 0, At, B0); PG8_MMA(0, 1, At, B1); PG8_BAR; PG8_SCHED;
            PG8_LDA(At, 1, 1); PG8_STAGE(PG8_SB(1, 0), b3, voffB); PG8_STAGE(PG8_SB(1, 1), b3 + hstepB, voffB); PG8_STAGE(PG8_SA(1, 0), a3, voffA);
            PG8_WAIT_V(8); PG8_WAIT_L(0); PG8_BAR; PG8_MMA(1, 0, At, B0); PG8_MMA(1, 1, At, B1); PG8_BAR; PG8_SCHED;
            } else {
            PG8_LDB(B0, 0, 0); PG8_SCHED; PG8_LDA(At, 0, 0); PG8_STAGE(PG8_SA(1, 1), a1 + hstepA, voffA);
            PG8_WAIT_L(8); PG8_BAR; PG8_WAIT_L(0); PG8_MMA(0, 0, At, B0); PG8_BAR; PG8_SCHED;
            PG8_LDB(B1, 0, 1); PG8_STAGE(PG8_SB(0, 0), b2, voffB);
            PG8_BAR; PG8_WAIT_L(0); PG8_MMA(0, 1, At, B1); PG8_BAR;
            PG8_LDA(At, 0, 1); PG8_STAGE(PG8_SA(0, 0), a2, voffA);
            PG8_BAR; PG8_WAIT_L(0); PG8_MMA(1, 0, At, B0); PG8_BAR; PG8_SCHED;
            PG8_STAGE(PG8_SB(0, 1), b2 + hstepB, voffB);
            PG8_WAIT_V(6); PG8_BAR; PG8_MMA(1, 1, At, B1); PG8_BAR;
            PG8_LDB(B0, 1, 0); PG8_SCHED; PG8_LDA(At, 1, 0); PG8_STAGE(PG8_SA(0, 1), a2 + hstepA, voffA);
            PG8_WAIT_L(8); PG8_BAR; PG8_WAIT_L(0); PG8_MMA(0, 0, At, B0); PG8_BAR; PG8_SCHED;
            PG8_LDB(B1, 1, 1); PG8_STAGE(PG8_SB(1, 0), b3, voffB);
            PG8_BAR; PG8_WAIT_L(0); PG8_MMA(0, 1, At, B1); PG8_BAR;
            PG8_LDA(At, 1, 1); PG8_STAGE(PG8_SA(1, 0), a3, voffA);
            PG8_BAR; PG8_WAIT_L(0); PG8_MMA(1, 0, At, B0); PG8_BAR; PG8_SCHED;
            PG8_STAGE(PG8_SB(1, 1), b3 + hstepB, voffB);
            PG8_WAIT_V(6); PG8_BAR; PG8_MMA(1, 1, At, B1); PG8_BAR;
            }
        }
        if constexpr (ALIGN_EPI) { if (wr == 0) PG8_BAR; }
        if constexpr (!Epi::AFTER_DRAIN) { E(acc, cur, wr, wc, fr, fq); S.done(cur); }
        if (!has_next) break;
#pragma unroll
        for (int a = 0; a < 2; ++a)
#pragma unroll
            for (int b = 0; b < 2; ++b)
#pragma unroll
                for (int m = 0; m < 4; ++m)
#pragma unroll
                    for (int n = 0; n < 2; ++n) acc[a][b][m][n] = (f32x4){0.f, 0.f, 0.f, 0.f};
        cur = nxt; cA = nA; cB = nB; ++ui;
        if constexpr (ALIGN_EPI) { if (wr == 1) PG8_BAR; }
    }
    PG8_WAIT_V(0);
    if constexpr (!ALIGN_EPI) { if (wr == 0) PG8_BAR; }
    PG8_BAR;
    if constexpr (Epi::AFTER_DRAIN) { E.fused(acc, cur, wr, wc, fr, fq, lds, wid, lane); S.done(cur); }
#undef PG8_SA
#undef PG8_SB
#undef PG8_STAGE
#undef PG8_LDA
#undef PG8_LDB
#undef PG8_MMA
#undef PG8_WAIT_V
#undef PG8_WAIT_L
#undef PG8_BAR
#undef PG8_SCHED
}
}

#define GAS __attribute__((address_space(1)))
#define LAS __attribute__((address_space(3)))
typedef unsigned short bf16;
typedef unsigned v4u __attribute__((ext_vector_type(4)));
typedef float f32x4 __attribute__((ext_vector_type(4)));
typedef short bf16x8 __attribute__((ext_vector_type(8)));
typedef GAS unsigned gu32;
typedef GAS unsigned long long gu64;
#define RLX_AGENT __ATOMIC_RELAXED, __HIP_MEMORY_SCOPE_AGENT
#define LDS_WAIT() asm volatile("s_waitcnt lgkmcnt(0)" ::: "memory")
#define VM_WAIT() asm volatile("s_waitcnt vmcnt(0)" ::: "memory")
__device__ __forceinline__ unsigned long long rt() { return __builtin_amdgcn_s_memrealtime(); }
__device__ __forceinline__ unsigned f2bf(float f) { unsigned u = __builtin_bit_cast(unsigned, f); return (u + 0x7fffu + ((u >> 16) & 1u)) >> 16; }
__device__ __forceinline__ unsigned pk2(float lo, float hi) { return f2bf(lo) | (f2bf(hi) << 16); }

#define XB_TMO      128
#define XB_XCNT(j)  (256  + 64 * (j))
#define XB_XSUB(j)  (1280 + 64 * (j))
#define XB_XGEN(j)  (2304 + 64 * (j))
#define XB_TOP      3328
#define XB_TOPGEN   3392
#define XCD_BAR_WORDS 3456
#define XB_SPIN_CAP (1u << 18)

__device__ __forceinline__ unsigned xb_ld(unsigned* p)              { return __hip_atomic_load(p, __ATOMIC_RELAXED, __HIP_MEMORY_SCOPE_AGENT); }
__device__ __forceinline__ unsigned xb_add(unsigned* p, unsigned v) { return __hip_atomic_fetch_add(p, v, __ATOMIC_RELAXED, __HIP_MEMORY_SCOPE_AGENT); }
__device__ __forceinline__ unsigned xb_xcc_id() { return (unsigned)__builtin_amdgcn_s_getreg((3 << 11) | 20) & 0xFu; }
#define XB_SPIN(cond, bar) do { unsigned _sp = 0; while (cond) { __builtin_amdgcn_s_sleep(1); \
    if ((++_sp & 255u) == 0u) { if (xb_ld(&(bar)[XB_TMO])) break; if (_sp > XB_SPIN_CAP) { atomicAdd(&(bar)[XB_TMO], 1u); break; } } } } while (0)

struct XcdBarrier {
    unsigned* bar; unsigned x;
    volatile LAS unsigned* st;
};

__device__ __forceinline__ XcdBarrier xcd_barrier_post(unsigned* bar, volatile LAS unsigned* st) {
    XcdBarrier b; b.bar = bar; b.x = xb_xcc_id(); b.st = st;
    if (threadIdx.x == 0) (void)xb_add(&bar[XB_XCNT(b.x)], 1u);
    return b;
}
__device__ __forceinline__ void xcd_barrier_complete(unsigned* bar, unsigned x, unsigned& nloc, unsigned& nx) {
    const unsigned G = gridDim.x * gridDim.y * gridDim.z;
    unsigned sum, cnt, mine, sp = 0u;
    for (;;) {
        sum = 0u; cnt = 0u; mine = 0u;
#pragma unroll
        for (unsigned j = 0; j < 16; ++j) { const unsigned c = xb_ld(&bar[XB_XCNT(j)]); sum += c; cnt += (c > 0u) ? 1u : 0u; mine = (j == x) ? c : mine; }
        if (sum == G) break;
        __builtin_amdgcn_s_sleep(1);
        if ((++sp & 255u) == 0u) { if (xb_ld(&bar[XB_TMO])) break; if (sp > XB_SPIN_CAP) { atomicAdd(&bar[XB_TMO], 1u); break; } }
    }
    nloc = mine > 0u ? mine : 1u; nx = cnt > 0u ? cnt : 1u;
}

__device__ __forceinline__ void xcd_barrier(const XcdBarrier& b) {
    asm volatile("s_waitcnt vmcnt(0)" ::: "memory");
    __syncthreads();
    if (threadIdx.x == 0) {
        unsigned* bar = b.bar;
        __builtin_amdgcn_s_waitcnt(0);
        unsigned nloc = b.st[0], nx = b.st[1];
        if (nloc == 0u) { xcd_barrier_complete(bar, b.x, nloc, nx); b.st[0] = nloc; b.st[1] = nx; }
        const unsigned old = xb_add(&bar[XB_XSUB(b.x)], 1u);
        const unsigned gen = old / nloc;
        if (old + 1u == (gen + 1u) * nloc) {
            __builtin_amdgcn_fence(__ATOMIC_RELEASE, "agent");
            asm volatile("s_waitcnt vmcnt(0)" ::: "memory");
            const unsigned og = xb_add(&bar[XB_TOP], 1u);
            const unsigned tg = og / nx;
            if (og + 1u == (tg + 1u) * nx) xb_add(&bar[XB_TOPGEN], 1u);
            else XB_SPIN(xb_ld(&bar[XB_TOPGEN]) == tg, bar);
            __builtin_amdgcn_fence(__ATOMIC_ACQUIRE, "agent");
            xb_add(&bar[XB_XGEN(b.x)], 1u);
            asm volatile("s_waitcnt vmcnt(0)" ::: "memory");
        } else {
            XB_SPIN(xb_ld(&bar[XB_XGEN(b.x)]) == gen, bar);
            __builtin_amdgcn_fence(__ATOMIC_ACQUIRE, "agent");
            asm volatile("s_waitcnt vmcnt(0)" ::: "memory");
        }
    }
    __syncthreads();
}

namespace att {
using bf16 = unsigned short;
typedef short bf16x8 __attribute__((ext_vector_type(8)));
typedef short s16x4 __attribute__((ext_vector_type(4)));
typedef float f32x16 __attribute__((ext_vector_type(16)));
typedef float f32x4 __attribute__((ext_vector_type(4)));
typedef unsigned u32x4 __attribute__((ext_vector_type(4)));
constexpr int DQK = 96, DV = 64, NW = 8, QBLK = 32, KVBLK = 64, QB = NW * QBLK;
constexpr int QP = 768, KP = 768, VP = 512, OP = 1536;
constexpr int SHM_V = KVBLK * DV * 2  , SHM_K = KVBLK * 256  ;
constexpr int LDS_BYTES = 2 * SHM_V + 2 * SHM_K + NW * 64 * 4;
constexpr float SCALE = 0.10206207261596575f;
constexpr float THR = 8.f;
#define KSWZ(row, colB) ((row) * 256 + ((colB) ^ (((row) & 7) << 4)))
#define SBAR() __builtin_amdgcn_sched_barrier(0)
__device__ __forceinline__ int v_st(int k, int c) { const int kk = (k & ~0xC) | ((k & 4) << 1) | ((k & 8) >> 1); return ((kk >> 3) * 2 + (c >> 5)) * 512 + ((kk & 7) * 32 + (c & 31)) * 2; }
__device__ __forceinline__ int v_rd_base(int lane) { return ((lane & 3) << 3) | (((lane >> 2) & 3) << 6) | (((lane >> 4) & 1) << 5) | (((lane >> 5) & 1) << 8); }
__device__ __forceinline__ int crow(int r, int hi) { return (r & 3) + 8 * (r >> 2) + 4 * hi; }
typedef float f32x2_t __attribute__((ext_vector_type(2))); typedef __bf16 bf16x2_t __attribute__((ext_vector_type(2)));
__device__ __forceinline__ unsigned cvtpk(float lo, float hi) { f32x2_t v = {lo, hi}; bf16x2_t b = __builtin_convertvector(v, bf16x2_t); return __builtin_bit_cast(unsigned, b); }
__device__ __forceinline__ void mask_tile(f32x16& p0, f32x16& p1, int dq) {
    const float NEG = -__builtin_inff();
#pragma unroll
    for (int r = 0; r < 16; ++r) { const int c = (r & 3) + 8 * (r >> 2); if (dq - c < 0) p0[r] = NEG; if (dq - c - 32 < 0) p1[r] = NEG; }
}
__device__ __forceinline__ void partialSM(f32x16& p0, f32x16& p1, float& m_reg, float& mn, float& alpha) {
    float pmax = p0[0];
#pragma unroll
    for (int r = 1; r < 16; ++r) pmax = fmaxf(pmax, p0[r]);
#pragma unroll
    for (int r = 0; r < 16; ++r) pmax = fmaxf(pmax, p1[r]);
    { auto rr = __builtin_amdgcn_permlane32_swap(__float_as_uint(pmax), __float_as_uint(pmax), false, false);
      pmax = fmaxf(__uint_as_float(rr[0]), __uint_as_float(rr[1])); }
    constexpr float C2 = 1.4426950408889634f * SCALE;
    if (__builtin_expect(__all((pmax - m_reg) * SCALE <= THR), 1)) { mn = m_reg; alpha = 1.f; }
    else { mn = fmaxf(m_reg, pmax); alpha = __builtin_amdgcn_exp2f((m_reg - mn) * C2); m_reg = mn; }
    const float mnL = -mn * C2;
#pragma unroll
    for (int r = 0; r < 16; ++r) p0[r] = fmaf(p0[r], C2, mnL);
#pragma unroll
    for (int r = 0; r < 16; ++r) p1[r] = fmaf(p1[r], C2, mnL);
#pragma unroll
    for (int r = 0; r < 16; ++r) p0[r] = __builtin_amdgcn_exp2f(p0[r]);
}
__device__ __forceinline__ void finishSM(f32x16& p0, f32x16& p1, float alpha, float& l_reg, bf16x8& pa0, bf16x8& pa1, bf16x8& pa2, bf16x8& pa3) {
#pragma unroll
    for (int r = 0; r < 16; ++r) p1[r] = __builtin_amdgcn_exp2f(p1[r]);
    float ps = 0;
#pragma unroll
    for (int r = 0; r < 16; ++r) ps += p0[r];
#pragma unroll
    for (int r = 0; r < 16; ++r) ps += p1[r];
    { auto rr = __builtin_amdgcn_permlane32_swap(__float_as_uint(ps), __float_as_uint(ps), false, false);
      ps = __uint_as_float(rr[0]) + __uint_as_float(rr[1]); }
    l_reg = l_reg * alpha + ps;
#define PK4(P, B_, OUT) do { unsigned a0 = cvtpk(P[B_+0], P[B_+1]), a1 = cvtpk(P[B_+2], P[B_+3]);                          \
        unsigned b0 = cvtpk(P[B_+4], P[B_+5]), b1 = cvtpk(P[B_+6], P[B_+7]);                                             \
        auto r0 = __builtin_amdgcn_permlane32_swap(a0, b0, false, false); auto r1 = __builtin_amdgcn_permlane32_swap(a1, b1, false, false); \
        u32x4 w = {r0[0], r1[0], r0[1], r1[1]}; OUT = *reinterpret_cast<bf16x8*>(&w); } while (0)
    PK4(p0, 0, pa0); PK4(p0, 8, pa1); PK4(p1, 0, pa2); PK4(p1, 8, pa3);
#undef PK4
}
template <int KB>
__device__ __forceinline__ void qkt(f32x16& p0, f32x16& p1, const char* K_lds, int r32, int hi, const bf16x8* qr) {
    p0 = f32x16{}; p1 = f32x16{};
    const char* kb[4];
#pragma unroll
    for (int dd = 0; dd < 4; ++dd) kb[dd] = K_lds + KB * SHM_K + KSWZ(r32, (dd * 16 + hi * 8) * 2);
#pragma unroll
    for (int d0 = 0; d0 < 6; ++d0) { const char* a = kb[d0 & 3] + (d0 >> 2) * 128;
        bf16x8 b0 = *reinterpret_cast<const bf16x8*>(a);
        bf16x8 b1 = *reinterpret_cast<const bf16x8*>(a + 32 * 256);
        p0 = __builtin_amdgcn_mfma_f32_32x32x16_bf16(b0, qr[d0], p0, 0, 0, 0);
        p1 = __builtin_amdgcn_mfma_f32_32x32x16_bf16(b1, qr[d0], p1, 0, 0, 0); }
}
template <int VB>
__device__ __forceinline__ void pv_tile(f32x16* o, int vb0, bf16x8 pa0, bf16x8 pa1, bf16x8 pa2, bf16x8 pa3) {
#define TRRD(dst, off) asm volatile("ds_read_b64_tr_b16 %0, %1 offset:%2" : "=&v"(dst) : "v"(vb0), "i"(off) : "memory")
#define PV_D0(d0) do { s16x4 l0, l1, l2, l3, h0, h1, h2, h3; constexpr int b_ = VB * SHM_V + (d0) * 512;   \
        TRRD(l0, b_); TRRD(h0, b_ + 1024); TRRD(l1, b_ + 2048); TRRD(h1, b_ + 3072); TRRD(l2, b_ + 4096); TRRD(h2, b_ + 5120); TRRD(l3, b_ + 6144); TRRD(h3, b_ + 7168); \
        asm volatile("s_waitcnt lgkmcnt(0)" ::: "memory"); SBAR();   \
        o[d0] = __builtin_amdgcn_mfma_f32_32x32x16_bf16(pa0, (bf16x8){l0[0], l0[1], l0[2], l0[3], h0[0], h0[1], h0[2], h0[3]}, o[d0], 0, 0, 0);   \
        o[d0] = __builtin_amdgcn_mfma_f32_32x32x16_bf16(pa1, (bf16x8){l1[0], l1[1], l1[2], l1[3], h1[0], h1[1], h1[2], h1[3]}, o[d0], 0, 0, 0);   \
        o[d0] = __builtin_amdgcn_mfma_f32_32x32x16_bf16(pa2, (bf16x8){l2[0], l2[1], l2[2], l2[3], h2[0], h2[1], h2[2], h2[3]}, o[d0], 0, 0, 0);   \
        o[d0] = __builtin_amdgcn_mfma_f32_32x32x16_bf16(pa3, (bf16x8){l3[0], l3[1], l3[2], l3[3], h3[0], h3[1], h3[2], h3[3]}, o[d0], 0, 0, 0); } while (0)
    PV_D0(0); PV_D0(1);
#undef PV_D0
#undef TRRD
}
struct BlockRef { const bf16* Q; const bf16* K; const bf16* V; bf16* O; int P0; };
struct Seam { bf16x8 qr[6]; bf16x8 st_v, st_k0, st_k1; };
#define VMW() asm volatile("s_waitcnt vmcnt(0)" ::: "memory")
#define VMWN(n) asm volatile("s_waitcnt vmcnt(%0)" :: "i"(n) : "memory")
#define SLOAD(Kp_, Vp_, k0) do { S.st_v = *(const bf16x8*)((Vp_) + (size_t)((k0) + vr) * VP + vc);                                   \
        if (kact) { S.st_k0 = *(const bf16x8*)((Kp_) + (size_t)((k0) + sr) * KP + kc); S.st_k1 = *(const bf16x8*)((Kp_) + (size_t)((k0) + 32 + sr) * KP + kc); } } while (0)
#define SWRITE_K(bf) do { if (kact) { *(bf16x8*)(K_lds + (bf) * SHM_K + kws) = S.st_k0; *(bf16x8*)(K_lds + (bf) * SHM_K + kws + 32 * 256) = S.st_k1; } } while (0)
#define SWRITE_V(bf) do { *(bf16x8*)(V_lds + (bf) * SHM_V + vst) = S.st_v; } while (0)
#define STG_DECL const int sr = tid >> 4, kc = ((tid & 15) < 12 ? (tid & 15) : 11) * 8; const bool kact = true; const int kws = KSWZ(sr, kc * 2); \
        const int vr = tid >> 3, vc = (tid & 7) * 8, vst = v_st(vr, vc);
__device__ __forceinline__ void attn_prime(const BlockRef& cur, char* lds, Seam& S, int tid_in) {
    int tid_ = tid_in; asm volatile("" : "+v"(tid_)); const int tid = tid_, wid = __builtin_amdgcn_readfirstlane(tid >> 6), lane = tid & 63, r32 = lane & 31, hi = lane >> 5;
    STG_DECL; (void)vst; char* K_lds = lds + 2 * SHM_V;
#pragma unroll
    for (int d0 = 0; d0 < 6; ++d0) S.qr[d0] = *(const bf16x8*)(cur.Q + (size_t)(wid * QBLK + r32) * QP + d0 * 16 + hi * 8);
    SLOAD(cur.K, cur.V, 0); VMW(); SWRITE_K(0);
    __syncthreads();
}
__device__ __forceinline__ void attn_block(const BlockRef& cur, const BlockRef& nxt, char* lds, Seam& S, int tid_in) {
    int tid_ = tid_in; asm volatile("" : "+v"(tid_)); const int tid = tid_, wid = __builtin_amdgcn_readfirstlane(tid >> 6), lane = tid & 63, r32 = lane & 31, hi = lane >> 5;
    const int NT = (cur.P0 + QB) / KVBLK;
    const int qlo = cur.P0 + wid * QBLK, qm = qlo + r32 - 4 * hi;
    char* V_lds = lds; char* K_lds = lds + 2 * SHM_V;
    float* ws = (float*)(lds + 2 * SHM_V + 2 * SHM_K) + wid * 64; float* li_l = ws, * al_l = ws + 32;
    float m_reg = -1e30f, l_reg = 0; f32x16 o[2] = {};
    STG_DECL;
    const int vb0 = (int)(uintptr_t)V_lds + v_rd_base(lane);
    const bf16* Kh = cur.K; const bf16* Vh = cur.V;
#define RESC(a) do { if (__any((a) < 1.f)) { if (hi == 0) al_l[r32] = (a); asm volatile("s_waitcnt lgkmcnt(0)" ::: "memory");              \
                     _Pragma("unroll") for (int d_ = 0; d_ < 2; ++d_) _Pragma("unroll") for (int r = 0; r < 16; ++r) o[d_][r] *= al_l[crow(r, hi)]; } } while (0)
#define KBASE(t) ((t) * KVBLK)
#define MASKT(P0_, P1_, t) do { const int kb_ = KBASE(t); if (kb_ + KVBLK - 1 > qlo) mask_tile(P0_, P1_, qm - kb_); } while (0)
    constexpr int NQL = 6;
#define SEAM_K0() do { VMWN(NQL); SWRITE_K(0); SBAR(); } while (0)
    f32x16 pA0, pA1, pB0, pB1; float mnA, mnB, alA, alB; bf16x8 pa0, pa1, pa2, pa3;
    SWRITE_V(0); SBAR();
    if (NT > 1) { SLOAD(Kh, Vh, KBASE(1)); }
    SBAR(); qkt<0>(pA0, pA1, K_lds, r32, hi, S.qr);
    MASKT(pA0, pA1, 0); partialSM(pA0, pA1, m_reg, mnA, alA);
    if (NT > 1) { VMW(); SWRITE_V(1); SWRITE_K(1); }
    __syncthreads();
#define HALF_STEP(PX0, PX1, mnX, alX, PY0, PY1, alY, t, KB, VB, SB) do {                                                      \
        SBAR(); qkt<KB>(PX0, PX1, K_lds, r32, hi, S.qr);                                                                      \
        finishSM(PY0, PY1, alY, l_reg, pa0, pa1, pa2, pa3); SBAR();                                                           \
        if ((t) + 1 < NT) { SLOAD(Kh, Vh, KBASE((t) + 1)); SBAR(); }                                                          \
        pv_tile<VB>(o, vb0, pa0, pa1, pa2, pa3); MASKT(PX0, PX1, (t)); partialSM(PX0, PX1, m_reg, mnX, alX);                  \
        __syncthreads();                                                                                                      \
        if ((t) + 1 < NT) { VMW(); SWRITE_V(SB); SWRITE_K(SB); }                                                              \
        RESC(alX); __syncthreads(); } while (0)
    for (int t = 1; t + 1 < NT; t += 2) {
        HALF_STEP(pB0, pB1, mnB, alB, pA0, pA1, alA, t, 1, 0, 0);
        HALF_STEP(pA0, pA1, mnA, alA, pB0, pB1, alB, t + 1, 0, 1, 1);
    }
    SBAR(); qkt<1>(pB0, pB1, K_lds, r32, hi, S.qr); SBAR();
    SLOAD(nxt.K, nxt.V, 0); SBAR();
#pragma unroll
    for (int d0 = 0; d0 < 6; ++d0) S.qr[d0] = *(const bf16x8*)(nxt.Q + (size_t)(wid * QBLK + r32) * QP + d0 * 16 + hi * 8);
    SBAR();
    finishSM(pA0, pA1, alA, l_reg, pa0, pa1, pa2, pa3); SBAR();
    pv_tile<0>(o, vb0, pa0, pa1, pa2, pa3);
    MASKT(pB0, pB1, NT - 1); partialSM(pB0, pB1, m_reg, mnB, alB); __syncthreads(); RESC(alB);
    finishSM(pB0, pB1, alB, l_reg, pa0, pa1, pa2, pa3); SBAR(); pv_tile<1>(o, vb0, pa0, pa1, pa2, pa3);
    SBAR(); SEAM_K0();
    if (hi == 0) li_l[r32] = l_reg; asm volatile("s_waitcnt lgkmcnt(0)" ::: "memory");
    float rli[16];
#pragma unroll
    for (int r = 0; r < 16; ++r) rli[r] = __builtin_amdgcn_rcpf(li_l[crow(r, hi)]);
    bf16* Ow = cur.O + (size_t)(wid * QBLK) * OP;
#pragma unroll
    for (int r = 0; r < 16; ++r) { const int orow = crow(r, hi);
#pragma unroll
        for (int d0 = 0; d0 < 2; ++d0) { const float v = o[d0][r] * rli[r];
            const float vn = __int_as_float(__builtin_amdgcn_mov_dpp(__float_as_int(v), 0xB1, 0xf, 0xf, true));
            if ((r32 & 1) == 0) *(unsigned*)(Ow + (size_t)orow * OP + d0 * 32 + r32) = cvtpk(v, vn); } }
    __syncthreads();
#undef RESC
#undef KBASE
#undef MASKT
#undef SEAM_K0
#undef HALF_STEP
}
#undef VMW
#undef VMWN
#undef SLOAD
#undef SWRITE_K
#undef SWRITE_V
#undef STG_DECL
#undef SBAR
}


template <int O> __device__ __forceinline__ float swz_xor(float v) { return __int_as_float(__builtin_amdgcn_ds_swizzle(__float_as_int(v), (O << 10) | 0x1f)); }
__device__ __forceinline__ float half_sum(float v) { auto rr = __builtin_amdgcn_permlane32_swap(__float_as_uint(v), __float_as_uint(v), false, false); return __uint_as_float(rr[0]) + __uint_as_float(rr[1]); }
__device__ __forceinline__ float wave_sum(float v) {
    v += swz_xor<1>(v); v += swz_xor<2>(v); v += swz_xor<4>(v); v += swz_xor<8>(v); v += swz_xor<16>(v);
    return half_sum(v);
}
__device__ __forceinline__ float bf2f(bf16 h) { return __uint_as_float((unsigned)h << 16); }
__device__ __forceinline__ float gelu_tanh(float x) { const float z = 1.5957691216057308f * (x + 0.044715f * x * x * x); return x * __builtin_amdgcn_rcpf(1.0f + __builtin_amdgcn_exp2f(-1.4426950408889634f * z)); }
__device__ __forceinline__ float sigm(float x) { return __builtin_amdgcn_rcpf(1.0f + __builtin_amdgcn_exp2f(-1.4426950408889634f * x)); }
__device__ __forceinline__ void unpack8(const v4u w, float* f) { f[0] = __uint_as_float(w.x << 16); f[1] = __uint_as_float(w.x & 0xffff0000u); f[2] = __uint_as_float(w.y << 16); f[3] = __uint_as_float(w.y & 0xffff0000u);
    f[4] = __uint_as_float(w.z << 16); f[5] = __uint_as_float(w.z & 0xffff0000u); f[6] = __uint_as_float(w.w << 16); f[7] = __uint_as_float(w.w & 0xffff0000u); }
__device__ __forceinline__ v4u pack8f(const float* f) { v4u o; o.x = pk2(f[0], f[1]); o.y = pk2(f[2], f[3]); o.z = pk2(f[4], f[5]); o.w = pk2(f[6], f[7]); return o; }

__device__ __forceinline__ int il2(int i, int half) { return i < half ? 2 * i : 2 * (i - half) + 1; }
__device__ __forceinline__ int dstrow(int kind, int s) {
    if (kind == 0) return s;
    if (kind == 1) {
        if (s < 1024) return s;
        if (s < 2048) { const int base = s < 1536 ? 1024 : 1536, w = s - base; return base + (w & ~63) + il2(w & 63, 32); }
        if (s < 3712) return s;
        if (s < 3744) return 3712 + il2(s - 3712, 16);
        return 3840 + (s - 3744);
    }
    if (kind == 3) { const int hd = s / 96, w = s - hd * 96; return w < 64 ? s : hd * 96 + 64 + il2(w - 64, 16); }
    { const int t = s < 2816 ? s : s - 2816; return (t >> 7) * 256 + (t & 127) + (s < 2816 ? 0 : 128); }
}
__device__ __forceinline__ void conv_item(const float* W, int K, int Nsrc, bf16* WT, int kind, const float* ksc, LAS float* scr, int item, int nblk, int lane) {
    const int kb = item / nblk, nb = item - kb * nblk, k0 = 64 * kb, s0 = 32 * nb;
    const int j4 = (lane & 7) * 4, kr = lane >> 3;
#pragma unroll
    for (int i = 0; i < 8; ++i) { const int kk = 8 * i + kr; f32x4 v = *(const f32x4*)(W + (size_t)(k0 + kk) * Nsrc + s0 + j4); if (ksc) v = v * ksc[k0 + kk];
        scr[kk * 33 + j4] = v.x; scr[kk * 33 + j4 + 1] = v.y; scr[kk * 33 + j4 + 2] = v.z; scr[kk * 33 + j4 + 3] = v.w; }
    LDS_WAIT(); asm volatile("" ::: "memory");
    const int c = lane & 7;
#pragma unroll
    for (int j = 0; j < 4; ++j) { const int n = (lane >> 3) + 8 * j; const LAS float* s = scr + (8 * c) * 33 + n;
        v4u o; o.x = pk2(s[0 * 33], s[1 * 33]); o.y = pk2(s[2 * 33], s[3 * 33]); o.z = pk2(s[4 * 33], s[5 * 33]); o.w = pk2(s[6 * 33], s[7 * 33]);
        *(GAS v4u*)(WT + (size_t)dstrow(kind, s0 + n) * K + k0 + 8 * c) = o; }
    LDS_WAIT(); asm volatile("" ::: "memory");
}
__device__ __forceinline__ int conv_matrix(const Ctx& X, LAS unsigned char* lds, int base, const float* W, int K, int Nsrc, bf16* WT, int kind, const float* ksc) {
    LAS float* scr = (LAS float*)(lds + X.wave * 16384);
    const int gw = X.vcu * NWAVES + X.wave, NGW = X.G * NWAVES, nblk = Nsrc / 32, nitems = (K / 64) * nblk;
    int first = (gw - base) % NGW; if (first < 0) first += NGW;
    for (int it = first; it < nitems; it += NGW) conv_item(W, K, Nsrc, WT, kind, ksc, scr, it, nblk, X.lane);
    return base + nitems;
}
__device__ __forceinline__ void convert_mixer(const Ctx& X, LAS unsigned char* lds, const Args& a, int l) {
    bf16* Wb = (bf16*)(wsptr(a) + WS_W); int base = 0;
    base = conv_matrix(X, lds, base, (const float*)inptr(a, I_WIN) + (size_t)l * 1024 * NIN, 1024, NIN, (bf16*)((char*)Wb + WO_IN), 1, nullptr);
    base = conv_matrix(X, lds, base, (const float*)inptr(a, I_WOUT) + (size_t)l * 1024 * 1024, 1024, 1024, (bf16*)((char*)Wb + WO_OUT), 0, nullptr);
    base = conv_matrix(X, lds, base, (const float*)inptr(a, I_LWO) + (size_t)l * 512 * 1024, 512, 1024, (bf16*)((char*)Wb + WO_O3), 0, nullptr);
    base = conv_matrix(X, lds, base, (const float*)inptr(a, I_RWO) + (size_t)l * 512 * 1024, 512, 1024, (bf16*)((char*)Wb + WO_O3) + 1024 * 512, 0, nullptr);
    base = conv_matrix(X, lds, base, (const float*)inptr(a, I_MWO) + (size_t)l * 512 * 1024, 512, 1024, (bf16*)((char*)Wb + WO_O3) + 2 * 1024 * 512, 0, nullptr);
    base = conv_matrix(X, lds, base, (const float*)inptr(a, I_WUQ) + (size_t)l * 384 * 768, 384, 768, (bf16*)((char*)Wb + WO_UQ), 3, (const float*)inptr(a, I_QNG) + l * 384);
    base = conv_matrix(X, lds, base, (const float*)inptr(a, I_WUKV) + (size_t)l * 256 * 1024, 256, 1024, (bf16*)((char*)Wb + WO_UKV), 0, (const float*)inptr(a, I_KVNG) + l * 256);
#pragma unroll 1
    for (int blk = 0; blk < 8; ++blk) {
        base = conv_matrix(X, lds, base, (const float*)inptr(a, I_LWA) + (size_t)(l * 8 + blk) * 4096, 64, 64, (bf16*)((char*)Wb + WO_AT) + blk * 4096, 0, nullptr);
        base = conv_matrix(X, lds, base, (const float*)inptr(a, I_LWX) + (size_t)(l * 8 + blk) * 4096, 64, 64, (bf16*)((char*)Wb + WO_XT) + blk * 4096, 0, nullptr);
    }
    { const int gt = X.vcu * 512 + X.tid, nth = X.G * 512; const unsigned zz = (unsigned)opaque_u(0); v4u z; z.x = zz; z.y = zz; z.z = zz; z.w = zz;
      for (int i = gt; i < 96 * 128; i += nth) *(GAS v4u*)((bf16*)((char*)Wb + WO_IN) + (size_t)3744 * 1024 + (size_t)i * 8) = z; }
}
__device__ __forceinline__ void convert_ffn(const Ctx& X, LAS unsigned char* lds, const Args& a, int l) {
    bf16* Wb = (bf16*)(wsptr(a) + WS_W); int base = 0;
    base = conv_matrix(X, lds, base, (const float*)inptr(a, I_WUP) + (size_t)l * 1024 * 5632, 1024, 5632, (bf16*)((char*)Wb + WO_UP), 4, nullptr);
    base = conv_matrix(X, lds, base, (const float*)inptr(a, I_WDOWN) + (size_t)l * 2816 * 1024, 2816, 1024, (bf16*)((char*)Wb + WO_DOWN), 0, nullptr);
}

__device__ __forceinline__ void p_mods(const Ctx& X, LAS unsigned char* lds, const Args& a) {
    LAS float* cact = (LAS float*)lds; LAS float* red = (LAS float*)(lds + 8192);
    const float* c = (const float*)inptr(a, I_C);
    for (int i = X.tid; i < NB * 1024; i += 512) { const float v = c[i]; cact[i] = v * sigm(v); }
    __syncthreads();
    float* MOD = (float*)(wsptr(a) + WS_MOD);
    const float* adaw = (const float*)inptr(a, I_ADAW); const float* adab = (const float*)inptr(a, I_ADAB);
    for (int it = X.vcu; it < DEPTH * 96; it += X.G) {
        const int l = it / 96, j0 = (it - l * 96) * 64, cl = X.tid & 63, ks = X.tid >> 6;
        const float* w = adaw + (size_t)l * 1024 * 6144 + j0 + cl;
        float a0 = 0.f, a1 = 0.f;
#pragma unroll 1
        for (int k0 = ks * 128; k0 < ks * 128 + 128; k0 += 32) { float wv[32];
#pragma unroll
            for (int i = 0; i < 32; ++i) wv[i] = w[(size_t)(k0 + i) * 6144];
#pragma unroll
            for (int i = 0; i < 32; ++i) { a0 += cact[k0 + i] * wv[i]; a1 += cact[1024 + k0 + i] * wv[i]; } }
        red[(ks * 64 + cl) * 2] = a0; red[(ks * 64 + cl) * 2 + 1] = a1;
        __syncthreads();
        if (X.tid < 128) { const int cc = X.tid & 63, b = X.tid >> 6; float s = 0.f;
#pragma unroll
            for (int q = 0; q < 8; ++q) s += red[(q * 64 + cc) * 2 + b];
            MOD[(size_t)(l * NB + b) * 6144 + j0 + cc] = s + adab[l * 6144 + j0 + cc]; }
        __syncthreads();
    }
}
__device__ __forceinline__ void p_rope(const Ctx& X, const Args& a) {
    float* cr = (float*)(wsptr(a) + WS_ROPE); float* sr = cr + (size_t)M * 32; float* cm = sr + (size_t)M * 32; float* sm = cm + (size_t)M * 16;
    const int* pos = (const int*)inptr(a, I_POS);
    const int nth = X.G * 512;
    for (int idx = X.vcu * 512 + X.tid; idx < M * 32; idx += nth) {
        const int row = idx >> 5, i = idx & 31;
        const double ang = (double)pos[row] * INVR[i];
        const double k = __builtin_rint(ang * 0.15915494309189535);
        double r = __builtin_fma(-k, 6.283185307179586, ang); r = __builtin_fma(-k, 2.4492935982947064e-16, r);
        const float rf = (float)r; const float sn = sinf(rf), cs = cosf(rf);
        cr[idx] = cs; sr[idx] = sn;
        if ((i & 1) == 0) { cm[row * 16 + (i >> 1)] = cs; sm[row * 16 + (i >> 1)] = sn; }
    }
}

template <int MODE, bool HAS_NEXT, bool HALO = false>
__device__ __forceinline__ void row_pass(const Ctx& X, const float* xin, float* xout, const bf16* Y, const float* gpost, const float* gate  ,
                                         const float* gpre, const float* shift, const float* scale, bf16* XN) {
    const int gw = X.vcu * NWAVES + X.wave, NGW = X.G * NWAVES, lane = X.lane;
    for (int b = 0; b < NB; ++b) {
        f32x4 vgp[4], vgt[4], vpre[4], vsh[4], vsc[4];
#pragma unroll
        for (int j = 0; j < 4; ++j) { const int cidx = 4 * lane + 256 * j;
            if (MODE == 1) { vgp[j] = *(const f32x4*)(gpost + cidx); vgt[j] = *(const f32x4*)(gate + (size_t)b * 6144 + cidx); }
            if (MODE == 0 || HAS_NEXT) { vpre[j] = *(const f32x4*)(gpre + cidx); vsh[j] = *(const f32x4*)(shift + (size_t)b * 6144 + cidx); vsc[j] = *(const f32x4*)(scale + (size_t)b * 6144 + cidx) + 1.0f; } }
        for (int m = gw; m < SEQ; m += NGW) { const size_t row = (size_t)b * SEQ + m;
            f32x4 xv[4];
#pragma unroll
            for (int j = 0; j < 4; ++j) xv[j] = *(const f32x4*)(xin + row * 1024 + 4 * lane + 256 * j);
            if (MODE == 1) { f32x4 yv[4]; float s = 0.f;
#pragma unroll
                for (int j = 0; j < 4; ++j) { const u32x2 yw = *(const u32x2*)(Y + row * 1024 + 4 * lane + 256 * j); yv[j].x = __uint_as_float(yw.x << 16); yv[j].y = __uint_as_float(yw.x & 0xffff0000u); yv[j].z = __uint_as_float(yw.y << 16); yv[j].w = __uint_as_float(yw.y & 0xffff0000u); s += (yv[j].x * yv[j].x + yv[j].y * yv[j].y) + (yv[j].z * yv[j].z + yv[j].w * yv[j].w); }
                const float rs = __builtin_amdgcn_rsqf(wave_sum(s) * (1.0f / 1024.0f) + EPS);
#pragma unroll
                for (int j = 0; j < 4; ++j) { xv[j] = xv[j] + vgt[j] * (yv[j] * rs * vgp[j]); *(f32x4*)(xout + row * 1024 + 4 * lane + 256 * j) = xv[j]; } }
            if (MODE == 0 || HAS_NEXT) { float s = 0.f;
#pragma unroll
                for (int j = 0; j < 4; ++j) s += (xv[j].x * xv[j].x + xv[j].y * xv[j].y) + (xv[j].z * xv[j].z + xv[j].w * xv[j].w);
                const float rs = __builtin_amdgcn_rsqf(wave_sum(s) * (1.0f / 1024.0f) + EPS);
#pragma unroll
                for (int j = 0; j < 4; ++j) { const f32x4 h = (xv[j] * rs * vpre[j]) * vsc[j] + vsh[j];
                    u32x2 w; w.x = pk2(h.x, h.y); w.y = pk2(h.z, h.w); *(u32x2*)(XN + row * 1024 + 4 * lane + 256 * j) = w;
                    if (HALO) { bf16* XNH = XN + (size_t)M * 1024; const int r64 = m & 63, q = (int)(row >> 6);
                        if (r64 >= 62) { const int qn = q + 1; if ((qn & 127) != 0) *(u32x2*)(XNH + (size_t)(4 * qn + r64 - 62) * 1024 + 4 * lane + 256 * j) = w; }
                        if (r64 <= 1) *(u32x2*)(XNH + (size_t)(4 * q + 2 + r64) * 1024 + 4 * lane + 256 * j) = w;
                        if (m == 0) { u32x2 z; z.x = 0u; z.y = 0u; *(u32x2*)(XNH + (size_t)(4 * q) * 1024 + 4 * lane + 256 * j) = z; *(u32x2*)(XNH + (size_t)(4 * q + 1) * 1024 + 4 * lane + 256 * j) = z; } } } }
        }
    }
}

__device__ __forceinline__ void p_mla_rstd(const Ctx& X, const Args& a) {
    const bf16* TM = (const bf16*)(wsptr(a) + WS_TM); float* RSTD = (float*)(wsptr(a) + WS_RSTD);
    const int gw = X.vcu * NWAVES + X.wave, NGW = X.G * NWAVES, lane = X.lane;
    for (int m0 = gw * 4; m0 < M; m0 += NGW * 4) {
        u32x2 w[4][3];
#pragma unroll
        for (int r = 0; r < 4; ++r)
#pragma unroll
            for (int k = 0; k < 3; ++k) w[r][k] = *(const u32x2*)(TM + (size_t)(m0 + r) * 768 + k * 256 + lane * 4);
#pragma unroll
        for (int r = 0; r < 4; ++r) { float sq = 0.f, skv = 0.f;
#pragma unroll
            for (int k = 0; k < 3; ++k) { const float f0 = __uint_as_float(w[r][k].x << 16), f1 = __uint_as_float(w[r][k].x & 0xffff0000u), f2 = __uint_as_float(w[r][k].y << 16), f3 = __uint_as_float(w[r][k].y & 0xffff0000u);
                const float s = (f0 * f0 + f1 * f1) + (f2 * f2 + f3 * f3);
                if (k == 0) sq += s; else if (k == 1) { if (lane < 32) sq += s; else skv += s; } else { if (lane < 32) skv += s; } }
            sq = wave_sum(sq); skv = wave_sum(skv);
            if (lane == 0) { RSTD[m0 + r] = __builtin_amdgcn_rsqf(sq * (1.0f / 384.0f) + EPS); RSTD[M + m0 + r] = __builtin_amdgcn_rsqf(skv * (1.0f / 256.0f) + EPS); } }
    }
}
__device__ __forceinline__ void p_krope(const Ctx& X, const Args& a) {
    const bf16* TM = (const bf16*)(wsptr(a) + WS_TM); bf16* Kp = (bf16*)(wsptr(a) + WS_K);
    const float* cm = (const float*)(wsptr(a) + WS_ROPE) + (size_t)M * 64; const float* sm = cm + (size_t)M * 16;
    const int nth = X.G * 512;
    for (int idx = X.vcu * 512 + X.tid; idx < M * 4; idx += nth) { const int row = idx >> 2, cc = idx & 3;
        const v4u w = *(const v4u*)(TM + (size_t)row * 768 + 640 + cc * 8); float f[8]; unpack8(w, f);
        const f32x4 cs = *(const f32x4*)(cm + (size_t)row * 16 + cc * 4), sn = *(const f32x4*)(sm + (size_t)row * 16 + cc * 4);
        float o[8];
#pragma unroll
        for (int p = 0; p < 4; ++p) { o[2 * p] = f[2 * p] * cs[p] - f[2 * p + 1] * sn[p]; o[2 * p + 1] = f[2 * p] * sn[p] + f[2 * p + 1] * cs[p]; }
        const v4u ow = pack8f(o);
#pragma unroll
        for (int h = 0; h < 8; ++h) *(v4u*)(Kp + (size_t)row * 768 + h * 96 + 64 + cc * 8) = ow; }
}

__device__ __forceinline__ float log1p_small(float e) { return e < 0.03f ? e * (1.0f + e * (-0.5f + e * (0.33333334f + e * (-0.25f + e * 0.2f)))) : 0.6931471805599453f * __builtin_amdgcn_logf(1.0f + e); }
__device__ __forceinline__ float softplus_neg(float x) { const float z = -x, e = __builtin_amdgcn_exp2f(-1.4426950408889634f * __builtin_fabsf(z)); return __builtin_fmaxf(z, 0.0f) + log1p_small(e); }
__device__ __forceinline__ float neg_expm1(float y) { return y > -0.1f ? -y * (1.0f + y * (0.5f + y * (0.16666667f + y * (0.041666668f + y * 0.008333334f)))) : 1.0f - __builtin_amdgcn_exp2f(1.4426950408889634f * y); }
constexpr int LRU_XS = 0, LRU_XC = 33792, LRU_XCB = LRU_XC + 32768, LRU_SEG = LRU_XCB + 18432, LRU_GS = LRU_SEG + 4096, LRU_END = LRU_GS + 16384;
static_assert(LRU_END <= 131072, "lru lds");
template <int PASS>
__device__ __forceinline__ void lru_phase(const Ctx& X, unsigned char* ldsg, const Args& a, int l) {
    float* XS = (float*)(ldsg + LRU_XS); float* XC = (float*)(ldsg + LRU_XC); bf16* XCB = (bf16*)(ldsg + LRU_XCB); float* AA = (float*)(ldsg + LRU_XS); float* SEG = (float*)(ldsg + LRU_SEG); bf16* GS = (bf16*)(ldsg + LRU_GS);
    const bf16* TL = (const bf16*)(wsptr(a) + WS_TL); bf16* YB = (bf16*)(wsptr(a) + WS_YB);
    const bf16* WaT = (const bf16*)(wsptr(a) + WS_W + WO_AT); const bf16* WxT = (const bf16*)(wsptr(a) + WS_W + WO_XT);
    float* LSA = (float*)(wsptr(a) + WS_LSA); float* LSH = (float*)(wsptr(a) + WS_LSH); const float* LC = (const float*)(wsptr(a) + WS_LC);
    const float* cw = (const float*)inptr(a, I_LCW) + l * 4 * 512; const float* cbv = (const float*)inptr(a, I_LCB) + l * 512;
    const float* ba = (const float*)inptr(a, I_LBA) + l * 512; const float* bx = (const float*)inptr(a, I_LBX) + l * 512; const float* lam = (const float*)inptr(a, I_LLAM) + l * 512;
    const int tid = X.tid, lane = X.lane, wave = X.wave, r32 = lane & 31, hi = lane >> 5;
    constexpr int NU = NB * 64 * 8;
    v4u px0, px1, px2, pg0, pg1;
#define LRU_ISSUE(u_) do { const int blk_ = (u_) & 7, n_ = ((u_) >> 3) & 63, b_ = (u_) >> 9; const v4u z_ = {0u, 0u, 0u, 0u}; \
        { const int c_ = tid, r_ = c_ >> 3, cc_ = (c_ & 7) * 8, s_ = n_ * 128 + r_ - 3; px0 = z_; if (s_ >= 0) px0 = *(const v4u*)(TL + ((size_t)b_ * SEQ + s_) * 1024 + blk_ * 64 + cc_); } \
        { const int c_ = tid + 512, r_ = c_ >> 3, cc_ = (c_ & 7) * 8, s_ = n_ * 128 + r_ - 3; px1 = z_; if (s_ >= 0) px1 = *(const v4u*)(TL + ((size_t)b_ * SEQ + s_) * 1024 + blk_ * 64 + cc_); } \
        { const int c_ = tid + 1024, r_ = c_ >> 3, cc_ = (c_ & 7) * 8, s_ = n_ * 128 + r_ - 3; px2 = z_; if (c_ < 131 * 8 && s_ >= 0) px2 = *(const v4u*)(TL + ((size_t)b_ * SEQ + s_) * 1024 + blk_ * 64 + cc_); } \
        if (PASS == 2) { const size_t row0_ = (size_t)b_ * SEQ + n_ * 128; \
          pg0 = *(const v4u*)(TL + (row0_ + (tid >> 3)) * 1024 + 512 + blk_ * 64 + (tid & 7) * 8); pg1 = *(const v4u*)(TL + (row0_ + 64 + (tid >> 3)) * 1024 + 512 + blk_ * 64 + (tid & 7) * 8); } } while (0)
    int u = X.vcu;
    if (u < NU) LRU_ISSUE(u);
    for (; u < NU; u += X.G) {
        const int blk = u & 7, n = (u >> 3) & 63, b = u >> 9, ch0 = blk * 64; const size_t row0 = (size_t)b * SEQ + n * 128;
        { float f[8]; unpack8(px0, f); { const int c = tid, r = c >> 3, cc = (c & 7) * 8;
#pragma unroll
            for (int e = 0; e < 8; ++e) XS[r * 64 + cc + e] = f[e]; }
          unpack8(px1, f); { const int c = tid + 512, r = c >> 3, cc = (c & 7) * 8;
#pragma unroll
            for (int e = 0; e < 8; ++e) XS[r * 64 + cc + e] = f[e]; }
          if (tid + 1024 < 131 * 8) { unpack8(px2, f); const int c = tid + 1024, r = c >> 3, cc = (c & 7) * 8;
#pragma unroll
            for (int e = 0; e < 8; ++e) XS[r * 64 + cc + e] = f[e]; }
          if (PASS == 2) { *(v4u*)(GS + (tid >> 3) * 64 + (tid & 7) * 8) = pg0; *(v4u*)(GS + (64 + (tid >> 3)) * 64 + (tid & 7) * 8) = pg1; } }
        __syncthreads();
        { const int c = tid & 63, rg = tid >> 6; const float w0 = cw[ch0 + c], w1 = cw[512 + ch0 + c], w2 = cw[1024 + ch0 + c], w3 = cw[1536 + ch0 + c], bb = cbv[ch0 + c];
#pragma unroll 4
            for (int r = 0; r < 16; ++r) { const int t = rg * 16 + r; const float v = bb + w0 * XS[t * 64 + c] + w1 * XS[(t + 1) * 64 + c] + w2 * XS[(t + 2) * 64 + c] + w3 * XS[(t + 3) * 64 + c];
                XC[t * 64 + c] = v; XCB[t * 72 + c] = (bf16)f2bf(v); } }
        __syncthreads();
        if (u + X.G < NU) LRU_ISSUE(u + X.G);
        { const int tb = wave >> 1, cb = wave & 1; f32x16 R = {}, I = {};
#pragma unroll
            for (int ks = 0; ks < 4; ++ks) { const bf16x8 A = *(const bf16x8*)(XCB + (32 * tb + r32) * 72 + 16 * ks + 8 * hi);
                const bf16x8 Ba = *(const bf16x8*)(WaT + (size_t)(blk * 64 + 32 * cb + r32) * 64 + 16 * ks + 8 * hi), Bx = *(const bf16x8*)(WxT + (size_t)(blk * 64 + 32 * cb + r32) * 64 + 16 * ks + 8 * hi);
                R = __builtin_amdgcn_mfma_f32_32x32x16_bf16(A, Ba, R, 0, 0, 0); I = __builtin_amdgcn_mfma_f32_32x32x16_bf16(A, Bx, I, 0, 0, 0); }
            const int c = 32 * cb + r32; const float bav = ba[ch0 + c], bxv = bx[ch0 + c], sp = softplus_neg(lam[ch0 + c]);
#pragma unroll
            for (int r = 0; r < 16; ++r) { const int t = 32 * tb + (r & 3) + 8 * (r >> 2) + 4 * hi;
                const float rr = sigm(R[r] + bav), ii = sigm(I[r] + bxv), la = -8.0f * rr * sp, av = __builtin_amdgcn_exp2f(1.4426950408889634f * la), mult = __builtin_amdgcn_sqrtf(neg_expm1(2.0f * la));
                AA[t * 64 + c] = av; XC[t * 64 + c] = mult * ii * XC[t * 64 + c]; } }
        __syncthreads();
        { const int c = tid & 63, sg = tid >> 6; float Ap = 1.f, Hp = 0.f;
#pragma unroll 4
            for (int i = 0; i < 16; ++i) { const int t = sg * 16 + i; const float av = AA[t * 64 + c]; Hp = av * Hp + XC[t * 64 + c]; Ap *= av; }
            SEG[sg * 64 + c] = Ap; SEG[512 + sg * 64 + c] = Hp;
            __syncthreads();
            if (PASS == 1) { if (tid < 64) { float A2 = 1.f, H2 = 0.f;
#pragma unroll
                    for (int s = 0; s < 8; ++s) { const float sa = SEG[s * 64 + c]; H2 = sa * H2 + SEG[512 + s * 64 + c]; A2 *= sa; }
                    LSA[(size_t)(b * 64 + n) * 512 + ch0 + c] = A2; LSH[(size_t)(b * 64 + n) * 512 + ch0 + c] = H2; } }
            else { float hin = LC[(size_t)(b * 64 + n) * 512 + ch0 + c];
                for (int s = 0; s < sg; ++s) hin = SEG[s * 64 + c] * hin + SEG[512 + s * 64 + c];
#pragma unroll 4
                for (int i = 0; i < 16; ++i) { const int t = sg * 16 + i; hin = AA[t * 64 + c] * hin + XC[t * 64 + c];
                    const float g = bf2f(GS[t * 64 + c]);
                    YB[(row0 + t) * 1536 + ch0 + c] = (bf16)f2bf(hin * gelu_tanh(g)); } }
        }
        __syncthreads();
    }
#undef LRU_ISSUE
}
__device__ __forceinline__ void lru_prefix(const Ctx& X, const Args& a) {
    const float* LSA = (const float*)(wsptr(a) + WS_LSA); const float* LSH = (const float*)(wsptr(a) + WS_LSH); float* LC = (float*)(wsptr(a) + WS_LC);
    const int idx = X.vcu * 512 + X.tid;
    if (idx < NB * 512) { const int b = idx >> 9, ch = idx & 511; float h = 0.f;
        for (int n0 = 0; n0 < 64; n0 += 8) { float av[8], hv[8];
#pragma unroll
            for (int j = 0; j < 8; ++j) { av[j] = LSA[(size_t)(b * 64 + n0 + j) * 512 + ch]; hv[j] = LSH[(size_t)(b * 64 + n0 + j) * 512 + ch]; }
#pragma unroll
            for (int j = 0; j < 8; ++j) { LC[(size_t)(b * 64 + n0 + j) * 512 + ch] = h; h = av[j] * h + hv[j]; } } }
}

constexpr int RT_Q = 0, RT_K = 18432, RT_V = 36864, RT_S = 55296, RT_HALF = 64512, RT_P = 72;
template <int PASS>
__device__ __forceinline__ void ret_phase(const Ctx& X, unsigned char* ldsg, const Args& a) {
    const bf16* TR = (const bf16*)(wsptr(a) + WS_TR); bf16* YB = (bf16*)(wsptr(a) + WS_YB); float* RS = (float*)(wsptr(a) + WS_RS);
    const float* cr = (const float*)(wsptr(a) + WS_ROPE); const float* sr = cr + (size_t)M * 32;
    const int tid = X.tid, lane = X.lane, wave = X.wave, r32 = lane & 31, hi = lane >> 5, half = wave >> 2, w4 = wave & 3, t2 = tid & 255;
    bf16* Qs = (bf16*)(ldsg + half * RT_HALF + RT_Q); bf16* Ks = (bf16*)(ldsg + half * RT_HALF + RT_K); bf16* Vs = (bf16*)(ldsg + half * RT_HALF + RT_V); bf16* Ss = (bf16*)(ldsg + half * RT_HALF + RT_S);
    for (int u = X.vcu; u < NB * 64 * 4; u += X.G) {
        const int hp = u & 3, n = (u >> 2) & 63, b = u >> 8, h = 2 * hp + half; const size_t row0 = (size_t)b * SEQ + n * 128; const float lg = LG2G[h];
        for (int c = t2; c < 1024; c += 256) { const int r = c >> 3, cc = (c & 7) * 8; const size_t grow = row0 + r;
            const f32x4 cs = *(const f32x4*)(cr + grow * 32 + (cc >> 1)), sn = *(const f32x4*)(sr + grow * 32 + (cc >> 1));
            { const v4u w = *(const v4u*)(TR + grow * 2048 + 512 + h * 64 + cc); float f[8], o[8]; unpack8(w, f);
              const float kd = (PASS == 1) ? 0.125f * __builtin_amdgcn_exp2f((float)(127 - r) * lg) : 0.125f;
#pragma unroll
              for (int p = 0; p < 4; ++p) { o[2 * p] = (f[2 * p] * cs[p] - f[2 * p + 1] * sn[p]) * kd; o[2 * p + 1] = (f[2 * p] * sn[p] + f[2 * p + 1] * cs[p]) * kd; }
              *(v4u*)(Ks + r * RT_P + cc) = pack8f(o); }
            *(v4u*)(Vs + r * RT_P + cc) = *(const v4u*)(TR + grow * 2048 + 1024 + h * 64 + cc);
            if (PASS == 2) { const v4u w = *(const v4u*)(TR + grow * 2048 + h * 64 + cc); float f[8], o[8]; unpack8(w, f);
#pragma unroll
              for (int p = 0; p < 4; ++p) { o[2 * p] = f[2 * p] * cs[p] - f[2 * p + 1] * sn[p]; o[2 * p + 1] = f[2 * p] * sn[p] + f[2 * p + 1] * cs[p]; }
              *(v4u*)(Qs + r * RT_P + cc) = pack8f(o); } }
        if (PASS == 2) { const float* sp = RS + ((size_t)(b * 8 + h) * 64 + n) * 4096;
            for (int c = t2; c < 1024; c += 256) { const int d = c >> 4, e0 = (c & 15) * 4; const f32x4 v = *(const f32x4*)(sp + d * 64 + e0);
                Ss[(e0 + 0) * RT_P + d] = (bf16)f2bf(v.x); Ss[(e0 + 1) * RT_P + d] = (bf16)f2bf(v.y); Ss[(e0 + 2) * RT_P + d] = (bf16)f2bf(v.z); Ss[(e0 + 3) * RT_P + d] = (bf16)f2bf(v.w); } }
        __syncthreads();
        if (PASS == 1) {
            const int db = w4 >> 1, eb = w4 & 1; f32x16 acc = {};
#pragma unroll
            for (int ks = 0; ks < 8; ++ks) { bf16x8 A, B;
#pragma unroll
                for (int j = 0; j < 8; ++j) { A[j] = (short)Ks[(16 * ks + 8 * hi + j) * RT_P + 32 * db + r32]; B[j] = (short)Vs[(16 * ks + 8 * hi + j) * RT_P + 32 * eb + r32]; }
                acc = __builtin_amdgcn_mfma_f32_32x32x16_bf16(A, B, acc, 0, 0, 0); }
            float* dst = RS + ((size_t)(b * 8 + h) * 64 + n) * 4096;
#pragma unroll
            for (int r = 0; r < 16; ++r) dst[(32 * db + (r & 3) + 8 * (r >> 2) + 4 * hi) * 64 + 32 * eb + r32] = acc[r];
        } else {
            const int cb = w4; bf16x8 qf[4];
#pragma unroll
            for (int ks = 0; ks < 4; ++ks) qf[ks] = *(const bf16x8*)(Qs + (32 * cb + r32) * RT_P + 16 * ks + 8 * hi);
            f32x16 yin[2] = {}, ycr[2] = {};
            for (int sb = 0; sb <= cb; ++sb) { f32x16 st = {};
#pragma unroll
                for (int ks = 0; ks < 4; ++ks) { const bf16x8 A = *(const bf16x8*)(Ks + (32 * sb + r32) * RT_P + 16 * ks + 8 * hi); st = __builtin_amdgcn_mfma_f32_32x32x16_bf16(A, qf[ks], st, 0, 0, 0); }
#pragma unroll
                for (int r = 0; r < 16; ++r) { const int d = (32 * cb + r32) - (32 * sb + (r & 3) + 8 * (r >> 2) + 4 * hi); st[r] = d >= 0 ? st[r] * __builtin_amdgcn_exp2f((float)d * lg) : 0.f; }
#pragma unroll
                for (int t = 0; t < 2; ++t) { v4u pw; pw.x = pk2(st[8 * t], st[8 * t + 1]); pw.y = pk2(st[8 * t + 2], st[8 * t + 3]); pw.z = pk2(st[8 * t + 4], st[8 * t + 5]); pw.w = pk2(st[8 * t + 6], st[8 * t + 7]);
                    const bf16x8 Bf = __builtin_bit_cast(bf16x8, pw);
#pragma unroll
                    for (int eb = 0; eb < 2; ++eb) { bf16x8 A;
#pragma unroll
                        for (int j = 0; j < 8; ++j) A[j] = (short)Vs[(32 * sb + 16 * t + 8 * (j >> 2) + 4 * hi + (j & 3)) * RT_P + 32 * eb + r32];
                        yin[eb] = __builtin_amdgcn_mfma_f32_32x32x16_bf16(A, Bf, yin[eb], 0, 0, 0); } } }
#pragma unroll
            for (int eb = 0; eb < 2; ++eb)
#pragma unroll
                for (int ks = 0; ks < 4; ++ks) { const bf16x8 A = *(const bf16x8*)(Ss + (32 * eb + r32) * RT_P + 16 * ks + 8 * hi); ycr[eb] = __builtin_amdgcn_mfma_f32_32x32x16_bf16(A, qf[ks], ycr[eb], 0, 0, 0); }
            const float qd = __builtin_amdgcn_exp2f((float)(32 * cb + r32 + 1) * lg);
            float s = 0.f;
#pragma unroll
            for (int eb = 0; eb < 2; ++eb)
#pragma unroll
                for (int r = 0; r < 16; ++r) { yin[eb][r] += qd * ycr[eb][r]; s += yin[eb][r]; }
            s = half_sum(s); const float mu = s * (1.0f / 64.0f); float q = 0.f;
#pragma unroll
            for (int eb = 0; eb < 2; ++eb)
#pragma unroll
                for (int r = 0; r < 16; ++r) { const float dlt = yin[eb][r] - mu; yin[eb][r] = dlt; q += dlt * dlt; }
            q = half_sum(q); const float rstd = __builtin_amdgcn_rsqf(q * (1.0f / 64.0f) + EPS);
            const size_t grow = row0 + 32 * cb + r32;
#pragma unroll
            for (int eb = 0; eb < 2; ++eb)
#pragma unroll
                for (int qd4 = 0; qd4 < 4; ++qd4) { const int e0 = 32 * eb + 8 * qd4 + 4 * hi;
                    const u32x2 gw = *(const u32x2*)(TR + grow * 2048 + 1536 + h * 64 + e0);
                    const float g0 = __uint_as_float(gw.x << 16), g1 = __uint_as_float(gw.x & 0xffff0000u), g2 = __uint_as_float(gw.y << 16), g3 = __uint_as_float(gw.y & 0xffff0000u);
                    u32x2 ow; ow.x = pk2(g0 * sigm(g0) * yin[eb][4 * qd4] * rstd, g1 * sigm(g1) * yin[eb][4 * qd4 + 1] * rstd); ow.y = pk2(g2 * sigm(g2) * yin[eb][4 * qd4 + 2] * rstd, g3 * sigm(g3) * yin[eb][4 * qd4 + 3] * rstd);
                    *(u32x2*)(YB + grow * 1536 + 512 + h * 64 + e0) = ow; }
        }
        __syncthreads();
    }
}
__device__ __forceinline__ void ret_prefix(const Ctx& X, const Args& a) {
    float* RS = (float*)(wsptr(a) + WS_RS);
    const int nth = X.G * 512;
    for (int idx = X.vcu * 512 + X.tid; idx < NB * 8 * 4096; idx += nth) { const int bh = idx >> 12, off = idx & 4095, h = bh & 7;
        const float cd = __builtin_amdgcn_exp2f(128.0f * LG2G[h]); float* base = RS + (size_t)bh * 64 * 4096 + off; float st = 0.f;
        for (int n0 = 0; n0 < 64; n0 += 8) { float t[8];
#pragma unroll
            for (int j = 0; j < 8; ++j) t[j] = base[(size_t)(n0 + j) * 4096];
#pragma unroll
            for (int j = 0; j < 8; ++j) { base[(size_t)(n0 + j) * 4096] = st; st = st * cd + t[j]; } } }
}


constexpr int PH_PER_LAYER = 12, NPH = 2 + PH_PER_LAYER * DEPTH;
constexpr int BIGT = 1 << 30;

__global__ void __launch_bounds__(NWAVES * 64, 2) mk_fwd(Args args) {
    unsigned char* lds = g_lds;
    LAS unsigned char* L3 = (LAS unsigned char*)lds;
    const int wave0 = __builtin_amdgcn_readfirstlane((int)threadIdx.x >> 6);
    const int lo = args.ph_lo, hi = args.ph_hi;
    for (int u = threadIdx.x; u < (LDS_BYTES - 131072) / 4; u += NWAVES * 64) ((LAS unsigned*)(L3 + 131072))[u] = 0u;
    __syncthreads();
    if (threadIdx.x < 31) ((LAS unsigned long long*)(L3 + ARGS_LDS_OFF))[threadIdx.x] = ((const unsigned long long*)&args)[threadIdx.x];
    __syncthreads();
    if (hi - lo > 1) (void)xcd_barrier_post((unsigned*)(wsptr(args) + WS_CTL) + 1024, (volatile LAS unsigned*)(L3 + MISC_OFF) + 8);
#ifndef PHMASK
#define PHMASK 0xFFFFFFFFu
#endif
#define PHON(j) ((PHMASK >> (2 + (j))) & 1u)
#define CTX Ctx X; int bx; LAS unsigned char* L3p; unsigned char* ldsp; \
        { int ln_; asm volatile("v_mbcnt_lo_u32_b32 %0, -1, 0\n\tv_mbcnt_hi_u32_b32 %0, -1, %0" : "=v"(ln_)); \
          const int w_ = opaque_u(wave0), g_ = opaque_u((int)gridDim.x), b_ = opaque_u((int)blockIdx.x), lz_ = opaque_u(0); \
          X.tid = w_ * 64 + ln_; X.lane = ln_; X.wave = w_; X.G = g_; bx = b_; X.vcu = (g_ % 8 == 0) ? (b_ % 8) * (g_ / 8) + b_ / 8 : b_; L3p = L3 + lz_; ldsp = lds + lz_; } \
        unsigned char* ws = wsptr(args); (void)bx; (void)L3p; (void)ldsp; (void)ws;
#define WPTR(off) ((const bf16*)(ws + WS_W + (off)))
#pragma unroll 1
    for (int ph = lo, rep = 0; ph < hi; ++ph) {
        const int l = ph < 2 ? 0 : (ph - 2) / PH_PER_LAYER, j = ph < 2 ? ph - 2 : (ph - 2) - l * PH_PER_LAYER;
#ifdef AMP_MASK
        const unsigned long long amp_t0 = __builtin_amdgcn_s_memrealtime();
#endif

#ifndef REPMASK
#define REPMASK 0u
#endif
        if (j == -2 && PHON(-2)) { CTX p_mods(X, L3p, args); __syncthreads(); p_rope(X, args); convert_mixer(X, L3p, args, 0); }
        else if (j == -1 && PHON(-1)) { CTX const float* MOD = (const float*)(ws + WS_MOD);
            row_pass<0, true>(X, (const float*)inptr(args, I_X), nullptr, nullptr, nullptr, nullptr, (const float*)inptr(args, I_MIXPRE), MOD, MOD + 1024, (bf16*)(ws + WS_XN)); }
        else if (j == 0 && PHON(0)) { CTX
            pg8::Gemm g{(const bf16*)(ws + WS_XN), WPTR(WO_IN), M, 3840, 1024, 1024}; pg8::StaticOrder S; S.init(M, 3840, X.G, bx);
            typedef pg8::EpiRoute<0, WS_TL, 1024, 4, WS_TR, 2048, 12, WS_TM, 768> E_t; E_t E{&args};
            pg8::gemm_phase<E_t, pg8::StaticOrder, true, true>(L3p, g, S, E, X.tid);
        }
        else if (j == 1 && PHON(1)) { CTX lru_phase<1>(X, ldsp, args, l); __syncthreads(); ret_phase<1>(X, ldsp, args); p_mla_rstd(X, args); }
        else if (j == 2 && PHON(2)) { CTX lru_prefix(X, args); ret_prefix(X, args); }
        else if (j == 3 && PHON(3)) { CTX lru_phase<2>(X, ldsp, args, l); __syncthreads(); ret_phase<2>(X, ldsp, args); }
        else if (j == 4 && PHON(4)) {
            { CTX p_krope(X, args); }
            { CTX pg8::Gemm g{(const bf16*)(ws + WS_TM), WPTR(WO_UQ), M, 768, 384, 768}; pg8::StaticOrder S; S.init(M, 768, X.G, bx);
              pg8::EpiQ E{&args}; pg8::gemm_phase<pg8::EpiQ, pg8::StaticOrder, true, true>(L3p, g, S, E, X.tid); }
            { CTX pg8::Gemm g{(const bf16*)(ws + WS_TM) + 384, WPTR(WO_UKV), M, 1024, 256, 768}; pg8::StaticOrder S; S.init(M, 1024, X.G, bx);
              pg8::EpiKV E{&args}; pg8::gemm_phase<pg8::EpiKV, pg8::StaticOrder, true, true>(L3p, g, S, E, X.tid); }
        }
        else if (j == 5 && PHON(5)) { CTX
            const bf16* Qb = (const bf16*)(ws + WS_Q); const bf16* Kb = (const bf16*)(ws + WS_K); const bf16* Vb = (const bf16*)(ws + WS_V); bf16* YB = (bf16*)(ws + WS_YB);
            att::Seam S;
            for (int L = X.vcu; L < 256; L += X.G) {
                const int bh = L >> 4, xq = L & 15, b = bh >> 3, h = bh & 7, qb0 = xq, qb1 = 31 - xq;
                const bf16* Kh = Kb + (size_t)b * SEQ * 768 + h * 96; const bf16* Vh = Vb + (size_t)b * SEQ * 512 + h * 64;
                att::BlockRef r0{Qb + ((size_t)b * SEQ + qb0 * 256) * 768 + h * 96, Kh, Vh, YB + ((size_t)b * SEQ + qb0 * 256) * 1536 + 1024 + h * 64, qb0 * 256};
                att::BlockRef r1{Qb + ((size_t)b * SEQ + qb1 * 256) * 768 + h * 96, Kh, Vh, YB + ((size_t)b * SEQ + qb1 * 256) * 1536 + 1024 + h * 64, qb1 * 256};
                att::attn_prime(r0, (char*)ldsp, S, X.tid);
                att::attn_block(r0, r1, (char*)ldsp, S, X.tid);
                att::attn_block(r1, r1, (char*)ldsp, S, X.tid);
                asm volatile("s_waitcnt vmcnt(0)" ::: "memory"); __syncthreads();
            }
        }
        else if (j == 6 && PHON(6)) {
            { CTX pg8::Gemm g{(const bf16*)(ws + WS_XN), WPTR(WO_G), M, 3072, 1024, 1024}; pg8::GateOrder S; S.init(M, X.G, bx);
              typedef pg8::EpiRoute<2, WS_G, 3072, BIGT, 0, 0, BIGT, 0, 0> E_t; E_t E{&args};
              pg8::gemm_phase<E_t, pg8::GateOrder, true, true>(L3p, g, S, E, X.tid);
              asm volatile("s_waitcnt vmcnt(0)" ::: "memory"); __syncthreads();
              __builtin_amdgcn_fence(__ATOMIC_ACQUIRE, "agent"); asm volatile("s_waitcnt vmcnt(0)" ::: "memory"); }
            { CTX pg8::Gemm g{(const bf16*)(ws + WS_YB), WPTR(WO_O3), M, 3072, 512, 1536}; pg8::MergeOrder S; S.init(M, X.G, bx);
              pg8::EpiMerge E{&args}; pg8::gemm_phase<pg8::EpiMerge, pg8::MergeOrder, true, true>(L3p, g, S, E, X.tid); }
        }
        else if (j == 7 && PHON(7)) { CTX
            pg8::Gemm g{(const bf16*)(ws + WS_XN), WPTR(WO_OUT), M, 1024, 1024, 1024}; pg8::StaticOrder S; S.init(M, 1024, X.G, bx);
            typedef pg8::EpiRoute<0, WS_Y, 1024, BIGT, 0, 0, BIGT, 0, 0> E_t; E_t E{&args}; pg8::gemm_phase<E_t, pg8::StaticOrder, true, true>(L3p, g, S, E, X.tid);
        }
        else if (j == 8 && PHON(8)) { CTX float* out = outptr(args); const float* MODl = (const float*)(ws + WS_MOD) + (size_t)l * NB * 6144;
            row_pass<1, true, true>(X, l == 0 ? (const float*)inptr(args, I_X) : (const float*)out, out, (const bf16*)(ws + WS_Y), (const float*)inptr(args, I_MIXPOST) + l * 1024, MODl + 2048,
                              (const float*)inptr(args, I_FPRE) + l * 1024, MODl + 3072, MODl + 4096, (bf16*)(ws + WS_XN));
            convert_ffn(X, L3p, args, l);
#ifdef REP_CONV
            convert_ffn(X, L3p, args, l);
#endif
        }
        else if (j == 9 && PHON(9)) { CTX
            pg8::Gemm g{(const bf16*)(ws + WS_XN), WPTR(WO_UP), M + 1024, 5632, 1024, 1024}; pg8::StaticOrder S; S.init(M + 1024, 5632, X.G, bx);
            pg8::EpiGlu E{&args, l}; pg8::gemm_phase<pg8::EpiGlu, pg8::StaticOrder, true, true>(L3p, g, S, E, X.tid);
        }
        else if (j == 10 && PHON(10)) { CTX
            pg8::Gemm g{(const bf16*)(ws + WS_ACT), WPTR(WO_DOWN), M, 1024, 2816, 2816}; pg8::StaticOrder S; S.init(M, 1024, X.G, bx);
            typedef pg8::EpiRoute<0, WS_Y2, 1024, BIGT, 0, 0, BIGT, 0, 0> E_t; E_t E{&args}; pg8::gemm_phase<E_t, pg8::StaticOrder, true, true>(L3p, g, S, E, X.tid);
        }
        else if (j == 11 && PHON(11)) { CTX float* out = outptr(args); const float* MOD = (const float*)(ws + WS_MOD); const float* MODl = MOD + (size_t)l * NB * 6144;
            if (l + 1 < DEPTH) {
                const float* MODn = MOD + (size_t)(l + 1) * NB * 6144;
                row_pass<1, true>(X, (const float*)out, out, (const bf16*)(ws + WS_Y2), (const float*)inptr(args, I_FPOST) + l * 1024, MODl + 5120,
                                  (const float*)inptr(args, I_MIXPRE) + (l + 1) * 1024, MODn, MODn + 1024, (bf16*)(ws + WS_XN));
                convert_mixer(X, L3p, args, l + 1);
#ifdef REP_CONV
                convert_mixer(X, L3p, args, l + 1);
#endif
            } else {
                row_pass<1, false>(X, (const float*)out, out, (const bf16*)(ws + WS_Y2), (const float*)inptr(args, I_FPOST) + l * 1024, MODl + 5120, nullptr, nullptr, nullptr, nullptr);
            }
        }
        if (REPMASK != 0u) { const int nrep = ((REPMASK >> (j + 2)) & 1u) ? 2 : 1; if (++rep < nrep) { --ph; continue; } rep = 0; }
        if (ph + 1 < hi) {
            if (ph == lo) { cg::this_grid().sync(); }
            else { unsigned char* ws = wsptr(args); const int lz_ = opaque_u(0); XcdBarrier bar; bar.bar = (unsigned*)(ws + WS_CTL) + 1024; bar.x = xb_xcc_id(); bar.st = (volatile LAS unsigned*)(L3 + lz_ + MISC_OFF) + 8; xcd_barrier(bar);
#ifdef REP_BAR
                   xcd_barrier(bar);
#endif
            }
        }
#ifdef AMP_MASK
        if ((AMP_MASK >> (j + 2)) & 1u) {
            const unsigned long long t1 = __builtin_amdgcn_s_memrealtime(), target = t1 + (unsigned long long)(AMP_N - 1) * (t1 - amp_t0);
            while (__builtin_amdgcn_s_memrealtime() < target) __builtin_amdgcn_s_sleep(8);
        }
#endif
    }
#undef PHON
#undef WPTR
#undef CTX
}


#ifdef DBG_K
__global__ void dbg_dump(const unsigned char* ws, float* out) {
    const bf16* buf = (const bf16*)(ws + (size_t)DBG_OFF);
    for (size_t i = (size_t)blockIdx.x * blockDim.x + threadIdx.x; i < (size_t)M * 1024; i += (size_t)gridDim.x * blockDim.x) {
        const size_t r = i >> 10; const int c = (int)(i & 1023);
        out[i] = c < DBG_NC ? __uint_as_float((unsigned)buf[r * DBG_LD + DBG_COL0 + c] << 16) : 0.f; }
}
#endif
extern "C" void kernel_launch(void* const* d_in, const int* in_sizes, int n_in, void* d_out, int out_size, void* d_ws, size_t ws_size, hipStream_t stream) {
    static int grid = 0;
    if (grid == 0) {
        if (n_in != 29 || in_sizes[0] != M * DM || out_size != M * DM || ws_size < WS_END) { fprintf(stderr, "kernel_launch: unexpected shapes (n_in %d, in0 %d, out %d, ws %zu)\n", n_in, n_in > 0 ? in_sizes[0] : -1, out_size, ws_size); grid = -1; return; }
        int dev = 0, cus = 0, per_cu = 0;
        if (hipGetDevice(&dev) != hipSuccess || hipDeviceGetAttribute(&cus, hipDeviceAttributeMultiprocessorCount, dev) != hipSuccess) { grid = -1; return; }
        if (hipFuncSetAttribute((const void*)mk_fwd, hipFuncAttributeMaxDynamicSharedMemorySize, LDS_BYTES) != hipSuccess) { fprintf(stderr, "kernel_launch: hipFuncSetAttribute failed\n"); grid = -1; return; }
        if (hipOccupancyMaxActiveBlocksPerMultiprocessor(&per_cu, (const void*)mk_fwd, NWAVES * 64, LDS_BYTES) != hipSuccess || per_cu < 1) { fprintf(stderr, "kernel_launch: occupancy query says %d blocks per CU\n", per_cu); per_cu = 1; }
        (void)hipGetLastError();
        grid = cus;
    }
    if (grid < 0) return;
    (void)hipMemsetAsync((char*)d_ws + WS_CTL, 0, CTL_ZERO_BYTES, stream);
    Args a{};
    for (int i = 0; i < 29; ++i) a.in[i] = d_in[i];
    a.out = (float*)d_out; a.ws = (unsigned char*)d_ws;
#if MK_ONE_LAUNCH
    a.ph_lo = 0; a.ph_hi = NPH;
    void* params[] = {&a};
    hipError_t e = hipLaunchCooperativeKernel((const void*)mk_fwd, dim3(grid), dim3(NWAVES * 64), params, LDS_BYTES, stream);
    if (e != hipSuccess) fprintf(stderr, "kernel_launch: cooperative launch failed: %s (grid %d)\n", hipGetErrorString(e), grid);
#else
#ifdef DBG_K
    for (int k = 0; k < DBG_K; ++k) { a.ph_lo = k; a.ph_hi = k + 1; hipLaunchKernelGGL(mk_fwd, dim3(grid), dim3(NWAVES * 64), LDS_BYTES, stream, a); }
    hipLaunchKernelGGL(dbg_dump, dim3(2048), dim3(256), 0, stream, (const unsigned char*)d_ws, (float*)d_out);
#else
    for (int k = 0; k < NPH; ++k) { a.ph_lo = k; a.ph_hi = k + 1; hipLaunchKernelGGL(mk_fwd, dim3(grid), dim3(NWAVES * 64), LDS_BYTES, stream, a); }
#endif
#endif
}
```
